# Optimizing an MI355X kernel written in HIP

```python
import math
import jax, jax.numpy as jnp
from jax import lax
import numpy as np

D_MODEL = 1024
BATCH = 2
SEQ = 8192
DEPTH = 2

N_MIXERS = 2
EPS = 1e-6
SSM_EXPAND = 2
SSM_D_INNER = SSM_EXPAND * D_MODEL
SSM_HEAD_DIM = 64
SSM_HEADS = SSM_D_INNER // SSM_HEAD_DIM
SSM_GROUPS = 4
SSM_STATE = 128
SSM_CONV = 4
SSM_CHUNK = 128
SSM_GN = SSM_GROUPS * SSM_STATE
SSM_CONV_DIM = SSM_D_INNER + 2 * SSM_GN
SSM_IN_DIM = SSM_D_INNER + SSM_CONV_DIM + SSM_HEADS
ATTN_HEAD_DIM = 64
ATTN_Q_HEADS = D_MODEL // ATTN_HEAD_DIM
ATTN_KV_HEADS = 4
ATTN_Q_PER_KV = ATTN_Q_HEADS // ATTN_KV_HEADS
WINDOW = 128
ATTN_QKV_DIM = (ATTN_Q_HEADS + 2 * ATTN_KV_HEADS) * ATTN_HEAD_DIM
REL_BUCKETS = 32
REL_MAX_DIST = 128
N_EXPERTS = 32
TOP_K = 4
EXPERT_FF = D_MODEL
SWIGLU_ALPHA = 1.702
SWIGLU_LIMIT = 7.0
MOE_BLOCK = 128
N_SSM_LAYERS = (DEPTH + 1) // 2
N_ATTN_LAYERS = DEPTH // 2

kernel_name = "hybrid_ssd_swa_moe_adaln"


def rms_norm(x, g):
    xf = x.astype(jnp.float32)
    xf = xf * lax.rsqrt(jnp.mean(xf * xf, axis=-1, keepdims=True) + EPS)
    return (xf * g.astype(jnp.float32)).astype(x.dtype)


def modulate(x, g, shift, scale):
    return rms_norm(x, g) * (1 + scale[:, None, :]) + shift[:, None, :]


def ssd_chunked(xs, dt, A, Bm, Cm):
    b, s, h, p = xs.shape
    g, n = Bm.shape[2], Bm.shape[3]
    r = h // g
    nc = s // SSM_CHUNK
    X = (xs.astype(jnp.float32) * dt[..., None]).reshape(b, nc, SSM_CHUNK, g, r, p)
    dA = (dt * A).reshape(b, nc, SSM_CHUNK, g, r).transpose(0, 3, 4, 1, 2)
    Bc = Bm.astype(jnp.float32).reshape(b, nc, SSM_CHUNK, g, n)
    Cc = Cm.astype(jnp.float32).reshape(b, nc, SSM_CHUNK, g, n)
    A_cs = jnp.cumsum(dA, axis=-1)
    causal = jnp.tril(jnp.ones((SSM_CHUNK, SSM_CHUNK), dtype=bool))
    seg = A_cs[..., :, None] - A_cs[..., None, :]
    L = jnp.exp(jnp.where(causal, seg, -jnp.inf))
    CB = jnp.einsum("bclgn,bcsgn->bcgls", Cc, Bc)
    y_diag = jnp.einsum("bcgls,bgrcls,bcsgrp->bclgrp", CB, L, X)
    decay_states = jnp.exp(A_cs[..., -1:] - A_cs)
    states = jnp.einsum("bclgn,bgrcl,bclgrp->bcgrpn", Bc, decay_states, X)
    chunk_decay = jnp.exp(A_cs[..., -1])

    def step(h_prev, inp):
        st, dec = inp
        return h_prev * dec[..., None, None] + st, h_prev

    init = jnp.zeros((b, g, r, p, n), jnp.float32)
    _, h_in = lax.scan(step, init, (jnp.moveaxis(states, 1, 0), jnp.moveaxis(chunk_decay, 3, 0)))
    h_in = jnp.moveaxis(h_in, 0, 1)
    y_off = jnp.einsum("bclgn,bcgrpn,bgrcl->bclgrp", Cc, h_in, jnp.exp(A_cs))
    return (y_diag + y_off).reshape(b, s, h, p)


def mamba2_mixer(h, in_w, conv_w, conv_b, dt_bias, A_log, D_skip, norm_g, out_w):
    b, s, _ = h.shape
    zxbcdt = h @ in_w
    z = zxbcdt[..., :SSM_D_INNER]
    xbc = zxbcdt[..., SSM_D_INNER:SSM_D_INNER + SSM_CONV_DIM]
    dt_raw = zxbcdt[..., SSM_D_INNER + SSM_CONV_DIM:]
    xbc = lax.conv_general_dilated(xbc, conv_w[:, None, :].astype(xbc.dtype), (1,), [(SSM_CONV - 1, 0)],
                                   dimension_numbers=("NWC", "WIO", "NWC"),
                                   feature_group_count=SSM_CONV_DIM) + conv_b
    xbc = jax.nn.silu(xbc)
    xs = xbc[..., :SSM_D_INNER].reshape(b, s, SSM_HEADS, SSM_HEAD_DIM)
    Bm = xbc[..., SSM_D_INNER:SSM_D_INNER + SSM_GN].reshape(b, s, SSM_GROUPS, SSM_STATE)
    Cm = xbc[..., SSM_D_INNER + SSM_GN:].reshape(b, s, SSM_GROUPS, SSM_STATE)
    dt = jax.nn.softplus(dt_raw.astype(jnp.float32) + dt_bias.astype(jnp.float32))
    A = -jnp.exp(A_log.astype(jnp.float32))
    y = ssd_chunked(xs, dt, A, Bm, Cm) + D_skip.astype(jnp.float32)[:, None] * xs.astype(jnp.float32)
    y = y.reshape(b, s, SSM_D_INNER) * jax.nn.silu(z.astype(jnp.float32))
    y = y.reshape(b, s, SSM_GROUPS, SSM_D_INNER // SSM_GROUPS)
    y = y * lax.rsqrt(jnp.mean(y * y, axis=-1, keepdims=True) + EPS)
    y = (y.reshape(b, s, SSM_D_INNER) * norm_g.astype(jnp.float32)).astype(h.dtype)
    return y @ out_w


def t5_causal_bucket(dist):
    max_exact = REL_BUCKETS // 2
    d = jnp.maximum(dist, 1).astype(jnp.float32)
    large = max_exact + (jnp.log(d / max_exact) / math.log(REL_MAX_DIST / max_exact)
                         * (REL_BUCKETS - max_exact)).astype(jnp.int32)
    large = jnp.minimum(large, REL_BUCKETS - 1)
    return jnp.where(dist < max_exact, dist, large)


def head_rms(x, g):
    xf = x.astype(jnp.float32)
    return xf * lax.rsqrt(jnp.mean(xf * xf, axis=-1, keepdims=True) + EPS) * g.astype(jnp.float32)


def swa_mixer(h, qkv_w, q_norm_g, k_norm_g, sinks, rel_bias, out_w):
    b, s, _ = h.shape
    nb = s // WINDOW
    qkv = h @ qkv_w
    q_end = ATTN_Q_HEADS * ATTN_HEAD_DIM
    k_end = q_end + ATTN_KV_HEADS * ATTN_HEAD_DIM
    q = head_rms(qkv[..., :q_end].reshape(b, s, ATTN_KV_HEADS, ATTN_Q_PER_KV, ATTN_HEAD_DIM), q_norm_g)
    k = head_rms(qkv[..., q_end:k_end].reshape(b, s, ATTN_KV_HEADS, ATTN_HEAD_DIM), k_norm_g)
    v = qkv[..., k_end:].reshape(b, s, ATTN_KV_HEADS, ATTN_HEAD_DIM).astype(jnp.float32)
    qb = q.reshape(b, nb, WINDOW, ATTN_KV_HEADS, ATTN_Q_PER_KV, ATTN_HEAD_DIM)
    kb = k.reshape(b, nb, WINDOW, ATTN_KV_HEADS, ATTN_HEAD_DIM)
    vb = v.reshape(b, nb, WINDOW, ATTN_KV_HEADS, ATTN_HEAD_DIM)
    pad = ((0, 0), (1, 0), (0, 0), (0, 0), (0, 0))
    kk = jnp.concatenate([jnp.pad(kb, pad)[:, :-1], kb], axis=2)
    vv = jnp.concatenate([jnp.pad(vb, pad)[:, :-1], vb], axis=2)
    scores = jnp.einsum("bnqgrd,bnkgd->bngrqk", qb, kk) * (ATTN_HEAD_DIM ** -0.5)
    qi = jnp.arange(WINDOW)[:, None]
    kj = jnp.arange(2 * WINDOW)[None, :]
    dist = qi + WINDOW - kj
    in_band = (dist >= 0) & (dist < WINDOW)
    key_pos = jnp.arange(nb)[:, None, None] * WINDOW + kj[None] - WINDOW
    valid = in_band[None] & (key_pos >= 0)
    bias = rel_bias.astype(jnp.float32)[t5_causal_bucket(jnp.maximum(dist, 0))]
    bias = bias.transpose(2, 0, 1).reshape(ATTN_KV_HEADS, ATTN_Q_PER_KV, WINDOW, 2 * WINDOW)
    scores = jnp.where(valid[None, :, None, None], scores + bias[None, None], -jnp.inf)
    sink = sinks.astype(jnp.float32).reshape(ATTN_KV_HEADS, ATTN_Q_PER_KV)[None, None, :, :, None, None]
    m = jnp.maximum(jnp.max(scores, axis=-1, keepdims=True), sink)
    p = jnp.exp(scores - m)
    probs = p / (jnp.sum(p, axis=-1, keepdims=True) + jnp.exp(sink - m))
    out = jnp.einsum("bngrqk,bnkgd->bnqgrd", probs, vv)
    out = out.reshape(b, s, ATTN_Q_HEADS * ATTN_HEAD_DIM).astype(h.dtype)
    return out @ out_w


def clamped_swiglu(hb):
    x_glu = jnp.minimum(hb[..., ::2], SWIGLU_LIMIT)
    x_lin = jnp.clip(hb[..., 1::2], -SWIGLU_LIMIT, SWIGLU_LIMIT)
    return x_glu * jax.nn.sigmoid(SWIGLU_ALPHA * x_glu) * (x_lin + 1)


def moe(h, r_w, r_b, w1, b1, w2, b2):
    b, s, d = h.shape
    T = b * s
    xt = h.reshape(T, d)
    logits = (xt @ r_w + r_b).astype(jnp.float32)
    top_val, top_idx = lax.top_k(logits, TOP_K)
    gates = jax.nn.softmax(top_val, axis=-1)
    n_assign = T * TOP_K
    e_flat = top_idx.reshape(-1)
    tok_flat = jnp.arange(n_assign, dtype=jnp.int32) // TOP_K
    order = jnp.argsort(e_flat)
    sorted_e = e_flat[order]
    sorted_tok = tok_flat[order]
    sorted_g = gates.reshape(-1)[order]
    counts = jnp.bincount(e_flat, length=N_EXPERTS)
    padded = ((counts + MOE_BLOCK - 1) // MOE_BLOCK) * MOE_BLOCK
    pend = jnp.cumsum(padded)
    pstart = pend - padded
    ustart = jnp.cumsum(counts) - counts
    pos = pstart[sorted_e] + (jnp.arange(n_assign, dtype=jnp.int32) - ustart[sorted_e])
    cap = n_assign + N_EXPERTS * MOE_BLOCK
    n_blk = cap // MOE_BLOCK
    tok_pad = jnp.full((cap,), T, jnp.int32).at[pos].set(sorted_tok)
    gate_pad = jnp.zeros((cap,), jnp.float32).at[pos].set(sorted_g)
    blk_start = jnp.arange(n_blk, dtype=jnp.int32) * MOE_BLOCK
    blk_e = jnp.minimum(jnp.sum(blk_start[:, None] >= pend[None, :], axis=1), N_EXPERTS - 1)
    x_ext = jnp.concatenate([xt, jnp.zeros((1, d), xt.dtype)], axis=0)
    xg = x_ext[tok_pad].reshape(n_blk, MOE_BLOCK, d)

    def expert_block(args):
        xb, e = args
        hb = clamped_swiglu(xb @ w1[e] + b1[e])
        return hb @ w2[e] + b2[e]

    yg = lax.map(expert_block, (xg, blk_e)).reshape(cap, d)
    yg = yg * gate_pad[:, None].astype(yg.dtype)
    out = jnp.zeros((T + 1, d), yg.dtype).at[tok_pad].add(yg)
    return out[:T].reshape(b, s, d)


def setup_inputs(seed: int = 0) -> dict:
    key = jax.random.key(seed)
    ks = jax.random.split(key, 32)
    f32 = jnp.float32

    def nrm(k, shape, scale):
        return jax.random.normal(k, shape, f32) * scale

    dt0 = jnp.exp(jax.random.uniform(ks[9], (N_SSM_LAYERS, SSM_HEADS), f32,
                                     minval=math.log(1e-3), maxval=math.log(1e-1)))
    return {
        "x": nrm(ks[0], (BATCH, SEQ, D_MODEL), 1.0),
        "c": nrm(ks[1], (BATCH, D_MODEL), 1.0),
        "ada_w": nrm(ks[2], (DEPTH, D_MODEL, 6 * D_MODEL), 0.01),
        "ada_b": nrm(ks[3], (DEPTH, 6 * D_MODEL), 0.01),
        "norm1_g": 1.0 + nrm(ks[4], (DEPTH, D_MODEL), 0.02),
        "norm2_g": 1.0 + nrm(ks[5], (DEPTH, D_MODEL), 0.02),
        "m_in_w": nrm(ks[6], (N_SSM_LAYERS, D_MODEL, SSM_IN_DIM), D_MODEL ** -0.5),
        "m_conv_w": nrm(ks[7], (N_SSM_LAYERS, SSM_CONV, SSM_CONV_DIM), SSM_CONV ** -0.5),
        "m_conv_b": nrm(ks[8], (N_SSM_LAYERS, SSM_CONV_DIM), 0.02),
        "m_dt_bias": dt0 + jnp.log(-jnp.expm1(-dt0)),
        "m_A_log": jnp.log(jax.random.uniform(ks[10], (N_SSM_LAYERS, SSM_HEADS), f32, minval=1.0, maxval=16.0)),
        "m_D": 1.0 + nrm(ks[11], (N_SSM_LAYERS, SSM_HEADS), 0.1),
        "m_norm_g": 1.0 + nrm(ks[12], (N_SSM_LAYERS, SSM_D_INNER), 0.02),
        "m_out_w": nrm(ks[13], (N_SSM_LAYERS, SSM_D_INNER, D_MODEL), SSM_D_INNER ** -0.5),
        "a_qkv_w": nrm(ks[14], (N_ATTN_LAYERS, D_MODEL, ATTN_QKV_DIM), D_MODEL ** -0.5),
        "a_q_norm_g": 1.0 + nrm(ks[15], (N_ATTN_LAYERS, ATTN_HEAD_DIM), 0.02),
        "a_k_norm_g": 1.0 + nrm(ks[16], (N_ATTN_LAYERS, ATTN_HEAD_DIM), 0.02),
        "a_sinks": nrm(ks[17], (N_ATTN_LAYERS, ATTN_Q_HEADS), 0.5),
        "a_out_w": nrm(ks[18], (N_ATTN_LAYERS, ATTN_Q_HEADS * ATTN_HEAD_DIM, D_MODEL),
                        (ATTN_Q_HEADS * ATTN_HEAD_DIM) ** -0.5),
        "rel_bias": nrm(ks[19], (REL_BUCKETS, ATTN_Q_HEADS), 0.5),
        "r_w": nrm(ks[20], (DEPTH, D_MODEL, N_EXPERTS), D_MODEL ** -0.5),
        "r_b": nrm(ks[21], (DEPTH, N_EXPERTS), 0.01),
        "e_w1": nrm(ks[22], (DEPTH, N_EXPERTS, D_MODEL, 2 * EXPERT_FF), D_MODEL ** -0.5),
        "e_b1": nrm(ks[23], (DEPTH, N_EXPERTS, 2 * EXPERT_FF), 0.01),
        "e_w2": nrm(ks[24], (DEPTH, N_EXPERTS, EXPERT_FF, D_MODEL), EXPERT_FF ** -0.5),
        "e_b2": nrm(ks[25], (DEPTH, N_EXPERTS, D_MODEL), 0.01),
    }


def reference(x, c, ada_w, ada_b, norm1_g, norm2_g, m_in_w, m_conv_w, m_conv_b, m_dt_bias, m_A_log, m_D,
              m_norm_g, m_out_w, a_qkv_w, a_q_norm_g, a_k_norm_g, a_sinks, a_out_w, rel_bias,
              r_w, r_b, e_w1, e_b1, e_w2, e_b2):
    c_act = jax.nn.silu(c)
    for i in range(DEPTH):
        mod = c_act @ ada_w[i] + ada_b[i]
        sh1, sc1, g1, sh2, sc2, g2 = jnp.split(mod, 6, axis=-1)
        h = modulate(x, norm1_g[i], sh1, sc1)
        j = i // N_MIXERS
        if i % N_MIXERS == 0:
            y = mamba2_mixer(h, m_in_w[j], m_conv_w[j], m_conv_b[j], m_dt_bias[j], m_A_log[j], m_D[j],
                             m_norm_g[j], m_out_w[j])
        else:
            y = swa_mixer(h, a_qkv_w[j], a_q_norm_g[j], a_k_norm_g[j], a_sinks[j], rel_bias, a_out_w[j])
        x = x + g1[:, None, :] * y
        h = modulate(x, norm2_g[i], sh2, sc2)
        x = x + g2[:, None, :] * moe(h, r_w[i], r_b[i], e_w1[i], e_b1[i], e_w2[i], e_b2[i])
    return x
```

```cpp
#include <hip/hip_runtime.h>
#include <cstdio>
#include <cstdint>

#define GAS __attribute__((address_space(1)))
#define LAS __attribute__((address_space(3)))
typedef unsigned short bf16;
typedef unsigned v4u __attribute__((ext_vector_type(4)));
typedef unsigned v2u __attribute__((ext_vector_type(2)));
typedef float f32x4 __attribute__((ext_vector_type(4)));
typedef short bf16x8 __attribute__((ext_vector_type(8)));
typedef short v4i16_t __attribute__((ext_vector_type(4)));
typedef GAS unsigned gu32;

namespace pg8 {
#define PG8_LAS __attribute__((address_space(3)))
typedef unsigned short bf16_t;
typedef unsigned u32x4 __attribute__((ext_vector_type(4)));
typedef int i32x4 __attribute__((ext_vector_type(4)));
constexpr int BM = 256, BK = 64, HALF = 128, HTB = HALF * BK * 2, STAGE_BYTES = 8 * HTB, NXCD = 8, WGM = 8;
__host__ __device__ __forceinline__ int lds_byte(int r, int c) { const int st = (r >> 4) * 2 + (c >> 5), rr = r & 15, cc = c & 31, ob = rr * 64 + cc * 2; return st * 1024 + (ob ^ (((ob >> 9) & 1) << 5)); }
__host__ __device__ __forceinline__ void stage_rc(int b, int& R, int& C) { const int st = b / 1024, sb = b % 1024, swz = sb ^ (((sb >> 9) & 1) << 5); R = (st >> 1) * 16 + swz / 64; C = (st & 1) * 32 + (swz % 64) / 2; }
__host__ __device__ __forceinline__ int perm32(int rho) { const int n = rho >> 4, i = rho & 15; return 8 * (i >> 2) + 4 * n + (i & 3); }
struct Unit { int pm, pn; };
struct Gemm { const bf16_t* A; const bf16_t* Bt; int M, N, K; };
struct StaticOrder {
    int nM, nN, nwg, G, c;
    __host__ __device__ void init(int M, int N, int G_, int c_) { nM = M / BM; nN = N / BM; nwg = nM * nN; G = G_; c = c_; }
    __host__ __device__ bool next(int i, Unit& u) const {
        const long L = (long)i * G + c; if (L >= nwg) return false;
        int wgid = (int)L; { const int q = nwg / NXCD, r = nwg % NXCD, xcd = wgid % NXCD, off = wgid / NXCD; wgid = (xcd < r ? xcd * (q + 1) : r * (q + 1) + (xcd - r) * q) + off; }
        const int nig = WGM * nN, gid = wgid / nig, fm = gid * WGM, gsz = (nM - fm) < WGM ? (nM - fm) : WGM;
        u.pm = fm + ((wgid % nig) % gsz); u.pn = (wgid % nig) / gsz; return true;
    }
    static constexpr bool GATHER = false; const int* rowoff = nullptr; PG8_LAS int* rowt = nullptr;
    __device__ __forceinline__ void a_ready(const Unit&) const {}
    __device__ __forceinline__ void done(const Unit&) const {}
};
template <bool GATHER_> struct MoeOrderT {
    static constexpr bool GATHER = GATHER_;
    int ntiles, NT, G, c; const volatile PG8_LAS int* te; const int* rowoff; PG8_LAS int* rowt;
    __device__ bool next(int i, Unit& u) const {
        const int L = i * G + c; if (L >= ntiles * NT) return false;
        const int tile = L / NT, n = L % NT; const int e = __builtin_amdgcn_readfirstlane(te[tile]);
        u.pm = tile; u.pn = e * NT + n; return true;
    }
    __device__ __forceinline__ void a_ready(const Unit&) const {}
    __device__ __forceinline__ void done(const Unit&) const {}
};
typedef MoeOrderT<false> MoeOrder; typedef MoeOrderT<true> MoeGatherOrder;
__device__ __forceinline__ unsigned cvt_pk_bf16(float lo, float hi) { unsigned r; asm volatile("v_cvt_pk_bf16_f32 %0, %1, %2" : "=v"(r) : "v"(lo), "v"(hi)); return r; }

struct EpiBf16 {
    static constexpr bool PERM = true, AFTER_DRAIN = false; static constexpr int MODE = 0; typedef f32x4 acc_t;
    bf16_t* O; int ldc;
    __device__ __forceinline__ void operator()(const f32x4 (&acc)[2][2][4][2], const Unit& u, int wr, int wc, int fr, int fq) const {
        const int row0 = u.pm * BM + wr * 64 + fr, col0 = u.pn * BM + wc * 32 + 8 * fq;
#pragma unroll
        for (int ai = 0; ai < 2; ++ai)
#pragma unroll
            for (int m = 0; m < 4; ++m) { bf16_t* rowp = O + (size_t)(row0 + ai * HALF + m * 16) * ldc + col0;
#pragma unroll
                for (int bj = 0; bj < 2; ++bj) { const f32x4 v0 = acc[ai][bj][m][0], v1 = acc[ai][bj][m][1];
                    u32x4 w; w.x = cvt_pk_bf16(v0[0], v0[1]); w.y = cvt_pk_bf16(v0[2], v0[3]); w.z = cvt_pk_bf16(v1[0], v1[1]); w.w = cvt_pk_bf16(v1[2], v1[3]);
                    *(u32x4*)(rowp + bj * HALF) = w; } }
    }
};
struct EpiResid {
    static constexpr bool PERM = true, AFTER_DRAIN = false; static constexpr int MODE = 0; typedef f32x4 acc_t;
    const float* res; float* out; const float* gate;
    __device__ __forceinline__ void operator()(const f32x4 (&acc)[2][2][4][2], const Unit& u, int wr, int wc, int fr, int fq) const {
        const int row0 = u.pm * BM + wr * 64 + fr, col0 = u.pn * BM + wc * 32 + 8 * fq; const int b = (u.pm * BM) >> 13;
        f32x4 gv[2][2];
#pragma unroll
        for (int bj = 0; bj < 2; ++bj)
#pragma unroll
            for (int n = 0; n < 2; ++n) gv[bj][n] = *(const f32x4*)(gate + b * 1024 + col0 + bj * HALF + 4 * n);
#pragma unroll
        for (int ai = 0; ai < 2; ++ai)
#pragma unroll
            for (int m = 0; m < 4; ++m) { const size_t off = (size_t)(row0 + ai * HALF + m * 16) * 1024 + col0;
#pragma unroll
                for (int bj = 0; bj < 2; ++bj)
#pragma unroll
                    for (int n = 0; n < 2; ++n) { const f32x4 r4 = *(const f32x4*)(res + off + bj * HALF + 4 * n);
                        *(f32x4*)(out + off + bj * HALF + 4 * n) = r4 + gv[bj][n] * acc[ai][bj][m][n]; } }
    }
};
struct EpiSwiglu {
    static constexpr bool PERM = true, AFTER_DRAIN = false; static constexpr int MODE = 0; typedef f32x4 acc_t;
    bf16_t* act; const float* b1;
    __device__ __forceinline__ void operator()(const f32x4 (&acc)[2][2][4][2], const Unit& u, int wr, int wc, int fr, int fq) const {
        const int row0 = u.pm * BM + wr * 64 + fr; const int e = u.pn >> 3, ntile = u.pn & 7;
        const int c0 = ntile * BM + wc * 32 + 8 * fq;
        f32x4 bv[2][2];
#pragma unroll
        for (int bj = 0; bj < 2; ++bj)
#pragma unroll
            for (int n = 0; n < 2; ++n) bv[bj][n] = *(const f32x4*)(b1 + e * 2048 + c0 + bj * HALF + 4 * n);
#pragma unroll
        for (int ai = 0; ai < 2; ++ai)
#pragma unroll
            for (int m = 0; m < 4; ++m) { bf16_t* rowp = act + (size_t)(row0 + ai * HALF + m * 16) * 1024 + (c0 >> 1);
#pragma unroll
                for (int bj = 0; bj < 2; ++bj) { const f32x4 v0 = acc[ai][bj][m][0] + bv[bj][0], v1 = acc[ai][bj][m][1] + bv[bj][1];
                    float o[4];
                    const float g[4] = {v0[0], v0[2], v1[0], v1[2]}, l[4] = {v0[1], v0[3], v1[1], v1[3]};
#pragma unroll
                    for (int t = 0; t < 4; ++t) { const float xg = fminf(g[t], 7.0f), xl = fminf(fmaxf(l[t], -7.0f), 7.0f);
                        o[t] = xg * __builtin_amdgcn_rcpf(1.0f + __expf(-1.702f * xg)) * (xl + 1.0f); }
                    v2u w; w.x = cvt_pk_bf16(o[0], o[1]); w.y = cvt_pk_bf16(o[2], o[3]);
                    *(v2u*)(rowp + bj * (HALF / 2)) = w; } }
    }
};
struct EpiMoeOut {
    static constexpr bool PERM = true, AFTER_DRAIN = false; static constexpr int MODE = 0; typedef f32x4 acc_t;
    bf16_t* yk; const float* b2; const int* srt_tok; const float* srt_gate;
    __device__ __forceinline__ void operator()(const f32x4 (&acc)[2][2][4][2], const Unit& u, int wr, int wc, int fr, int fq) const {
        const int row0 = u.pm * BM + wr * 64 + fr; const int e = u.pn >> 2, ntile = u.pn & 3;
        const int c0 = ntile * BM + wc * 32 + 8 * fq;
        f32x4 bv[2][2];
#pragma unroll
        for (int bj = 0; bj < 2; ++bj)
#pragma unroll
            for (int n = 0; n < 2; ++n) bv[bj][n] = *(const f32x4*)(b2 + e * 1024 + c0 + bj * HALF + 4 * n);
#pragma unroll
        for (int ai = 0; ai < 2; ++ai)
#pragma unroll
            for (int m = 0; m < 4; ++m) { const int pos = row0 + ai * HALF + m * 16; const int id = srt_tok[pos]; const float gt = srt_gate[pos];
                if (id >= 0) { bf16_t* rowp = yk + (size_t)id * 1024 + c0;
#pragma unroll
                    for (int bj = 0; bj < 2; ++bj) { const f32x4 v0 = (acc[ai][bj][m][0] + bv[bj][0]) * gt, v1 = (acc[ai][bj][m][1] + bv[bj][1]) * gt;
                        u32x4 w; w.x = cvt_pk_bf16(v0[0], v0[1]); w.y = cvt_pk_bf16(v0[2], v0[3]); w.z = cvt_pk_bf16(v1[0], v1[1]); w.w = cvt_pk_bf16(v1[2], v1[3]);
                        *(u32x4*)(rowp + bj * HALF) = w; } } }
    }
};

struct EpiBf16Q {
    static constexpr bool PERM = true, AFTER_DRAIN = false; static constexpr int MODE = 1; typedef i32x4 acc_t;
    bf16_t* O; int ldc; const float* sa; const float* sb;
    __device__ __forceinline__ void operator()(const i32x4 (&acc)[2][2][4][2], const Unit& u, int wr, int wc, int fr, int fq) const {
        const int row0 = u.pm * BM + wr * 64 + fr, col0 = u.pn * BM + wc * 32 + 8 * fq;
        f32x4 sv[2][2];
#pragma unroll
        for (int bj = 0; bj < 2; ++bj)
#pragma unroll
            for (int n = 0; n < 2; ++n) sv[bj][n] = *(const f32x4*)(sb + col0 + bj * HALF + 4 * n);
#pragma unroll
        for (int ai = 0; ai < 2; ++ai)
#pragma unroll
            for (int m = 0; m < 4; ++m) { const int row = row0 + ai * HALF + m * 16; const float s = sa[row]; bf16_t* rowp = O + (size_t)row * ldc + col0;
#pragma unroll
                for (int bj = 0; bj < 2; ++bj) { const f32x4 v0 = __builtin_convertvector(acc[ai][bj][m][0], f32x4) * (sv[bj][0] * s), v1 = __builtin_convertvector(acc[ai][bj][m][1], f32x4) * (sv[bj][1] * s);
                    u32x4 w; w.x = cvt_pk_bf16(v0[0], v0[1]); w.y = cvt_pk_bf16(v0[2], v0[3]); w.z = cvt_pk_bf16(v1[0], v1[1]); w.w = cvt_pk_bf16(v1[2], v1[3]);
                    *(u32x4*)(rowp + bj * HALF) = w; } }
    }
};
__device__ __forceinline__ void xpose4(unsigned& r0, unsigned& r1, unsigned& r2, unsigned& r3) {
    { const auto t = __builtin_amdgcn_permlane32_swap(r0, r2, false, false); r0 = t[0]; r2 = t[1]; }
    { const auto t = __builtin_amdgcn_permlane32_swap(r1, r3, false, false); r1 = t[0]; r3 = t[1]; }
    { const auto t = __builtin_amdgcn_permlane16_swap(r0, r1, false, false); r0 = t[0]; r1 = t[1]; }
    { const auto t = __builtin_amdgcn_permlane16_swap(r2, r3, false, false); r2 = t[0]; r3 = t[1]; }
}
struct EpiSwigluQ {
    static constexpr bool PERM = true, AFTER_DRAIN = false; static constexpr int MODE = 1; typedef i32x4 acc_t;
    unsigned char* act; const float* b1; const float* sa; const float* sb;
    __device__ __forceinline__ void operator()(const i32x4 (&acc)[2][2][4][2], const Unit& u, int wr, int wc, int fr, int fq) const {
        const int row0 = u.pm * BM + wr * 64 + fr; const int e = u.pn >> 3, ntile = u.pn & 7;
        const int c0 = ntile * BM + wc * 32 + 8 * fq;
        f32x4 bv[2][2], sv[2][2];
#pragma unroll
        for (int bj = 0; bj < 2; ++bj)
#pragma unroll
            for (int n = 0; n < 2; ++n) { bv[bj][n] = *(const f32x4*)(b1 + e * 2048 + c0 + bj * HALF + 4 * n); sv[bj][n] = *(const f32x4*)(sb + e * 2048 + c0 + bj * HALF + 4 * n); }
#pragma unroll
        for (int ai = 0; ai < 2; ++ai) { unsigned w[2][4];
#pragma unroll
            for (int m = 0; m < 4; ++m) { const int row = row0 + ai * HALF + m * 16; const float s = sa[row];
#pragma unroll
                for (int bj = 0; bj < 2; ++bj) { const f32x4 v0 = __builtin_convertvector(acc[ai][bj][m][0], f32x4) * (sv[bj][0] * s) + bv[bj][0], v1 = __builtin_convertvector(acc[ai][bj][m][1], f32x4) * (sv[bj][1] * s) + bv[bj][1];
                    float o[4];
                    const float g[4] = {v0[0], v0[2], v1[0], v1[2]}, l[4] = {v0[1], v0[3], v1[1], v1[3]};
#pragma unroll
                    for (int t = 0; t < 4; ++t) { const float xg = fminf(g[t], 7.0f), xl = fminf(fmaxf(l[t], -7.0f), 7.0f);
                        const float tg = xg * __builtin_amdgcn_rcpf(1.0f + __builtin_amdgcn_exp2f(xg * -2.4554669595930156f)); o[t] = __builtin_fmaf(tg, xl, tg); }
                    int wv = __builtin_amdgcn_cvt_pk_fp8_f32(o[0], o[1], 0, false); wv = __builtin_amdgcn_cvt_pk_fp8_f32(o[2], o[3], wv, true);
                    w[bj][m] = (unsigned)wv; } }
            unsigned char* rowp = act + (size_t)(row0 + ai * HALF + 16 * fq) * 1024 + ((ntile * BM + wc * 32) >> 1);
#pragma unroll
            for (int bj = 0; bj < 2; ++bj) { xpose4(w[bj][0], w[bj][1], w[bj][2], w[bj][3]);
                u32x4 o4; o4.x = w[bj][0]; o4.y = w[bj][1]; o4.z = w[bj][2]; o4.w = w[bj][3];
                *(u32x4*)(rowp + bj * (HALF / 2)) = o4; } }
    }
};
struct EpiMoeOutF8 {
    static constexpr bool PERM = true, AFTER_DRAIN = false; static constexpr int MODE = 2; typedef f32x4 acc_t;
    unsigned char* yk; const float* b2; const float* sb; const int* srt_tok; const float* srt_gate;
    __device__ __forceinline__ void operator()(const f32x4 (&acc)[2][2][4][2], const Unit& u, int wr, int wc, int fr, int fq) const {
        const int row0 = u.pm * BM + wr * 64 + fr; const int e = u.pn >> 2, ntile = u.pn & 3;
        const int c0 = ntile * BM + wc * 32 + 8 * fq;
#pragma unroll
        for (int bj = 0; bj < 2; ++bj) { f32x4 bv[2], sv[2];
#pragma unroll
            for (int n = 0; n < 2; ++n) { bv[n] = *(const f32x4*)(b2 + e * 1024 + c0 + bj * HALF + 4 * n); sv[n] = *(const f32x4*)(sb + e * 1024 + c0 + bj * HALF + 4 * n); }
#pragma unroll
            for (int ai = 0; ai < 2; ++ai)
#pragma unroll
                for (int m = 0; m < 4; ++m) { const int pos = row0 + ai * HALF + m * 16; const int id = srt_tok[pos]; const float gt = srt_gate[pos];
                    if (id >= 0) { const f32x4 v0 = (acc[ai][bj][m][0] * sv[0] + bv[0]) * gt, v1 = (acc[ai][bj][m][1] * sv[1] + bv[1]) * gt;
                        int w0 = __builtin_amdgcn_cvt_pk_fp8_f32(v0[0], v0[1], 0, false); w0 = __builtin_amdgcn_cvt_pk_fp8_f32(v0[2], v0[3], w0, true);
                        int w1 = __builtin_amdgcn_cvt_pk_fp8_f32(v1[0], v1[1], 0, false); w1 = __builtin_amdgcn_cvt_pk_fp8_f32(v1[2], v1[3], w1, true);
                        v2u w; w.x = (unsigned)w0; w.y = (unsigned)w1;
                        *(v2u*)(yk + (size_t)id * 1024 + c0 + bj * HALF) = w; } }
            asm volatile("" ::: "memory"); }
    }
};


typedef int i32x8 __attribute__((ext_vector_type(8)));
struct Frag2 { bf16x8 h[2]; };
template <int MODE> struct FragOps { typedef Frag2 frag_t;
    static __device__ __forceinline__ Frag2 load(const PG8_LAS unsigned char* p) { Frag2 f; f.h[0] = *(const PG8_LAS bf16x8*)p; f.h[1] = *(const PG8_LAS bf16x8*)(p + 1024); return f; } };
template <> struct FragOps<2> { typedef i32x8 frag_t;
    static __device__ __forceinline__ i32x8 load(const PG8_LAS unsigned char* p) { const i32x4 lo = *(const PG8_LAS i32x4*)p, hi = *(const PG8_LAS i32x4*)(p + 1024); return __builtin_shufflevector(lo, hi, 0, 1, 2, 3, 4, 5, 6, 7); } };
template <int MODE> struct Mma;
template <> struct Mma<0> { static __device__ __forceinline__ f32x4 run(const Frag2& a, const Frag2& b, f32x4 c) { c = __builtin_amdgcn_mfma_f32_16x16x32_bf16(a.h[0], b.h[0], c, 0, 0, 0); return __builtin_amdgcn_mfma_f32_16x16x32_bf16(a.h[1], b.h[1], c, 0, 0, 0); } };
template <> struct Mma<1> { static __device__ __forceinline__ i32x4 run(const Frag2& a, const Frag2& b, i32x4 c) { c = __builtin_amdgcn_mfma_i32_16x16x64_i8(__builtin_bit_cast(i32x4, a.h[0]), __builtin_bit_cast(i32x4, b.h[0]), c, 0, 0, 0);
        return __builtin_amdgcn_mfma_i32_16x16x64_i8(__builtin_bit_cast(i32x4, a.h[1]), __builtin_bit_cast(i32x4, b.h[1]), c, 0, 0, 0); } };
template <> struct Mma<2> { static __device__ __forceinline__ f32x4 run(const i32x8& a, const i32x8& b, f32x4 c) {
        asm volatile("v_mfma_scale_f32_16x16x128_f8f6f4 %0, %1, %2, %0, %3, %3 op_sel_hi:[0,0,0]" : "+v"(c) : "v"(a), "v"(b), "v"(0x7F7F7F7F)); return c; } };

template <class Epi, class Sched, bool ALIGN_EPI = false, bool SP2 = false>
__device__ __forceinline__ void gemm_phase(PG8_LAS unsigned char* lds, const Gemm g, const Sched& S, const Epi& E) {
    const int tid = threadIdx.x, wid = __builtin_amdgcn_readfirstlane(tid >> 6), lane = tid & 63, wr = wid >> 2, wc = wid & 3, fr = lane & 15, fq = lane >> 4;
    constexpr int MODE = Epi::MODE; typedef typename Epi::acc_t acc_t;
    const int rowb = MODE ? g.K : g.K * 2, nt = rowb / (BK * 2);
    unsigned voffA[2], voffB[2];
#pragma unroll
    for (int i = 0; i < 2; ++i) { int R, C; stage_rc(tid * 16 + i * 8192, R, C); const int Rb = Epi::PERM ? ((R & ~31) + perm32(R & 31)) : R;
        voffA[i] = (unsigned)(R * rowb + C * 2); voffB[i] = (unsigned)(Rb * rowb + C * 2); }
    const size_t kstep = (size_t)(BK * 2);
    const size_t hstep = (size_t)HALF * rowb;
    const size_t tstep = 2 * hstep;
    const unsigned ldsw = (unsigned)wid * 1024u;
    const int aoff = lds_byte(wr * 64 + fr, fq * 8), boff = lds_byte(wc * 32 + fr, fq * 8);
    constexpr bool GATHER = Sched::GATHER;
    int gR[2]; unsigned gC[2]; unsigned gA[2][2], gN[2][2];
#pragma unroll
    for (int i = 0; i < 2; ++i) { int R, C; stage_rc(tid * 16 + i * 8192, R, C); gR[i] = R; gC[i] = (unsigned)(C * 2);
#pragma unroll
        for (int h = 0; h < 2; ++h) { gA[h][i] = 0u; gN[h][i] = 0u; } }
#define PG8_SA(b, h) (((b) * 2 + (h)) * HTB)
#define PG8_SB(b, h) ((4 + (b) * 2 + (h)) * HTB)
#define PG8_STAGE(bufoff, gbase, voff) do { _Pragma("unroll") for (int _i = 0; _i < 2; ++_i) \
        __builtin_amdgcn_global_load_lds((const unsigned*)((const char*)(gbase) + (voff)[_i]), (PG8_LAS unsigned*)(lds + (bufoff) + ldsw + _i * 8192), 16, 0, 0); } while (0)
#define PG8_STA(bufoff, h, nxsel, kb) do { if constexpr (GATHER) { unsigned o_[2] = {(nxsel) ? gN[h][0] : gA[h][0], (nxsel) ? gN[h][1] : gA[h][1]}; PG8_STAGE(bufoff, (const char*)g.A + (kb), o_); } \
        else { PG8_STAGE(bufoff, ((nxsel) ? nA : cA) + (size_t)(h) * hstep + (kb), voffA); } } while (0)
#define PG8_ROWT_ISSUE(slot, pm) do { if constexpr (GATHER) { if (wid < 4) __builtin_amdgcn_global_load_lds((const unsigned*)(S.rowoff + (size_t)(pm) * BM + wid * 64 + lane), (PG8_LAS unsigned*)(S.rowt + (slot) * 256 + wid * 64), 4, 0, 0); } } while (0)
#define PG8_ROWT_READ(dst, slot) do { if constexpr (GATHER) { _Pragma("unroll") for (int h_ = 0; h_ < 2; ++h_) _Pragma("unroll") for (int i_ = 0; i_ < 2; ++i_) dst[h_][i_] = (unsigned)S.rowt[(slot) * 256 + h_ * HALF + gR[i_]] + gC[i_]; } } while (0)
#define PG8_LDA(dst, b, h) do { _Pragma("unroll") for (int m = 0; m < 4; ++m) dst[m] = FragOps<MODE>::load(lds + PG8_SA(b, h) + aoff + m * 2048); } while (0)
#define PG8_LDB(dst, b, h) do { _Pragma("unroll") for (int n = 0; n < 2; ++n) dst[n] = FragOps<MODE>::load(lds + PG8_SB(b, h) + boff + n * 2048); } while (0)
#define PG8_MMA(ai, bj, At, Bt) do { __builtin_amdgcn_s_setprio(1); _Pragma("unroll") for (int m = 0; m < 4; ++m) _Pragma("unroll") for (int n = 0; n < 2; ++n) \
        acc[ai][bj][m][n] = Mma<MODE>::run(Bt[n], At[m], acc[ai][bj][m][n]); __builtin_amdgcn_s_setprio(0); } while (0)
#define PG8_WAIT_V(n) asm volatile("s_waitcnt vmcnt(" #n ")" ::: "memory")
#define PG8_WAIT_L(n) asm volatile("s_waitcnt lgkmcnt(" #n ")" ::: "memory")
#define PG8_BAR __builtin_amdgcn_s_barrier()
#define PG8_SCHED __builtin_amdgcn_sched_barrier(0)
    Unit cur, nxt; int ui = 0;
    if (!S.next(0, cur)) return;
    acc_t acc[2][2][4][2];
#pragma unroll
    for (int a = 0; a < 2; ++a)
#pragma unroll
        for (int b = 0; b < 2; ++b)
#pragma unroll
            for (int m = 0; m < 4; ++m)
#pragma unroll
                for (int n = 0; n < 2; ++n) acc[a][b][m][n] = (acc_t)0;
    typename FragOps<MODE>::frag_t At[4], B0[2], B1[2];
    const char* cA = (const char*)g.A + (size_t)cur.pm * tstep; const char* cB = (const char*)g.Bt + (size_t)cur.pn * tstep; const char* nA = cA;
    S.a_ready(cur);
    if constexpr (GATHER) { PG8_ROWT_ISSUE(0, cur.pm); PG8_WAIT_V(0); __syncthreads(); PG8_ROWT_READ(gA, 0); PG8_WAIT_L(0); }
    if constexpr (SP2) {
        PG8_STAGE(PG8_SB(0, 0), cB, voffB); PG8_STAGE(PG8_SB(0, 1), cB + hstep, voffB); PG8_STA(PG8_SA(0, 0), 0, false, 0); PG8_STA(PG8_SA(0, 1), 1, false, 0);
        if (wr == 1) PG8_BAR;
        PG8_WAIT_V(2); PG8_BAR;
        PG8_STAGE(PG8_SB(1, 0), cB + kstep, voffB); PG8_STA(PG8_SA(1, 0), 0, false, kstep); PG8_STAGE(PG8_SB(1, 1), cB + hstep + kstep, voffB);
        PG8_WAIT_V(6); PG8_BAR;
    } else {
        PG8_STAGE(PG8_SB(0, 0), cB, voffB); PG8_STAGE(PG8_SA(0, 0), cA, voffA); PG8_STAGE(PG8_SB(0, 1), cB + hstep, voffB); PG8_STAGE(PG8_SA(0, 1), cA + hstep, voffA);
        if (wr == 1) PG8_BAR;
        PG8_WAIT_V(4); PG8_BAR;
        PG8_STAGE(PG8_SB(1, 0), cB + kstep, voffB); PG8_STAGE(PG8_SA(1, 0), cA + kstep, voffA); PG8_STAGE(PG8_SB(1, 1), cB + hstep + kstep, voffB);
        PG8_WAIT_V(6); PG8_BAR;
    }
    for (;;) {
        const bool has_next = S.next(ui + 1, nxt);
        nA = has_next ? (const char*)g.A + (size_t)nxt.pm * tstep : cA; const char* nB = has_next ? (const char*)g.Bt + (size_t)nxt.pn * tstep : cB;
        if (has_next) PG8_ROWT_ISSUE((ui + 1) & 1, nxt.pm);
#pragma unroll 1
        for (int t = 0; t < nt; t += 2) {
            const bool last = (t == nt - 2);
            const char* a1 = cA + (size_t)(t + 1) * kstep;
            const char* a2 = last ? nA : cA + (size_t)(t + 2) * kstep; const char* b2 = last ? nB : cB + (size_t)(t + 2) * kstep;
            const char* a3 = a2 + kstep; const char* b3 = b2 + kstep;
            const size_t kb1 = (size_t)(t + 1) * kstep, kb2 = last ? 0 : (size_t)(t + 2) * kstep, kb3 = kb2 + kstep;
            if (last && has_next) S.a_ready(nxt);
            if constexpr (GATHER) { if (last) { if (has_next) { PG8_ROWT_READ(gN, (ui + 1) & 1); } else {
#pragma unroll
                        for (int h_ = 0; h_ < 2; ++h_) { gN[h_][0] = gA[h_][0]; gN[h_][1] = gA[h_][1]; } } } }
            if constexpr (SP2) {
            PG8_LDB(B0, 0, 0); PG8_LDB(B1, 0, 1); PG8_SCHED; PG8_LDA(At, 0, 0); PG8_STA(PG8_SA(1, 1), 1, false, kb1);
            PG8_WAIT_V(8); PG8_WAIT_L(0); PG8_BAR; PG8_MMA(0, 0, At, B0); PG8_MMA(0, 1, At, B1); PG8_BAR; PG8_SCHED;
            PG8_LDA(At, 0, 1); PG8_STAGE(PG8_SB(0, 0), b2, voffB); PG8_STAGE(PG8_SB(0, 1), b2 + hstep, voffB); PG8_STA(PG8_SA(0, 0), 0, last, kb2);
            PG8_WAIT_V(8); PG8_WAIT_L(0); PG8_BAR; PG8_MMA(1, 0, At, B0); PG8_MMA(1, 1, At, B1); PG8_BAR; PG8_SCHED;
            PG8_LDB(B0, 1, 0); PG8_LDB(B1, 1, 1); PG8_SCHED; PG8_LDA(At, 1, 0); PG8_STA(PG8_SA(0, 1), 1, last, kb2);
            PG8_WAIT_V(8); PG8_WAIT_L(0); PG8_BAR; PG8_MMA(0, 0, At, B0); PG8_MMA(0, 1, At, B1); PG8_BAR; PG8_SCHED;
            PG8_LDA(At, 1, 1); PG8_STAGE(PG8_SB(1, 0), b3, voffB); PG8_STAGE(PG8_SB(1, 1), b3 + hstep, voffB); PG8_STA(PG8_SA(1, 0), 0, last, kb3);
            PG8_WAIT_V(8); PG8_WAIT_L(0); PG8_BAR; PG8_MMA(1, 0, At, B0); PG8_MMA(1, 1, At, B1); PG8_BAR; PG8_SCHED;
            } else {
            PG8_LDB(B0, 0, 0); PG8_SCHED; PG8_LDA(At, 0, 0); PG8_STAGE(PG8_SA(1, 1), a1 + hstep, voffA);
            PG8_WAIT_L(8); PG8_BAR; PG8_WAIT_L(0); PG8_MMA(0, 0, At, B0); PG8_BAR; PG8_SCHED;
            PG8_LDB(B1, 0, 1); PG8_STAGE(PG8_SB(0, 0), b2, voffB);
            PG8_BAR; PG8_WAIT_L(0); PG8_MMA(0, 1, At, B1); PG8_BAR;
            PG8_LDA(At, 0, 1); PG8_STAGE(PG8_SA(0, 0), a2, voffA);
            PG8_BAR; PG8_WAIT_L(0); PG8_MMA(1, 0, At, B0); PG8_BAR; PG8_SCHED;
            PG8_STAGE(PG8_SB(0, 1), b2 + hstep, voffB);
            PG8_WAIT_V(6); PG8_BAR; PG8_MMA(1, 1, At, B1); PG8_BAR;
            PG8_LDB(B0, 1, 0); PG8_SCHED; PG8_LDA(At, 1, 0); PG8_STAGE(PG8_SA(0, 1), a2 + hstep, voffA);
            PG8_WAIT_L(8); PG8_BAR; PG8_WAIT_L(0); PG8_MMA(0, 0, At, B0); PG8_BAR; PG8_SCHED;
            PG8_LDB(B1, 1, 1); PG8_STAGE(PG8_SB(1, 0), b3, voffB);
            PG8_BAR; PG8_WAIT_L(0); PG8_MMA(0, 1, At, B1); PG8_BAR;
            PG8_LDA(At, 1, 1); PG8_STAGE(PG8_SA(1, 0), a3, voffA);
            PG8_BAR; PG8_WAIT_L(0); PG8_MMA(1, 0, At, B0); PG8_BAR; PG8_SCHED;
            PG8_STAGE(PG8_SB(1, 1), b3 + hstep, voffB);
            PG8_WAIT_V(6); PG8_BAR; PG8_MMA(1, 1, At, B1); PG8_BAR;
            }
        }
        if constexpr (ALIGN_EPI) { if (wr == 0) PG8_BAR; }
        if constexpr (!Epi::AFTER_DRAIN) { E(acc, cur, wr, wc, fr, fq); S.done(cur); }
        if (!has_next) break;
#pragma unroll
        for (int a = 0; a < 2; ++a)
#pragma unroll
            for (int b = 0; b < 2; ++b)
#pragma unroll
                for (int m = 0; m < 4; ++m)
#pragma unroll
                    for (int n = 0; n < 2; ++n) acc[a][b][m][n] = (acc_t)0;
        cur = nxt; cA = nA; cB = nB; ++ui;
        if constexpr (GATHER) {
#pragma unroll
            for (int h_ = 0; h_ < 2; ++h_) { gA[h_][0] = gN[h_][0]; gA[h_][1] = gN[h_][1]; } }
        if constexpr (ALIGN_EPI) { if (wr == 1) PG8_BAR; }
    }
    PG8_WAIT_V(0);
    if constexpr (!ALIGN_EPI) { if (wr == 0) PG8_BAR; }
    PG8_BAR;
#undef PG8_SA
#undef PG8_SB
#undef PG8_STAGE
#undef PG8_STA
#undef PG8_ROWT_ISSUE
#undef PG8_ROWT_READ
#undef PG8_LDA
#undef PG8_LDB
#undef PG8_MMA
#undef PG8_WAIT_V
#undef PG8_WAIT_L
#undef PG8_BAR
#undef PG8_SCHED
}
}

constexpr int NWAVES = 8, NTHR = 512;
constexpr int BATCH = 2, SEQ = 8192, T = BATCH * SEQ, D = 1024;
constexpr int DI = 2048, SH = 32, HP = 64, NGRP = 4, NS = 128, CHK = 128, NCH = SEQ / CHK;
constexpr int IN_DIM = 5152, XW = 5120, XOFF = 2048, BOFF = 4096, COFF = 4608, CONVD = 3072;
constexpr int QH = 16, KVH = 4, HD = 64, QKVW = 1536;
constexpr int NE = 32, TOPK = 4, FF = 1024, NA = T * TOPK, MTILE = 256, CAP = NA + NE * MTILE, MAXTILES = CAP / MTILE;
constexpr float EPS = 1e-6f;

constexpr size_t MiB = 1u << 20;
constexpr size_t WS_CTL = 0, CTL_ZERO_BYTES = 32768;
constexpr size_t WS_MODP = 1 * MiB;
constexpr size_t WS_MISC = 2 * MiB;
constexpr size_t MISC_CNT = 0, MISC_TE = 65536, MISC_NT = 65536 + 2048, MISC_CDEC = 131072, MISC_GATE = 262144;
constexpr size_t WS_WSC = 3 * MiB;
constexpr size_t WSC_W1 = 0, WSC_IN = 524288, WSC_QKV = 524288 + 32768, WSC_W2 = 524288 + 65536;
constexpr size_t HS_OFF = 16 * MiB, XGS_OFF = 80 * MiB;
constexpr size_t WS_WIN = 4 * MiB, WS_WOUT = 14 * MiB, WS_WQKV = 18 * MiB, WS_WAO = 21 * MiB;
constexpr size_t WS_W1 = 32 * MiB, WS_W2 = 288 * MiB;
constexpr size_t WS_H = 416 * MiB, WS_ZX = 448 * MiB, WS_DT = 608 * MiB, WS_ST = 610 * MiB, WS_Y = 674 * MiB;
constexpr size_t WS_X1 = 738 * MiB, WS_X2 = 802 * MiB, WS_X3 = 866 * MiB;
constexpr size_t WS_ASG = 930 * MiB;
constexpr size_t WS_SRT = 931 * MiB;
constexpr size_t WS_XG = 932 * MiB, WS_ACT = 1076 * MiB, WS_YK = 1220 * MiB, WS_QKV = 1348 * MiB, WS_AO = 1396 * MiB;
constexpr size_t WS_XT = 1428 * MiB, WS_BT = 1492 * MiB, WS_BN = 1508 * MiB, WS_CN = 1524 * MiB, WS_END = 1540 * MiB;
constexpr int CW_TMO = 0, CW_CODE = 1, CW_BAR = 4096;

constexpr int RING_OFF = 0, RING_BYTES = 131072;
constexpr int LDSCTL_OFF = RING_BYTES, MISC_OFF = LDSCTL_OFF + 320, TE_OFF = MISC_OFF + 128;
constexpr int ROWT_OFF = TE_OFF + 1280;
constexpr int LDS_BYTES = 147456;
static_assert(ROWT_OFF + 2048 <= LDS_BYTES, "LDS map");
static_assert(TE_OFF + 4 * (MAXTILES + 4) <= LDS_BYTES, "LDS map");

#define LDS_WAIT() asm volatile("s_waitcnt lgkmcnt(0)" ::: "memory")
#define VM_WAIT() asm volatile("s_waitcnt vmcnt(0)" ::: "memory")
__device__ __forceinline__ unsigned f2bf(float f) { unsigned u = __builtin_bit_cast(unsigned, f); return (u + 0x7fffu + ((u >> 16) & 1u)) >> 16; }
typedef float f32x2_t __attribute__((ext_vector_type(2)));
typedef __bf16 bf16x2_t __attribute__((ext_vector_type(2)));
__device__ __forceinline__ unsigned pk2(float lo, float hi) { const f32x2_t v = {lo, hi}; const bf16x2_t b = __builtin_convertvector(v, bf16x2_t); return __builtin_bit_cast(unsigned, b); }
__device__ __forceinline__ float bf2f(unsigned h) { return __builtin_bit_cast(float, h << 16); }
__device__ __forceinline__ float bflo(unsigned w) { return __builtin_bit_cast(float, w << 16); }
__device__ __forceinline__ float bfhi(unsigned w) { return __builtin_bit_cast(float, w & 0xffff0000u); }
__device__ __forceinline__ bf16x8 pack8(const float (&o)[8]) { v4u w; w.x = pk2(o[0], o[1]); w.y = pk2(o[2], o[3]); w.z = pk2(o[4], o[5]); w.w = pk2(o[6], o[7]); return __builtin_bit_cast(bf16x8, w); }
__device__ __forceinline__ float rcp_f(float x) { return __builtin_amdgcn_rcpf(x); }
__device__ __forceinline__ float rsq_f(float x) { return __builtin_amdgcn_rsqf(x); }
__device__ __forceinline__ float silu_f(float x) { return x * rcp_f(1.0f + __expf(-x)); }
__device__ __forceinline__ float wave_sum(float v) {
#pragma unroll
    for (int o = 1; o < 64; o <<= 1) v += __shfl_xor(v, o);
    return v;
}
#define MFMA16(a, b, c) __builtin_amdgcn_mfma_f32_16x16x32_bf16((a), (b), (c), 0, 0, 0)

#define XB_TMO      128
#define XB_XCNT(j)  (256  + 64 * (j))
#define XB_XSUB(j)  (1280 + 64 * (j))
#define XB_XGEN(j)  (2304 + 64 * (j))
#define XB_TOP      3328
#define XB_TOPGEN   3392
#define XCD_BAR_WORDS 3456
#define XB_SPIN_CAP (1u << 18)
__device__ __forceinline__ unsigned xb_ld(unsigned* p)              { return __hip_atomic_load(p, __ATOMIC_RELAXED, __HIP_MEMORY_SCOPE_AGENT); }
__device__ __forceinline__ unsigned xb_add(unsigned* p, unsigned v) { return __hip_atomic_fetch_add(p, v, __ATOMIC_RELAXED, __HIP_MEMORY_SCOPE_AGENT); }
__device__ __forceinline__ unsigned xb_xcc_id() { return (unsigned)__builtin_amdgcn_s_getreg((3 << 11) | 20) & 0xFu; }
#define XB_SPIN(cond, bar) do { unsigned _sp = 0; while (cond) { __builtin_amdgcn_s_sleep(1); \
    if ((++_sp & 255u) == 0u) { if (xb_ld(&(bar)[XB_TMO])) break; if (_sp > XB_SPIN_CAP) { atomicAdd(&(bar)[XB_TMO], 1u); break; } } } } while (0)
struct XcdBarrier { unsigned* bar; unsigned x; volatile LAS unsigned* st; };
__device__ __forceinline__ XcdBarrier xcd_barrier_post(unsigned* bar, volatile LAS unsigned* st) {
    XcdBarrier b; b.bar = bar; b.x = xb_xcc_id(); b.st = st;
    if (threadIdx.x == 0) (void)xb_add(&bar[XB_XCNT(b.x)], 1u);
    return b;
}
__device__ __forceinline__ void xcd_barrier_complete(unsigned* bar, unsigned x, unsigned& nloc, unsigned& nx) {
    const unsigned G = gridDim.x * gridDim.y * gridDim.z;
    unsigned sum, cnt, mine, sp = 0u;
    for (;;) {
        sum = 0u; cnt = 0u; mine = 0u;
#pragma unroll
        for (unsigned j = 0; j < 16; ++j) { const unsigned c = xb_ld(&bar[XB_XCNT(j)]); sum += c; cnt += (c > 0u) ? 1u : 0u; mine = (j == x) ? c : mine; }
        if (sum == G) break;
        __builtin_amdgcn_s_sleep(1);
        if ((++sp & 255u) == 0u) { if (xb_ld(&bar[XB_TMO])) break; if (sp > XB_SPIN_CAP) { atomicAdd(&bar[XB_TMO], 1u); break; } }
    }
    nloc = mine > 0u ? mine : 1u; nx = cnt > 0u ? cnt : 1u;
}
__device__ __forceinline__ void xcd_barrier(const XcdBarrier& b) {
    asm volatile("s_waitcnt vmcnt(0)" ::: "memory");
    __syncthreads();
    if (threadIdx.x == 0) {
        unsigned* bar = b.bar;
        __builtin_amdgcn_s_waitcnt(0);
        unsigned nloc = b.st[0], nx = b.st[1];
        if (nloc == 0u) { xcd_barrier_complete(bar, b.x, nloc, nx); b.st[0] = nloc; b.st[1] = nx; }
        const unsigned old = xb_add(&bar[XB_XSUB(b.x)], 1u);
        const unsigned gen = old / nloc;
        if (old + 1u == (gen + 1u) * nloc) {
            __builtin_amdgcn_fence(__ATOMIC_RELEASE, "agent");
            asm volatile("s_waitcnt vmcnt(0)" ::: "memory");
            const unsigned og = xb_add(&bar[XB_TOP], 1u);
            const unsigned tg = og / nx;
            if (og + 1u == (tg + 1u) * nx) xb_add(&bar[XB_TOPGEN], 1u);
            else XB_SPIN(xb_ld(&bar[XB_TOPGEN]) == tg, bar);
            __builtin_amdgcn_fence(__ATOMIC_ACQUIRE, "agent");
            xb_add(&bar[XB_XGEN(b.x)], 1u);
            asm volatile("s_waitcnt vmcnt(0)" ::: "memory");
        } else {
            XB_SPIN(xb_ld(&bar[XB_XGEN(b.x)]) == gen, bar);
            __builtin_amdgcn_fence(__ATOMIC_ACQUIRE, "agent");
            asm volatile("s_waitcnt vmcnt(0)" ::: "memory");
        }
    }
    __syncthreads();
}

struct Args { const float* in[26]; float* out; unsigned char* ws; int ph_lo, ph_hi; };
enum { I_X = 0, I_C, I_ADAW, I_ADAB, I_N1G, I_N2G, I_MINW, I_MCONVW, I_MCONVB, I_MDTB, I_MALOG, I_MD, I_MNG, I_MOUTW, I_AQKVW, I_AQNG, I_AKNG, I_ASINK, I_AOUTW, I_RELB, I_RW, I_RB, I_EW1, I_EB1, I_EW2, I_EB2 };

__device__ __forceinline__ void p0_transpose_item(const float* __restrict__ W, int ldw, int K, int nblk, bf16* WT, LAS float* scr, int item, int lane) {
    const int kb = item / nblk, nb = item % nblk, k0 = 64 * kb, n0 = 32 * nb;
    float tv[32];
#pragma unroll
    for (int i = 0; i < 32; ++i) { const int kk = 2 * i + (lane >> 5); tv[i] = W[(size_t)(k0 + kk) * ldw + n0 + (lane & 31)]; }
#pragma unroll
    for (int i = 0; i < 32; ++i) { const int kk = 2 * i + (lane >> 5); scr[kk * 33 + (lane & 31)] = tv[i]; }
    LDS_WAIT(); asm volatile("" ::: "memory");
    const int c = lane & 7;
#pragma unroll
    for (int j = 0; j < 4; ++j) { const int n = (lane >> 3) + 8 * j; const LAS float* s = scr + (8 * c) * 33 + n;
        v4u o; o.x = pk2(s[0 * 33], s[1 * 33]); o.y = pk2(s[2 * 33], s[3 * 33]); o.z = pk2(s[4 * 33], s[5 * 33]); o.w = pk2(s[6 * 33], s[7 * 33]);
        *(GAS v4u*)(WT + (size_t)(n0 + n) * K + k0 + 8 * c) = o; }
    LDS_WAIT(); asm volatile("" ::: "memory");
}
__device__ __forceinline__ void p0_prologue(const Args& a, LAS unsigned char* lds, int wave, int lane) {
    unsigned char* ws = a.ws; const int blk = blockIdx.x, G = gridDim.x;
    float* modp = (float*)(ws + WS_MODP);
    const float* __restrict__ cin = a.in[I_C]; const float* __restrict__ adaw = a.in[I_ADAW];
    if (wave < 2) {
        for (int it = wave * G + blk; it < 384; it += 2 * G) {
            const int kc = it & 7, rest = it >> 3, l = rest / 24, nb = rest % 24;
            f32x4 a0 = {0.f, 0.f, 0.f, 0.f}, a1 = {0.f, 0.f, 0.f, 0.f};
            const float* wp = adaw + ((size_t)l * 1024 + kc * 128) * 6144 + nb * 256 + lane * 4;
#pragma unroll 32
            for (int k = 0; k < 128; ++k) { const f32x4 w = *(const f32x4*)(wp + (size_t)k * 6144);
                const float c0 = silu_f(cin[kc * 128 + k]), c1 = silu_f(cin[1024 + kc * 128 + k]); a0 += w * c0; a1 += w * c1; }
            *(f32x4*)(modp + ((size_t)(kc * 2 + l) * 2 + 0) * 6144 + nb * 256 + lane * 4) = a0;
            *(f32x4*)(modp + ((size_t)(kc * 2 + l) * 2 + 1) * 6144 + nb * 256 + lane * 4) = a1;
        }
    } else {
        LAS float* scr = (LAS float*)(lds + RING_OFF + wave * 16384);
        constexpr int I1 = 32 * 32, I3 = 16 * 32;
        constexpr int NITEMS = I1 + I3;
        for (int it = (wave - 2) * G + blk; it < NITEMS; it += 6 * G) {
            int r = it;
            if (r < I1) { p0_transpose_item(a.in[I_MOUTW], 1024, 2048, 32, (bf16*)(ws + WS_WOUT), scr, r, lane); continue; } r -= I1;
            { p0_transpose_item(a.in[I_AOUTW], 1024, 1024, 32, (bf16*)(ws + WS_WAO), scr, r, lane); }
        }
    }
}
struct QItem { const float* W; int ldw, n0; signed char* outq; float* sc; int f8; };
__device__ __forceinline__ QItem quant_decode(const Args& a, int it) {
    unsigned char* ws = a.ws; float* wsc = (float*)(ws + WS_WSC); QItem q; q.f8 = 0;
    constexpr int Q2 = 160;
    if (it < Q2) { q.W = a.in[I_MINW]; q.ldw = IN_DIM; q.n0 = 32 * it; q.outq = (signed char*)(ws + WS_WIN); q.sc = wsc + WSC_IN / 4; }
    else { q.W = a.in[I_AQKVW]; q.ldw = 1536; q.n0 = 32 * (it - Q2); q.outq = (signed char*)(ws + WS_WQKV); q.sc = wsc + WSC_QKV / 4; }
    return q;
}
__device__ __forceinline__ void quant_load(const QItem& q, int wave, int lane, float (&vals)[64]) {
    const int n = lane & 31, kh = lane >> 5; const float* __restrict__ wp = q.W + (size_t)(128 * wave + kh) * q.ldw + q.n0 + n;
#pragma unroll
    for (int i = 0; i < 64; ++i) vals[i] = wp[(size_t)(2 * i) * q.ldw];
}
__device__ __forceinline__ void quant_finish(const QItem& q, const float (&vals)[64], LAS unsigned char* lds, int wave, int lane) {
    LAS float* AMX = (LAS float*)(lds + 36864);
    LAS unsigned char* Tt = lds + wave * 4224;
    const int n = lane & 31, kh = lane >> 5; float am = 0.f;
#pragma unroll
    for (int i = 0; i < 64; ++i) am = fmaxf(am, fabsf(vals[i]));
    am = fmaxf(am, __shfl_xor(am, 32));
    if (lane < 32) AMX[wave * 32 + n] = am;
    __syncthreads();
    float amt = 0.f;
#pragma unroll
    for (int w = 0; w < 8; ++w) amt = fmaxf(amt, AMX[w * 32 + n]);
    const float qmax = q.f8 ? 448.0f : 127.0f;
    const float inv = amt > 0.f ? qmax / amt : 0.f;
    if (wave == 0 && lane < 32) q.sc[q.n0 + n] = amt > 0.f ? amt / qmax : 1.0f;
    if (q.f8) {
#pragma unroll
        for (int i = 0; i < 64; ++i) { const float x = vals[i] * inv; Tt[n * 132 + 2 * i + kh] = (unsigned char)(__builtin_amdgcn_cvt_pk_fp8_f32(x, x, 0, false) & 255); }
    } else {
#pragma unroll
        for (int i = 0; i < 64; ++i) Tt[n * 132 + 2 * i + kh] = (unsigned char)((int)__builtin_rintf(vals[i] * inv) & 255);
    }
    LDS_WAIT(); asm volatile("" ::: "memory");
    { const int rn = lane >> 1, half = lane & 1; const LAS unsigned* src = (const LAS unsigned*)(Tt + rn * 132 + 64 * half);
        v4u o[4];
#pragma unroll
        for (int qd = 0; qd < 4; ++qd) { o[qd].x = src[4 * qd]; o[qd].y = src[4 * qd + 1]; o[qd].z = src[4 * qd + 2]; o[qd].w = src[4 * qd + 3]; }
#pragma unroll
        for (int qd = 0; qd < 4; ++qd) *(v4u*)(q.outq + (size_t)(q.n0 + rn) * 1024 + 128 * wave + 64 * half + 16 * qd) = o[qd]; }
    __syncthreads();
}
__device__ __forceinline__ void p0_quant(const Args& a, LAS unsigned char* lds, int wave, int lane) {
    constexpr int NQ = 160 + 48;
    __syncthreads();
    float va[64], vb[64];
    int it = blockIdx.x;
    if (it < NQ) { const QItem q0 = quant_decode(a, it); quant_load(q0, wave, lane, va); }
#pragma unroll 1
    for (; it < NQ; it += gridDim.x) {
        const int nx = it + gridDim.x;
        if (nx < NQ) { const QItem qn = quant_decode(a, nx); quant_load(qn, wave, lane, vb); }
        const QItem q = quant_decode(a, it);
        quant_finish(q, va, lds, wave, lane);
#pragma unroll
        for (int i = 0; i < 64; ++i) va[i] = vb[i];
    }
}
constexpr int BG_N = 2048 + 1024;
__device__ __forceinline__ QItem bg_decode(const Args& a, int j, int matbase) {
    unsigned char* ws = a.ws; float* wsc = (float*)(ws + WS_WSC); QItem q;
    if (j < 2048) { const int mat = matbase + (j >> 6), nb = j & 63;
        q.W = a.in[I_EW1] + (size_t)mat * 1024 * 2048; q.ldw = 2048; q.n0 = 32 * nb; q.outq = (signed char*)(ws + WS_W1) + (size_t)mat * 2048 * 1024; q.sc = wsc + WSC_W1 / 4 + mat * 2048; q.f8 = 0; }
    else { const int g = j - 2048, mat = matbase + (g >> 5), nb = g & 31;
        q.W = a.in[I_EW2] + (size_t)mat * 1024 * 1024; q.ldw = 1024; q.n0 = 32 * nb; q.outq = (signed char*)(ws + WS_W2) + (size_t)mat * 1024 * 1024; q.sc = wsc + WSC_W2 / 4 + mat * 1024; q.f8 = 1; }
    return q;
}
__device__ __forceinline__ void bg_run(const Args& a, LAS unsigned char* lds, int first, int count, int step, int wave, int lane, int matbase = 32) {
    if (first > BG_N) first = BG_N;
    __syncthreads();
    float va[64], vb[64];
    int j = first, left = count;
    if (j >= BG_N) left = 0;
    if (left > 0) { const QItem q0 = bg_decode(a, j, matbase); quant_load(q0, wave, lane, va); }
#pragma unroll 1
    for (; left > 0; --left, j += step) {
        const int nx = j + step; const bool more = (left > 1) && (nx < BG_N);
        if (more) { const QItem qn = bg_decode(a, nx, matbase); quant_load(qn, wave, lane, vb); }
        const QItem q = bg_decode(a, j, matbase);
        quant_finish(q, va, lds, wave, lane);
        if (!more) break;
#pragma unroll
        for (int i = 0; i < 64; ++i) va[i] = vb[i];
    }
    __syncthreads();
}
__device__ __forceinline__ float modval(const Args& a, int l, int b, int idx) {
    const float* modp = (const float*)(a.ws + WS_MODP);
    float s = a.in[I_ADAB][l * 6144 + idx];
#pragma unroll
    for (int kc = 0; kc < 8; ++kc) s += modp[((size_t)(kc * 2 + l) * 2 + b) * 6144 + idx];
    return s;
}

constexpr int NP_MOD = 0, NP_HI = 16384, NP_LO = NP_HI + 16 * 1032 * 2, NP_PART = NP_LO + 16 * 1032 * 2, NP_LOG = NP_PART + 16384, NP_AE = NP_LOG + 2048, NP_AG = NP_AE + 1024, NP_TOPV = NP_AG + 1024, NP_END = NP_TOPV + 256;
static_assert(NP_END <= RING_BYTES, "norm phase LDS");
template <int MODE, bool COMBINE, bool NORM>
__device__ __forceinline__ void norm_phase(const Args& a, LAS unsigned char* lds, int layer, int which, const float* xin, const float* cgate, const unsigned char* yk, float* xout,
                                           const float* __restrict__ Wsk, int ldw, const float* __restrict__ bsk, int tid, int wave, int lane) {
    unsigned char* ws = a.ws;
    LAS float* MOD = (LAS float*)(lds + NP_MOD);
    LAS bf16* HI = (LAS bf16*)(lds + NP_HI); LAS bf16* LO = (LAS bf16*)(lds + NP_LO);
    LAS float* PART = (LAS float*)(lds + NP_PART); LAS float* LOG = (LAS float*)(lds + NP_LOG);
    LAS int* AE = (LAS int*)(lds + NP_AE); LAS float* AG = (LAS float*)(lds + NP_AG); LAS float* TOPV = (LAS float*)(lds + NP_TOPV);
    signed char* H8 = (signed char*)(ws + WS_H); float* hscale = (float*)(ws + WS_H + HS_OFF);
    const int rb = blockIdx.x;
    if (NORM) {
        const float* ng = a.in[which ? I_N2G : I_N1G] + layer * 1024;
        for (int idx = tid; idx < 2048; idx += NTHR) { const int b = idx >> 10, col = idx & 1023;
            const float sh = modval(a, layer, b, which * 3072 + col), sc = modval(a, layer, b, which * 3072 + 1024 + col);
            MOD[(b * 2 + 0) * 1024 + col] = ng[col] * (1.0f + sc); MOD[(b * 2 + 1) * 1024 + col] = sh; }
    }
    const int fi = lane & 15, fq = lane >> 4;
    bf16x8 Bh[2][4], Bl[2][4];
    if (MODE != 2) {
#pragma unroll
        for (int s = 0; s < 4; ++s)
#pragma unroll
            for (int nt = 0; nt < 2; ++nt) { float hi[8], lo[8];
#pragma unroll
                for (int e = 0; e < 8; ++e) { const float w = Wsk[(size_t)(128 * wave + 32 * s + 8 * fq + e) * ldw + 16 * nt + fi]; const float h = bf2f(f2bf(w)); hi[e] = h; lo[e] = w - h; }
                Bh[nt][s] = pack8(hi); Bl[nt][s] = pack8(lo); }
    }
    __syncthreads();
    f32x4 vn[2][4]; unsigned yn[2][4][4];
#define NP_LOAD_TILE(tlx) do { _Pragma("unroll") for (int rr_ = 0; rr_ < 2; ++rr_) { const int m_ = 64 * rb + 16 * (tlx) + 8 * rr_ + wave; \
        _Pragma("unroll") for (int j = 0; j < 4; ++j) { vn[rr_][j] = *(const f32x4*)(xin + (size_t)m_ * 1024 + 4 * lane + 256 * j); \
            if (COMBINE) { _Pragma("unroll") for (int k = 0; k < 4; ++k) yn[rr_][j][k] = *(const unsigned*)(yk + ((size_t)m_ * 4 + k) * 1024 + 4 * lane + 256 * j); } } } } while (0)
    NP_LOAD_TILE(0);
#pragma unroll 1
    for (int tl = 0; tl < 4; ++tl) {
        f32x4 vc[2][4]; unsigned yc[2][4][4];
#pragma unroll
        for (int rr = 0; rr < 2; ++rr)
#pragma unroll
            for (int j = 0; j < 4; ++j) { vc[rr][j] = vn[rr][j];
                if (COMBINE) {
#pragma unroll
                    for (int k = 0; k < 4; ++k) yc[rr][j][k] = yn[rr][j][k]; } }
        if (tl < 3) NP_LOAD_TILE(tl + 1);
#pragma unroll
        for (int rr = 0; rr < 2; ++rr) {
            const int lr = 8 * rr + wave, m = 64 * rb + 16 * tl + lr, b = m >> 13;
            f32x4 v[4];
#pragma unroll
            for (int j = 0; j < 4; ++j) v[j] = vc[rr][j];
            if (COMBINE) {
#pragma unroll
                for (int j = 0; j < 4; ++j) { const int col = 4 * lane + 256 * j; const f32x4 g = *(const f32x4*)(cgate + b * 1024 + col);
                    f32x4 s = {0.f, 0.f, 0.f, 0.f};
#pragma unroll
                    for (int k = 0; k < 4; ++k) { const unsigned y = yc[rr][j][k]; const f32x2_t lo = __builtin_amdgcn_cvt_pk_f32_fp8((int)y, false), hi = __builtin_amdgcn_cvt_pk_f32_fp8((int)y, true); s += (f32x4){lo[0], lo[1], hi[0], hi[1]}; }
                    v[j] += g * s; *(f32x4*)(xout + (size_t)m * 1024 + col) = v[j]; }
            }
            if (NORM) {
                float ss = 0.f;
#pragma unroll
                for (int j = 0; j < 4; ++j) ss += (v[j].x * v[j].x + v[j].y * v[j].y) + (v[j].z * v[j].z + v[j].w * v[j].w);
                const float r = rsq_f(wave_sum(ss) * (1.0f / 1024.0f) + EPS);
                float am = 0.f;
#pragma unroll
                for (int j = 0; j < 4; ++j) { const int col = 4 * lane + 256 * j;
                    const f32x4 A = *(const LAS f32x4*)(MOD + (b * 2 + 0) * 1024 + col), S = *(const LAS f32x4*)(MOD + (b * 2 + 1) * 1024 + col);
                    const f32x4 h = v[j] * r * A + S; v[j] = h;
                    am = fmaxf(fmaxf(am, fmaxf(fabsf(h.x), fabsf(h.y))), fmaxf(fabsf(h.z), fabsf(h.w)));
                    if (MODE != 2) { v2u hw; hw.x = pk2(h.x, h.y); hw.y = pk2(h.z, h.w);
                        const f32x4 hr = {bflo(hw.x), bfhi(hw.x), bflo(hw.y), bfhi(hw.y)}; const f32x4 l4 = h - hr;
                        v2u lw; lw.x = pk2(l4.x, l4.y); lw.y = pk2(l4.z, l4.w);
                        *(LAS v2u*)(HI + lr * 1032 + col) = hw; *(LAS v2u*)(LO + lr * 1032 + col) = lw; } }
#pragma unroll
                for (int o = 1; o < 64; o <<= 1) am = fmaxf(am, __shfl_xor(am, o));
                const float inv = am > 0.f ? 127.0f / am : 0.f;
#pragma unroll
                for (int j = 0; j < 4; ++j) { const int col = 4 * lane + 256 * j;
                    const int q0 = (int)__builtin_rintf(v[j].x * inv), q1 = (int)__builtin_rintf(v[j].y * inv), q2 = (int)__builtin_rintf(v[j].z * inv), q3 = (int)__builtin_rintf(v[j].w * inv);
                    *(unsigned*)(H8 + (size_t)m * 1024 + col) = (unsigned)(q0 & 255) | ((unsigned)(q1 & 255) << 8) | ((unsigned)(q2 & 255) << 16) | ((unsigned)q3 << 24); }
                if (lane == 0) hscale[m] = am * (1.0f / 127.0f);
            }
        }
        if (MODE != 2) {
            __syncthreads();
            f32x4 acc[2] = {{0.f, 0.f, 0.f, 0.f}, {0.f, 0.f, 0.f, 0.f}};
#pragma unroll
            for (int s = 0; s < 4; ++s) { const int k0 = 128 * wave + 32 * s + 8 * fq;
                const bf16x8 ah = *(const LAS bf16x8*)(HI + fi * 1032 + k0), al = *(const LAS bf16x8*)(LO + fi * 1032 + k0);
#pragma unroll
                for (int nt = 0; nt < 2; ++nt) { acc[nt] = MFMA16(ah, Bh[nt][s], acc[nt]); acc[nt] = MFMA16(al, Bh[nt][s], acc[nt]); acc[nt] = MFMA16(ah, Bl[nt][s], acc[nt]); } }
#pragma unroll
            for (int nt = 0; nt < 2; ++nt)
#pragma unroll
                for (int r = 0; r < 4; ++r) PART[(wave * 16 + 4 * fq + r) * 32 + 16 * nt + fi] = acc[nt][r];
            __syncthreads();
            { const int lr = tid >> 5, n = tid & 31; float s = bsk[n];
#pragma unroll
                for (int w = 0; w < 8; ++w) s += PART[(w * 16 + lr) * 32 + n];
                if (MODE == 0) { const float sp = fmaxf(s, 0.f) + log1pf(__expf(-fabsf(s))); ((float*)(ws + WS_DT))[(size_t)(64 * rb + 16 * tl + lr) * 32 + n] = sp; }
                else LOG[lr * 32 + n] = s; }
            if (MODE == 1) {
                __syncthreads();
                { const int lr = tid >> 5, n = tid & 31; const float sv = LOG[lr * 32 + n]; int rank = 0;
#pragma unroll
                    for (int n2 = 0; n2 < 32; ++n2) { const float o = LOG[lr * 32 + n2]; rank += (o > sv || (o == sv && n2 < n)) ? 1 : 0; }
                    if (rank < 4) { TOPV[lr * 4 + rank] = sv; AE[(16 * tl + lr) * 4 + rank] = n; } }
                __syncthreads();
                if (tid < 64) { const int row = tid >> 2, k = tid & 3; const float v0 = TOPV[row * 4], v1 = TOPV[row * 4 + 1], v2 = TOPV[row * 4 + 2], v3 = TOPV[row * 4 + 3];
                    const float e0 = 1.0f, e1 = __expf(v1 - v0), e2 = __expf(v2 - v0), e3 = __expf(v3 - v0); const float sum = (e0 + e1) + (e2 + e3);
                    const float ek = k == 0 ? e0 : (k == 1 ? e1 : (k == 2 ? e2 : e3));
                    AG[(16 * tl + row) * 4 + k] = ek / sum; }
            }
        }
    }
    if (MODE == 1) {
        __syncthreads();
        int* asg_e = (int*)(ws + WS_ASG); float* asg_g = (float*)(ws + WS_ASG + 262144); int* asg_r = (int*)(ws + WS_ASG + 524288);
        int* cntblk = (int*)(ws + WS_MISC + MISC_CNT);
        LAS int* WC = (LAS int*)(lds + NP_PART);
        int e_mine = 0, rank_w = 0;
        if (wave < 4) { e_mine = AE[tid];
#pragma unroll 4
            for (int e = 0; e < 32; ++e) { const unsigned long long mb = __ballot(e_mine == e); if (e_mine == e) rank_w = __popcll(mb & ((1ull << lane) - 1ull)); if (lane == 0) WC[wave * 32 + e] = __popcll(mb); } }
        __syncthreads();
        if (wave < 4) { int base = 0;
#pragma unroll
            for (int w = 0; w < 3; ++w) base += (w < wave) ? WC[w * 32 + e_mine] : 0;
            asg_e[rb * 256 + tid] = e_mine; asg_g[rb * 256 + tid] = AG[tid]; asg_r[rb * 256 + tid] = base + rank_w; }
        else if (tid < 288) { const int e = tid - 256; cntblk[rb * 32 + e] = (WC[e] + WC[32 + e]) + (WC[64 + e] + WC[96 + e]); }
    }
    __syncthreads();
}

__device__ __forceinline__ void moe_scatter(const Args& a, LAS unsigned char* lds, int tid, int wave, int lane) {
    unsigned char* ws = a.ws; const int rb = blockIdx.x, G = gridDim.x;
    LAS int* PARTS = (LAS int*)(lds + 0); LAS int* TOT = (LAS int*)(lds + 4096); LAS int* BASE = (LAS int*)(lds + 4224); LAS int* PS = (LAS int*)(lds + 4352); LAS int* POS = (LAS int*)(lds + 4608);
    const int* cntblk = (const int*)(ws + WS_MISC + MISC_CNT);
    const int* asg_e = (const int*)(ws + WS_ASG); const float* asg_g = (const float*)(ws + WS_ASG + 262144); const int* asg_r = (const int*)(ws + WS_ASG + 524288);
    int* srt_tok = (int*)(ws + WS_SRT); float* srt_gate = (float*)(ws + WS_SRT + 524288);
    int* rowoff = (int*)(ws + WS_XG); float* xgs = (float*)(ws + WS_XG + XGS_OFF); const float* hscale = (const float*)(ws + WS_H + HS_OFF);
    { const int e = tid & 31, part = tid >> 5; int tot = 0, base = 0;
        for (int bb = part * 16; bb < part * 16 + 16; ++bb) { if (bb < G) { const int c = cntblk[bb * 32 + e]; tot += c; if (bb < rb) base += c; } }
        PARTS[(part * 32 + e) * 2] = tot; PARTS[(part * 32 + e) * 2 + 1] = base; }
    __syncthreads();
    if (tid < 32) { int tot = 0, base = 0; for (int p = 0; p < 16; ++p) { tot += PARTS[(p * 32 + tid) * 2]; base += PARTS[(p * 32 + tid) * 2 + 1]; } TOT[tid] = tot; BASE[tid] = base; }
    __syncthreads();
    if (tid == 0) { int ps = 0; for (int e = 0; e < 32; ++e) { PS[e] = ps; ps += ((TOT[e] + MTILE - 1) / MTILE) * MTILE; } PS[32] = ps; }
    __syncthreads();
    if (tid < 256) { const int aidx = rb * 256 + tid; const int e = asg_e[aidx]; const int pos = PS[e] + BASE[e] + asg_r[aidx];
        srt_tok[pos] = aidx; srt_gate[pos] = asg_g[aidx]; rowoff[pos] = (aidx >> 2) * 1024; xgs[pos] = hscale[aidx >> 2]; }
    if (rb < 32) { const int e = rb; const int p0 = PS[e] + TOT[e], p1 = PS[e + 1];
        for (int pos = p0 + tid; pos < p1; pos += NTHR) { srt_tok[pos] = -1; srt_gate[pos] = 0.f; xgs[pos] = 0.f; rowoff[pos] = 0; } }
    if (rb == 0) { int* te = (int*)(ws + WS_MISC + MISC_TE);
        if (tid < MAXTILES) { const int r0 = tid * MTILE; int e = 0; for (int j = 0; j < 32; ++j) e += (PS[j + 1] <= r0) ? 1 : 0; te[tid] = (r0 < PS[32]) ? e : 31; }
        if (tid == 0) *(int*)(ws + WS_MISC + MISC_NT) = PS[32] / MTILE; }
    __syncthreads();
    __syncthreads();
}
__device__ __forceinline__ void load_tile_table(const Args& a, LAS unsigned char* lds, int tid) {
    const int* te = (const int*)(a.ws + WS_MISC + MISC_TE);
    LAS int* TE = (LAS int*)(lds + TE_OFF);
    if (tid < MAXTILES) TE[tid] = te[tid];
    if (tid == MAXTILES) TE[MAXTILES] = *(const int*)(a.ws + WS_MISC + MISC_NT);
    __syncthreads();
}

#define OPAQUE(x) asm volatile("" : "+v"(x))
__device__ __forceinline__ void conv_load(const bf16* __restrict__ ZX, int tok0, int l0, int zc0, int lane, v4u (&raw)[11]) {
    const int chunk = lane & 7, run = lane >> 3; const int zc = zc0 + 8 * chunk;
    const bf16* __restrict__ base = ZX - 3 * XW; unsigned off = (unsigned)((tok0 + l0 + 8 * run) * XW + zc);
#pragma unroll
    for (int e = 0; e < 11; ++e) { raw[e] = *(const v4u*)(base + off); off += XW; OPAQUE(off); }
}
__device__ __forceinline__ void conv_finish(const Args& a, bool first, int l0, int zc0, bf16* outT, bf16* outN, int lane, v4u (&raw)[11], LAS bf16* ldsT = nullptr, int ldsS = 0, int ldsL = 0) {
    const int chunk = lane & 7, run = lane >> 3; const int zc = zc0 + 8 * chunk, ch = zc - XOFF;
    const float* __restrict__ cw = a.in[I_MCONVW]; const float* __restrict__ cbp = a.in[I_MCONVB];
    if (first && l0 == 0 && run == 0) { raw[0] = (v4u){0u, 0u, 0u, 0u}; raw[1] = (v4u){0u, 0u, 0u, 0u}; raw[2] = (v4u){0u, 0u, 0u, 0u}; }
    float w[4][8], cb[8];
#pragma unroll
    for (int j = 0; j < 4; ++j) { const f32x4 t0 = *(const f32x4*)(cw + j * CONVD + ch), t1 = *(const f32x4*)(cw + j * CONVD + ch + 4);
        w[j][0] = t0.x; w[j][1] = t0.y; w[j][2] = t0.z; w[j][3] = t0.w; w[j][4] = t1.x; w[j][5] = t1.y; w[j][6] = t1.z; w[j][7] = t1.w; }
    { const f32x4 t0 = *(const f32x4*)(cbp + ch), t1 = *(const f32x4*)(cbp + ch + 4); cb[0] = t0.x; cb[1] = t0.y; cb[2] = t0.z; cb[3] = t0.w; cb[4] = t1.x; cb[5] = t1.y; cb[6] = t1.z; cb[7] = t1.w; }
    unsigned P[4][8];
#pragma unroll
    for (int rp = 0; rp < 4; ++rp) { float o[2][8];
#pragma unroll
        for (int rr = 0; rr < 2; ++rr) { const int r = 2 * rp + rr;
#pragma unroll
            for (int cx = 0; cx < 8; ++cx) o[rr][cx] = cb[cx];
#pragma unroll
            for (int j = 0; j < 4; ++j) { const v4u x = raw[r + j];
                const float xv[8] = {bflo(x.x), bfhi(x.x), bflo(x.y), bfhi(x.y), bflo(x.z), bfhi(x.z), bflo(x.w), bfhi(x.w)};
#pragma unroll
                for (int cx = 0; cx < 8; ++cx) o[rr][cx] += w[j][cx] * xv[cx]; }
#pragma unroll
            for (int cx = 0; cx < 8; ++cx) o[rr][cx] = silu_f(o[rr][cx]); }
#pragma unroll
        for (int cx = 0; cx < 8; ++cx) P[rp][cx] = pk2(o[0][cx], o[1][cx]); }
    if (outT) {
#pragma unroll
        for (int cx = 0; cx < 8; ++cx) { v4u t = {P[0][cx], P[1][cx], P[2][cx], P[3][cx]}; *(v4u*)(outT + (8 * chunk + cx) * 128 + l0 + 8 * run) = t; } }
    if (ldsS != 0) {
#pragma unroll
        for (int cx = 0; cx < 8; ++cx) { v4u t = {P[0][cx], P[1][cx], P[2][cx], P[3][cx]}; *(LAS v4u*)(ldsT + (8 * chunk + cx) * ldsS + ldsL + 8 * run) = t; } }
    if (outN) {
#pragma unroll
        for (int rp = 0; rp < 4; ++rp) { v4u e0, e1;
            e0.x = (P[rp][0] & 0xffffu) | (P[rp][1] << 16); e0.y = (P[rp][2] & 0xffffu) | (P[rp][3] << 16); e0.z = (P[rp][4] & 0xffffu) | (P[rp][5] << 16); e0.w = (P[rp][6] & 0xffffu) | (P[rp][7] << 16);
            e1.x = (P[rp][0] >> 16) | (P[rp][1] & 0xffff0000u); e1.y = (P[rp][2] >> 16) | (P[rp][3] & 0xffff0000u); e1.z = (P[rp][4] >> 16) | (P[rp][5] & 0xffff0000u); e1.w = (P[rp][6] >> 16) | (P[rp][7] & 0xffff0000u);
            *(v4u*)(outN + (l0 + 8 * run + 2 * rp) * 128 + 8 * chunk) = e0; *(v4u*)(outN + (l0 + 8 * run + 2 * rp + 1) * 128 + 8 * chunk) = e1; } }
}
__device__ __forceinline__ void head_scan(const float* __restrict__ DT, int tok0, int hh, float Ah, int lane, float& d0, float& d1, float& acs0, float& acs1, float& total) {
    d0 = DT[(size_t)(tok0 + 2 * lane) * 32 + hh]; d1 = DT[(size_t)(tok0 + 2 * lane + 1) * 32 + hh];
    const float a0 = d0 * Ah, a1 = a0 + d1 * Ah;
    float v = a1;
#pragma unroll
    for (int o = 1; o < 64; o <<= 1) { const float t = __shfl_up(v, o); if (lane >= o) v += t; }
    acs0 = v - a1 + a0; acs1 = v; total = __shfl(v, 63);
}
__device__ __forceinline__ void ssd_states(const Args& a, LAS unsigned char* lds, int tid, int wave, int lane) {
    unsigned char* ws = a.ws;
    const bf16* __restrict__ ZX = (const bf16*)(ws + WS_ZX); const float* __restrict__ DT = (const float*)(ws + WS_DT);
    bf16* ST = (bf16*)(ws + WS_ST); float* CDEC = (float*)(ws + WS_MISC + MISC_CDEC);
    bf16* XT = (bf16*)(ws + WS_XT); bf16* BT = (bf16*)(ws + WS_BT); bf16* BN = (bf16*)(ws + WS_BN); bf16* CN = (bf16*)(ws + WS_CN);
    LAS bf16* BTs = (LAS bf16*)(lds + 0);
    LAS bf16* XTs = (LAS bf16*)(lds + 34816 + wave * 9216);
    LAS float* WL = (LAS float*)(lds + 34816 + 8 * 9216 + wave * 512);
    const int fi = lane & 15, fq = lane >> 4;
    for (int u = (int)((blockIdx.x & 7) * (gridDim.x >> 3) + (blockIdx.x >> 3)); u < BATCH * NCH * NGRP; u += gridDim.x) {
        const int b = u >> 8, c = (u >> 2) & 63, g = u & 3; const int tok0 = b * SEQ + c * CHK; const bool first = (c == 0);
        const size_t cg = (size_t)((b * NCH + c) * NGRP + g);
        const int hh = 8 * g + wave; const float Ah = -__expf(a.in[I_MALOG][hh]);
        { float d0, d1, acs0, acs1, total; head_scan(DT, tok0, hh, Ah, lane, d0, d1, acs0, acs1, total);
            WL[2 * lane] = d0 * __expf(total - acs0); WL[2 * lane + 1] = d1 * __expf(total - acs1);
            if (lane == 0) CDEC[(b * NCH + c) * SH + hh] = __expf(total); }
        { const int rh = wave & 1, cb2 = (wave & 3) >> 1; const bool isC = wave >= 4;
            const int zc0 = (isC ? COFF : BOFF) + g * 128 + 64 * cb2;
            v4u raw[11]; conv_load(ZX, tok0, 64 * rh, zc0, lane, raw);
            conv_finish(a, first, 64 * rh, zc0, nullptr, (isC ? CN : BN) + cg * 16384 + 64 * cb2, lane, raw, BTs + (64 * cb2) * 136, isC ? 0 : 136, 64 * rh); }
        bf16x8 Xf[4][4];
        bf16* xtg = XT + ((size_t)((b * NCH + c) * SH + hh)) * 8192;
#pragma unroll
        for (int rh = 0; rh < 2; ++rh) {
            { v4u raw[11]; conv_load(ZX, tok0, 64 * rh, XOFF + hh * 64, lane, raw);
                conv_finish(a, first, 64 * rh, XOFF + hh * 64, xtg, nullptr, lane, raw, XTs, 72, 0); }
            LDS_WAIT(); asm volatile("" ::: "memory");
#pragma unroll
            for (int pt = 0; pt < 4; ++pt)
#pragma unroll
                for (int k2 = 0; k2 < 2; ++k2) { const int ll = 32 * k2 + 8 * fq, l0 = 64 * rh + ll; const v4u x = *(const LAS v4u*)(XTs + (16 * pt + fi) * 72 + ll);
                    const f32x4 s0 = *(const LAS f32x4*)(WL + l0), s1 = *(const LAS f32x4*)(WL + l0 + 4);
                    const float o[8] = {bflo(x.x) * s0.x, bfhi(x.x) * s0.y, bflo(x.y) * s0.z, bfhi(x.y) * s0.w, bflo(x.z) * s1.x, bfhi(x.z) * s1.y, bflo(x.w) * s1.z, bfhi(x.w) * s1.w};
                    Xf[pt][2 * rh + k2] = pack8(o); }
            LDS_WAIT(); asm volatile("" ::: "memory");
        }
        __syncthreads();
        bf16* stp = ST + ((size_t)((b * NCH + c) * SH + hh)) * 8192;
#pragma unroll 1
        for (int nh = 0; nh < 2; ++nh) {
            f32x4 acc[4][4];
#pragma unroll
            for (int n4 = 0; n4 < 4; ++n4)
#pragma unroll
                for (int pt = 0; pt < 4; ++pt) acc[n4][pt] = (f32x4){0.f, 0.f, 0.f, 0.f};
#pragma unroll
            for (int ks = 0; ks < 4; ++ks)
#pragma unroll
                for (int n4 = 0; n4 < 4; ++n4) { const bf16x8 af = *(const LAS bf16x8*)(BTs + (16 * (4 * nh + n4) + fi) * 136 + 32 * ks + 8 * fq);
#pragma unroll
                    for (int pt = 0; pt < 4; ++pt) acc[n4][pt] = MFMA16(af, Xf[pt][ks], acc[n4][pt]); }
#pragma unroll
            for (int n4 = 0; n4 < 4; ++n4)
#pragma unroll
                for (int pt = 0; pt < 4; ++pt) { v2u w; w.x = pk2(acc[n4][pt][0], acc[n4][pt][1]); w.y = pk2(acc[n4][pt][2], acc[n4][pt][3]);
                    *(v2u*)(stp + (16 * pt + fi) * 128 + 16 * (4 * nh + n4) + 4 * fq) = w; }
            asm volatile("" ::: "memory");
        }
        __syncthreads();
    }
}

__device__ __forceinline__ void ssd_scan(const Args& a, int tid) {
    unsigned char* ws = a.ws; bf16* ST = (bf16*)(ws + WS_ST); const float* CDEC = (const float*)(ws + WS_MISC + MISC_CDEC);
    for (int e4 = blockIdx.x * NTHR + tid; e4 < BATCH * SH * 2048; e4 += gridDim.x * NTHR) {
        const int b = e4 >> 16, rem = e4 & 65535, hh = rem >> 11, off = (rem & 2047) * 4;
        f32x4 h = {0.f, 0.f, 0.f, 0.f};
        bf16* p = ST + ((size_t)(b * NCH) * SH + hh) * 8192 + off;
        for (int c0 = 0; c0 < NCH; c0 += 8) { v2u s[8]; float dc[8];
#pragma unroll
            for (int j = 0; j < 8; ++j) { s[j] = *(const v2u*)(p + (size_t)(c0 + j) * SH * 8192); dc[j] = CDEC[(b * NCH + c0 + j) * SH + hh]; }
#pragma unroll
            for (int j = 0; j < 8; ++j) { v2u o; o.x = pk2(h.x, h.y); o.y = pk2(h.z, h.w); *(v2u*)(p + (size_t)(c0 + j) * SH * 8192) = o;
                const f32x4 sv = {bflo(s[j].x), bfhi(s[j].x), bflo(s[j].y), bfhi(s[j].y)}; h = h * dc[j] + sv; } }
    }
}

constexpr int S3_CC = 0, S3_BC = 34816, S3_CB = 69632, S3_TAB = 104448, S3_WV = 109568, S3_RMS = 117760, S3_END = 121856;
static_assert(S3_END <= RING_BYTES, "S3 LDS");
__device__ __forceinline__ void ssd_out(const Args& a, LAS unsigned char* lds, int tid, int wave, int lane) {
    unsigned char* ws = a.ws;
    const bf16* __restrict__ ZX = (const bf16*)(ws + WS_ZX); const float* __restrict__ DT = (const float*)(ws + WS_DT);
    const bf16* ST = (const bf16*)(ws + WS_ST); bf16* Y = (bf16*)(ws + WS_Y);
    LAS bf16* Cc = (LAS bf16*)(lds + S3_CC); LAS bf16* Bc = (LAS bf16*)(lds + S3_BC); LAS bf16* CB = (LAS bf16*)(lds + S3_CB);
    LAS float* ACS = (LAS float*)(lds + S3_WV + wave * 1024); LAS float* DTW = ACS + 128;
    LAS float* RMS = (LAS float*)(lds + S3_RMS);
    const int fi = lane & 15, fq = lane >> 4;
    const int u0 = (int)((blockIdx.x & 7) * (gridDim.x >> 3) + (blockIdx.x >> 3));
    v4u bcn[4], ccn[4];
#define S3_LOAD_BC(uu) do { const int b_ = (uu) >> 8, c_ = ((uu) >> 2) & 63, g_ = (uu) & 3; const size_t cg_ = (size_t)((b_ * NCH + c_) * NGRP + g_); \
        const bf16* bn_ = (const bf16*)(ws + WS_BN) + cg_ * 16384; const bf16* cn_ = (const bf16*)(ws + WS_CN) + cg_ * 16384; \
        _Pragma("unroll") for (int i = 0; i < 4; ++i) { const int idx = tid + NTHR * i, row = idx >> 4, c8 = (idx & 15) * 8; bcn[i] = *(const v4u*)(bn_ + row * 128 + c8); ccn[i] = *(const v4u*)(cn_ + row * 128 + c8); } } while (0)
    if (u0 < BATCH * NCH * NGRP) S3_LOAD_BC(u0);
    for (int u = u0; u < BATCH * NCH * NGRP; u += gridDim.x) {
        const int b = u >> 8, c = (u >> 2) & 63, g = u & 3; const int tok0 = b * SEQ + c * CHK;
        {
#pragma unroll
            for (int i = 0; i < 4; ++i) { const int idx = tid + NTHR * i, row = idx >> 4, c8 = (idx & 15) * 8;
                *(LAS v4u*)(Bc + row * 136 + c8) = bcn[i]; *(LAS v4u*)(Cc + row * 136 + c8) = ccn[i]; } }
        const int hh = 8 * g + wave; const float Ah = -__expf(a.in[I_MALOG][hh]); const float Dh = a.in[I_MD][hh];
        { float d0, d1, acs0, acs1, total; head_scan(DT, tok0, hh, Ah, lane, d0, d1, acs0, acs1, total);
            ACS[2 * lane] = acs0; ACS[2 * lane + 1] = acs1; DTW[2 * lane] = d0; DTW[2 * lane + 1] = d1; }
        bf16x8 Xf[4][4];
        { const bf16* xth = (const bf16*)(ws + WS_XT) + ((size_t)((b * NCH + c) * SH + hh)) * 8192;
#pragma unroll
            for (int pt = 0; pt < 4; ++pt)
#pragma unroll
                for (int ks = 0; ks < 4; ++ks) Xf[pt][ks] = *(const bf16x8*)(xth + (16 * pt + fi) * 128 + 32 * ks + 8 * fq); }
        __syncthreads();
        if (u + (int)gridDim.x < BATCH * NCH * NGRP) S3_LOAD_BC(u + (int)gridDim.x);
        { const int lt = wave;
#pragma unroll 1
            for (int st = 0; st < 8; ++st) { if (st <= lt) { f32x4 cacc = {0.f, 0.f, 0.f, 0.f};
#pragma unroll
                for (int kn = 0; kn < 4; ++kn) { const bf16x8 af = *(const LAS bf16x8*)(Bc + (16 * st + fi) * 136 + 32 * kn + 8 * fq), bfr = *(const LAS bf16x8*)(Cc + (16 * lt + fi) * 136 + 32 * kn + 8 * fq);
                    cacc = MFMA16(af, bfr, cacc); }
                v2u w; w.x = pk2(cacc[0], cacc[1]); w.y = pk2(cacc[2], cacc[3]);
                *(LAS v2u*)(CB + (16 * lt + fi) * 136 + 16 * st + 4 * fq) = w; } } }
        __syncthreads();
        const bf16* sth = ST + ((size_t)((b * NCH + c) * SH + hh)) * 8192;
        const float* __restrict__ ng = a.in[I_MNG];
#pragma unroll 1
        for (int lhi = 0; lhi < 4; ++lhi) {
            int lh = lhi; asm volatile("" : "+s"(lh));
            int fio = fi, fqo = fq; asm volatile("" : "+v"(fio), "+v"(fqo));
            f32x4 acc[4][2];
#pragma unroll
            for (int pt = 0; pt < 4; ++pt)
#pragma unroll
                for (int l4 = 0; l4 < 2; ++l4) acc[pt][l4] = (f32x4){0.f, 0.f, 0.f, 0.f};
            bf16x8 ah0[4], ah1[4];
#pragma unroll
            for (int pt = 0; pt < 4; ++pt) { ah0[pt] = *(const bf16x8*)(sth + (16 * pt + fio) * 128 + 8 * fqo); ah1[pt] = *(const bf16x8*)(sth + (16 * pt + fio) * 128 + 32 + 8 * fqo); }
#pragma unroll
            for (int kn = 0; kn < 4; ++kn) { bf16x8 bfr[2];
#pragma unroll
                for (int l4 = 0; l4 < 2; ++l4) bfr[l4] = *(const LAS bf16x8*)(Cc + (16 * (2 * lh + l4) + fio) * 136 + 32 * kn + 8 * fqo);
#pragma unroll
                for (int pt = 0; pt < 4; ++pt) { const bf16x8 ah = (kn & 1) ? ah1[pt] : ah0[pt];
#pragma unroll
                    for (int l4 = 0; l4 < 2; ++l4) acc[pt][l4] = MFMA16(ah, bfr[l4], acc[pt][l4]); }
                if (kn < 2) {
#pragma unroll
                    for (int pt = 0; pt < 4; ++pt) { const bf16x8 t = *(const bf16x8*)(sth + (16 * pt + fio) * 128 + 32 * (kn + 2) + 8 * fqo); if (kn & 1) ah1[pt] = t; else ah0[pt] = t; } }
                asm volatile("" ::: "memory"); }
#pragma unroll
            for (int l4 = 0; l4 < 2; ++l4) { const float ea = __expf(ACS[16 * (2 * lh + l4) + fio]);
#pragma unroll
                for (int pt = 0; pt < 4; ++pt) acc[pt][l4] *= ea; }
            v2u zq[2][4];
#pragma unroll
            for (int l4 = 0; l4 < 2; ++l4)
#pragma unroll
                for (int pt = 0; pt < 4; ++pt) zq[l4][pt] = *(const v2u*)(ZX + (size_t)(tok0 + 16 * (2 * lh + l4) + fio) * XW + hh * 64 + 16 * pt + 4 * fqo);
#pragma unroll
            for (int l4 = 0; l4 < 2; ++l4) { const int lt = 2 * lh + l4, l = 16 * lt + fio; const float al = ACS[l];
#pragma unroll
                for (int ks = 0; ks < 4; ++ks) { if (32 * ks <= 16 * lt + 15) { const int s0 = 32 * ks + 8 * fqo;
                    const v4u cb8 = *(const LAS v4u*)(CB + l * 136 + s0);
                    const f32x4 as0 = *(const LAS f32x4*)(ACS + s0), as1 = *(const LAS f32x4*)(ACS + s0 + 4), dt0 = *(const LAS f32x4*)(DTW + s0), dt1 = *(const LAS f32x4*)(DTW + s0 + 4);
                    const float cbv[8] = {bflo(cb8.x), bfhi(cb8.x), bflo(cb8.y), bfhi(cb8.y), bflo(cb8.z), bfhi(cb8.z), bflo(cb8.w), bfhi(cb8.w)};
                    const float asv[8] = {as0.x, as0.y, as0.z, as0.w, as1.x, as1.y, as1.z, as1.w}, dtv[8] = {dt0.x, dt0.y, dt0.z, dt0.w, dt1.x, dt1.y, dt1.z, dt1.w};
                    float mv[8];
#pragma unroll
                    for (int e = 0; e < 8; ++e) { const int s = s0 + e; float v = (s <= l) ? cbv[e] * __expf(al - asv[e]) * dtv[e] : 0.f; if (s == l) v += Dh; mv[e] = v; }
                    const bf16x8 mf = pack8(mv);
#pragma unroll
                    for (int pt = 0; pt < 4; ++pt) acc[pt][l4] = MFMA16(Xf[pt][ks], mf, acc[pt][l4]); asm volatile("" ::: "memory"); } } }
#pragma unroll
            for (int l4 = 0; l4 < 2; ++l4) { const int l = 16 * (2 * lh + l4) + fio; float ssq = 0.f;
#pragma unroll
                for (int pt = 0; pt < 4; ++pt) { const v2u z = zq[l4][pt];
                    const float zv[4] = {bflo(z.x), bfhi(z.x), bflo(z.y), bfhi(z.y)};
#pragma unroll
                    for (int r = 0; r < 4; ++r) { const float yv = acc[pt][l4][r] * silu_f(zv[r]); acc[pt][l4][r] = yv; ssq += yv * yv; } }
                ssq += __shfl_xor(ssq, 16); ssq += __shfl_xor(ssq, 32);
                if (fqo == 0) RMS[wave * 128 + l] = ssq; asm volatile("" ::: "memory"); }
            __syncthreads();
#pragma unroll
            for (int l4 = 0; l4 < 2; ++l4) { const int l = 16 * (2 * lh + l4) + fio; float tot = 0.f;
#pragma unroll
                for (int w = 0; w < 8; ++w) tot += RMS[w * 128 + l];
                const float rstd = rsq_f(tot * (1.0f / 512.0f) + EPS);
#pragma unroll
                for (int pt = 0; pt < 4; ++pt) { const int col = hh * 64 + 16 * pt + 4 * fqo; const f32x4 gv = *(const f32x4*)(ng + col);
                    v2u w; w.x = pk2(acc[pt][l4][0] * rstd * gv.x, acc[pt][l4][1] * rstd * gv.y); w.y = pk2(acc[pt][l4][2] * rstd * gv.z, acc[pt][l4][3] * rstd * gv.w);
                    *(v2u*)(Y + (size_t)(tok0 + l) * DI + col) = w; } }
        }
        __syncthreads();
    }
}

constexpr int AT_K = 0, AT_V = 36864, AT_TAB = 73728, AT_END = 75776;
__device__ __forceinline__ void attn_phase(const Args& a, LAS unsigned char* lds, int tid, int wave, int lane) {
    unsigned char* ws = a.ws;
    const bf16* __restrict__ QKV = (const bf16*)(ws + WS_QKV); bf16* AO = (bf16*)(ws + WS_AO);
    LAS bf16* Ks = (LAS bf16*)(lds + AT_K); LAS bf16* Vs = (LAS bf16*)(lds + AT_V); LAS float* TAB = (LAS float*)(lds + AT_TAB);
    const float* __restrict__ qg = a.in[I_AQNG]; const float* __restrict__ kg = a.in[I_AKNG];
    const int fi = lane & 15, fq = lane >> 4;
    const int u0 = (int)((blockIdx.x & 7) * (gridDim.x >> 3) + (blockIdx.x >> 3));
    v4u kxn[4], vxn[4];
#define AT_LOAD_KV(uu) do { const int b_ = (uu) >> 8, nb_ = ((uu) >> 2) & 63, g_ = (uu) & 3; const int key_ = tid >> 1, half_ = tid & 1; \
        const bf16* kp_ = QKV + (ptrdiff_t)(b_ * SEQ + nb_ * 128 - 128 + key_) * QKVW + 1024 + g_ * 64 + 32 * half_; \
        _Pragma("unroll") for (int j = 0; j < 4; ++j) { kxn[j] = *(const v4u*)(kp_ + 8 * j); vxn[j] = *(const v4u*)(kp_ + 256 + 8 * j); } } while (0)
    if (u0 < BATCH * 64 * KVH) AT_LOAD_KV(u0);
    for (int u = u0; u < BATCH * 64 * KVH; u += gridDim.x) {
        const int b = u >> 8, nb = (u >> 2) & 63, g = u & 3; const int tokq0 = b * SEQ + nb * 128;
        { const int key = tid >> 1, half = tid & 1; const bool valid = (nb > 0) || (key >= 128);
            v4u kx[4], vx[4];
            {
#pragma unroll
                for (int j = 0; j < 4; ++j) { kx[j] = kxn[j]; vx[j] = vxn[j]; }
                if (!valid) {
#pragma unroll
                    for (int j = 0; j < 4; ++j) { kx[j] = (v4u){0u, 0u, 0u, 0u}; vx[j] = (v4u){0u, 0u, 0u, 0u}; } } }
            float kf[32]; float ss = 0.f;
#pragma unroll
            for (int j = 0; j < 4; ++j) { kf[8 * j + 0] = bflo(kx[j].x); kf[8 * j + 1] = bfhi(kx[j].x); kf[8 * j + 2] = bflo(kx[j].y); kf[8 * j + 3] = bfhi(kx[j].y);
                kf[8 * j + 4] = bflo(kx[j].z); kf[8 * j + 5] = bfhi(kx[j].z); kf[8 * j + 6] = bflo(kx[j].w); kf[8 * j + 7] = bfhi(kx[j].w); }
#pragma unroll
            for (int e = 0; e < 32; ++e) ss += kf[e] * kf[e];
            ss += __shfl_xor(ss, 1);
            const float r = rsq_f(ss * (1.0f / 64.0f) + EPS);
#pragma unroll
            for (int j = 0; j < 4; ++j) { float o[8];
#pragma unroll
                for (int e = 0; e < 8; ++e) o[e] = kf[8 * j + e] * r * kg[32 * half + 8 * j + e];
                *(LAS bf16x8*)(Ks + key * 72 + 32 * half + 8 * j) = pack8(o);
                *(LAS v4u*)(Vs + key * 72 + 32 * half + 8 * j) = vx[j]; } }
        { const int r = tid >> 7, dist = tid & 127; int bucket;
            if (dist < 16) bucket = dist; else { bucket = 16 + (int)(logf((float)dist / 16.0f) / logf(8.0f) * 16.0f); bucket = bucket < 31 ? bucket : 31; }
            TAB[r * 128 + dist] = a.in[I_RELB][bucket * 16 + 4 * g + r]; }
        __syncthreads();
        if (u + (int)gridDim.x < BATCH * 64 * KVH) AT_LOAD_KV(u + (int)gridDim.x);
        const int r = wave >> 1, hf = wave & 1, h = 4 * g + r; const float sink = a.in[I_ASINK][h];
        for (int qt = 0; qt < 4; ++qt) {
            const int qi0 = 64 * hf + 16 * qt;
            bf16x8 Qf[2];
            { const bf16* qp = QKV + (size_t)(tokq0 + qi0 + fi) * QKVW + h * 64 + 8 * fq;
                const v4u q0 = *(const v4u*)qp, q1 = *(const v4u*)(qp + 32);
                float f0[8] = {bflo(q0.x), bfhi(q0.x), bflo(q0.y), bfhi(q0.y), bflo(q0.z), bfhi(q0.z), bflo(q0.w), bfhi(q0.w)};
                float f1[8] = {bflo(q1.x), bfhi(q1.x), bflo(q1.y), bfhi(q1.y), bflo(q1.z), bfhi(q1.z), bflo(q1.w), bfhi(q1.w)};
                float ss = 0.f;
#pragma unroll
                for (int e = 0; e < 8; ++e) ss += f0[e] * f0[e] + f1[e] * f1[e];
                ss += __shfl_xor(ss, 16); ss += __shfl_xor(ss, 32);
                const float rs = 0.125f * rsq_f(ss * (1.0f / 64.0f) + EPS);
#pragma unroll
                for (int e = 0; e < 8; ++e) { f0[e] *= rs * qg[8 * fq + e]; f1[e] *= rs * qg[32 + 8 * fq + e]; }
                Qf[0] = pack8(f0); Qf[1] = pack8(f1); }
            const int kt0 = (qi0 >> 4) < 6 ? (qi0 >> 4) : 6;
            f32x4 s[10];
#pragma unroll
            for (int kt = 0; kt < 10; ++kt) { const LAS bf16* kp = Ks + (16 * (kt0 + kt) + fi) * 72 + 8 * fq;
                f32x4 z = {0.f, 0.f, 0.f, 0.f};
                z = MFMA16(*(const LAS bf16x8*)kp, Qf[0], z); z = MFMA16(*(const LAS bf16x8*)(kp + 32), Qf[1], z); s[kt] = z; }
            const int qi = qi0 + fi; float mx = -__builtin_inff();
#pragma unroll
            for (int kt = 0; kt < 10; ++kt)
#pragma unroll
                for (int rr = 0; rr < 4; ++rr) { const int kj = 16 * (kt0 + kt) + 4 * fq + rr; const int dist = qi + 128 - kj;
                    const bool valid = (dist >= 0) && (dist < 128) && ((nb > 0) || (kj >= 128));
                    const float sc = valid ? s[kt][rr] + TAB[r * 128 + (dist & 127)] : -__builtin_inff();
                    s[kt][rr] = sc; mx = fmaxf(mx, sc); }
            mx = fmaxf(mx, __shfl_xor(mx, 16)); mx = fmaxf(mx, __shfl_xor(mx, 32)); mx = fmaxf(mx, sink);
            float sum = 0.f;
#pragma unroll
            for (int kt = 0; kt < 10; ++kt)
#pragma unroll
                for (int rr = 0; rr < 4; ++rr) { const float p = __expf(s[kt][rr] - mx); s[kt][rr] = p; sum += p; }
            sum += __shfl_xor(sum, 16); sum += __shfl_xor(sum, 32);
            const float inv = rcp_f(sum + __expf(sink - mx));
            f32x4 o[4];
#pragma unroll
            for (int dt = 0; dt < 4; ++dt) o[dt] = (f32x4){0.f, 0.f, 0.f, 0.f};
#pragma unroll
            for (int kk = 0; kk < 5; ++kk) {
                const float pv[8] = {s[2 * kk][0], s[2 * kk][1], s[2 * kk][2], s[2 * kk][3], s[2 * kk + 1][0], s[2 * kk + 1][1], s[2 * kk + 1][2], s[2 * kk + 1][3]};
                const bf16x8 pf = pack8(pv);
#pragma unroll
                for (int dt = 0; dt < 4; ++dt) {
                    const LAS bf16* vp0 = Vs + (16 * (kt0 + 2 * kk) + 4 * fq + (fi >> 2)) * 72 + 16 * dt + 4 * (fi & 3);
                    const v4i16_t t0 = __builtin_amdgcn_ds_read_tr16_b64_v4i16((LAS v4i16_t*)vp0);
                    const v4i16_t t1 = __builtin_amdgcn_ds_read_tr16_b64_v4i16((LAS v4i16_t*)(vp0 + 16 * 72));
                    const bf16x8 vf = {t0[0], t0[1], t0[2], t0[3], t1[0], t1[1], t1[2], t1[3]};
                    o[dt] = MFMA16(vf, pf, o[dt]); } }
            bf16* op = AO + (size_t)(tokq0 + qi) * 1024 + h * 64 + 4 * fq;
#pragma unroll
            for (int dt = 0; dt < 4; ++dt) { v2u w; w.x = pk2(o[dt][0] * inv, o[dt][1] * inv); w.y = pk2(o[dt][2] * inv, o[dt][3] * inv); *(v2u*)(op + 16 * dt) = w; }
        }
        __syncthreads();
    }
}

constexpr int NPHASE = 20;
constexpr int BG6_PER = 8, BG6 = 256 * BG6_PER;
constexpr int BGQ9 = 4, BGQ10 = 3, BGQ12 = 3;
__device__ __forceinline__ int bg_done9(int nt) { const int r = (nt * 8) & 255; return BG6 + (r ? (256 - r) * BGQ9 : 0); }
__device__ __forceinline__ int bg_done10(int nt) { const int r = (nt * 4) & 255; return bg_done9(nt) + (r ? (256 - r) * BGQ10 : 0); }
__global__ void __launch_bounds__(NTHR, 2) fwd_kernel(Args args) {
    extern __shared__ __attribute__((aligned(16))) unsigned char lds_raw[];
    LAS unsigned char* lds = (LAS unsigned char*)lds_raw;
    volatile LAS unsigned* MISC = (volatile LAS unsigned*)(lds + MISC_OFF);
    const int tid = threadIdx.x, lane = tid & 63, wave = __builtin_amdgcn_readfirstlane(tid >> 6);
    const int G = gridDim.x;
    unsigned char* ws = args.ws;
    gu32* ctl = (gu32*)(ws + WS_CTL);
    for (int u = tid; u < (LDS_BYTES - LDSCTL_OFF) / 4; u += NTHR) ((LAS unsigned*)(lds + LDSCTL_OFF))[u] = 0u;
    __syncthreads();
    XcdBarrier bar = xcd_barrier_post((unsigned*)(ctl + CW_BAR), MISC + 8);
    const int lo = args.ph_lo, hi = args.ph_hi;
    int nt_l0 = 256;
#ifndef PROBE_MASK
#define PROBE_MASK 0
#endif
#define PROBE_REP(k) ((int)(((unsigned)PROBE_MASK >> (k)) & 1u))
#define PHASE(k, ...) do { if (IN(k)) { __VA_ARGS__ } if (IN(k) && PROBE_REP(k)) { __VA_ARGS__ } } while (0)
#ifdef ONLYMASK
#define IN(k) (((ONLYMASK >> (k)) & 1) && lo <= (k) && (k) < hi)
#else
#define IN(k) (lo <= (k) && (k) < hi)
#endif
#define SEAM(k) do { if (IN(k) && IN((k) + 1)) xcd_barrier(bar); } while (0)
    bf16* H = (bf16*)(ws + WS_H);
    float* X1 = (float*)(ws + WS_X1); float* X2 = (float*)(ws + WS_X2); float* X3 = (float*)(ws + WS_X3);
    float* GATE = (float*)(ws + WS_MISC + MISC_GATE);
    const unsigned char* YK = (const unsigned char*)(ws + WS_YK);

    PHASE(0,  p0_prologue(args, lds, wave, lane); p0_quant(args, lds, wave, lane); ); SEAM(0);
    PHASE(1,
        { const int gid = blockIdx.x * NTHR + tid; if (gid < 8192) { const int l = gid >> 12, w = (gid >> 11) & 1, b = (gid >> 10) & 1, col = gid & 1023; GATE[gid] = modval(args, l, b, (w ? 5120 : 2048) + col); } }
        norm_phase<0, false, true>(args, lds, 0, 0, args.in[I_X], nullptr, nullptr, nullptr, args.in[I_MINW] + XW, IN_DIM, args.in[I_MDTB], tid, wave, lane);
    ); SEAM(1);
    PHASE(2,  const bool grpA_ = (((int)blockIdx.x >> 3) & 1) == 0;
        if (grpA_) bg_run(args, lds, (int)blockIdx.x, 12, 256, wave, lane, 0);
        pg8::Gemm g{H, (const bf16*)(ws + WS_WIN), T, XW, D}; pg8::StaticOrder S; S.init(T, XW, G, (int)blockIdx.x);
        pg8::EpiBf16Q E{(bf16*)(ws + WS_ZX), XW, (const float*)(ws + WS_H + HS_OFF), (const float*)(ws + WS_WSC + WSC_IN)};
        pg8::gemm_phase<pg8::EpiBf16Q, pg8::StaticOrder, true, true>(lds + RING_OFF, g, S, E);
        if (!grpA_) bg_run(args, lds, (int)blockIdx.x, 12, 256, wave, lane, 0); ); SEAM(2);
    PHASE(3,  ssd_states(args, lds, tid, wave, lane); ); SEAM(3);
    PHASE(4,  ssd_scan(args, tid); ); SEAM(4);
    PHASE(5,  ssd_out(args, lds, tid, wave, lane); ); SEAM(5);
    PHASE(6,  const bool grpA6_ = (((int)blockIdx.x >> 3) & 1) == 0;
        if (!grpA6_) bg_run(args, lds, (int)blockIdx.x, BG6_PER, 256, wave, lane, 32);
        pg8::Gemm g{(const bf16*)(ws + WS_Y), (const bf16*)(ws + WS_WOUT), T, D, DI}; pg8::StaticOrder S; S.init(T, D, G, (int)blockIdx.x);
        pg8::EpiResid E{args.in[I_X], X1, GATE + (0 * 2 + 0) * 2048};
        pg8::gemm_phase<pg8::EpiResid, pg8::StaticOrder, true, true>(lds + RING_OFF, g, S, E);
        if (grpA6_) bg_run(args, lds, (int)blockIdx.x, BG6_PER, 256, wave, lane, 32); ); SEAM(6);
#define MOE_PHASES(layer, pb, xres) \
    PHASE(pb,  norm_phase<1, false, true>(args, lds, layer, 1, xres, nullptr, nullptr, nullptr, args.in[I_RW] + (size_t)(layer) * 1024 * 32, 32, args.in[I_RB] + (layer) * 32, tid, wave, lane); ); SEAM(pb); \
    PHASE((pb) + 1,  moe_scatter(args, lds, tid, wave, lane); \
        if ((layer) == 1) { const int d_ = bg_done10(nt_l0) + 128 * BGQ12; bg_run(args, lds, d_ + (int)blockIdx.x, 16, 256, wave, lane); } ); SEAM((pb) + 1); \
    PHASE((pb) + 2,  load_tile_table(args, lds, tid); \
        const volatile LAS int* TE = (const volatile LAS int*)(lds + TE_OFF); \
        pg8::Gemm g{(const bf16*)(ws + WS_H), (const bf16*)(ws + WS_W1 + (size_t)(layer) * 32 * 2048 * 1024), CAP, 32 * 2048, D}; \
        pg8::MoeGatherOrder S{(int)TE[MAXTILES], 8, G, (int)((blockIdx.x & 7) * 32 + (blockIdx.x >> 3)), TE, (const int*)(ws + WS_XG), (LAS int*)(lds + ROWT_OFF)}; \
        pg8::EpiSwigluQ E{(unsigned char*)(ws + WS_ACT), args.in[I_EB1] + (size_t)(layer) * 32 * 2048, (const float*)(ws + WS_XG + XGS_OFF), (const float*)(ws + WS_WSC + WSC_W1) + (size_t)(layer) * 32 * 2048}; \
        pg8::gemm_phase<pg8::EpiSwigluQ, pg8::MoeGatherOrder, true, true>(lds + RING_OFF, g, S, E); \
        if ((layer) == 0) { const int nt_ = (int)TE[MAXTILES]; nt_l0 = nt_; const int r_ = (nt_ * 8) & 255, vc_ = (int)((blockIdx.x & 7) * 32 + (blockIdx.x >> 3)); if (r_ && vc_ >= r_) bg_run(args, lds, BG6 + (vc_ - r_) * BGQ9, BGQ9, 1, wave, lane); } ); SEAM((pb) + 2); \
    PHASE((pb) + 3,  load_tile_table(args, lds, tid); \
        const volatile LAS int* TE = (const volatile LAS int*)(lds + TE_OFF); \
        pg8::Gemm g{(const bf16*)(ws + WS_ACT), (const bf16*)(ws + WS_W2 + (size_t)(layer) * 32 * 1024 * 1024), CAP, 32 * 1024, FF}; \
        pg8::MoeOrder S{(int)TE[MAXTILES], 4, G, (int)((blockIdx.x & 7) * 32 + (blockIdx.x >> 3)), TE, nullptr, nullptr}; \
        pg8::EpiMoeOutF8 E{(unsigned char*)(ws + WS_YK), args.in[I_EB2] + (size_t)(layer) * 32 * 1024, (const float*)(ws + WS_WSC + WSC_W2) + (size_t)(layer) * 32 * 1024, (const int*)(ws + WS_SRT), (const float*)(ws + WS_SRT + 524288)}; \
        pg8::gemm_phase<pg8::EpiMoeOutF8, pg8::MoeOrder, true, true>(lds + RING_OFF, g, S, E); \
        if ((layer) == 0) { const int nt_ = (int)TE[MAXTILES]; const int r_ = (nt_ * 4) & 255, vc_ = (int)((blockIdx.x & 7) * 32 + (blockIdx.x >> 3)); if (r_ && vc_ >= r_) bg_run(args, lds, bg_done9(nt_) + (vc_ - r_) * BGQ10, BGQ10, 1, wave, lane); } ); SEAM((pb) + 3);

    MOE_PHASES(0, 7, X1)
    PHASE(11,  norm_phase<2, true, true>(args, lds, 1, 0, X1, GATE + (0 * 2 + 1) * 2048, YK, X2, nullptr, 0, nullptr, tid, wave, lane); ); SEAM(11);
    PHASE(12,  pg8::Gemm g{H, (const bf16*)(ws + WS_WQKV), T, QKVW, D}; pg8::StaticOrder S; S.init(T, QKVW, G, (int)blockIdx.x);
        pg8::EpiBf16Q E{(bf16*)(ws + WS_QKV), QKVW, (const float*)(ws + WS_H + HS_OFF), (const float*)(ws + WS_WSC + WSC_QKV)};
        pg8::gemm_phase<pg8::EpiBf16Q, pg8::StaticOrder, true, true>(lds + RING_OFF, g, S, E);
        if ((int)blockIdx.x >= 128) bg_run(args, lds, bg_done10(nt_l0) + ((int)blockIdx.x - 128) * BGQ12, BGQ12, 1, wave, lane); ); SEAM(12);
    PHASE(13,  attn_phase(args, lds, tid, wave, lane); ); SEAM(13);
    PHASE(14,  pg8::Gemm g{(const bf16*)(ws + WS_AO), (const bf16*)(ws + WS_WAO), T, D, D}; pg8::StaticOrder S; S.init(T, D, G, (int)blockIdx.x);
        pg8::EpiResid E{X2, X3, GATE + (1 * 2 + 0) * 2048};
        pg8::gemm_phase<pg8::EpiResid, pg8::StaticOrder, true, true>(lds + RING_OFF, g, S, E); ); SEAM(14);
    MOE_PHASES(1, 15, X3)
    PHASE(19,  norm_phase<2, true, false>(args, lds, 1, 0, X3, GATE + (1 * 2 + 1) * 2048, YK, args.out, nullptr, 0, nullptr, tid, wave, lane); );
#undef MOE_PHASES
#undef IN
#undef SEAM
}

extern "C" void kernel_launch(void* const* d_in, const int* in_sizes, int n_in, void* d_out, int out_size, void* d_ws, size_t ws_size, hipStream_t stream) {
    static int grid = 0;
    if (grid == 0) {
        if (n_in != 26 || in_sizes[0] != T * D || out_size != T * D || ws_size < WS_END) { fprintf(stderr, "kernel_launch: unexpected shapes (n_in %d, in0 %d, out %d, ws %zu)\n", n_in, n_in > 0 ? in_sizes[0] : -1, out_size, ws_size); grid = -1; return; }
        if (hipFuncSetAttribute((const void*)fwd_kernel, hipFuncAttributeMaxDynamicSharedMemorySize, LDS_BYTES) != hipSuccess) { fprintf(stderr, "kernel_launch: hipFuncSetAttribute failed\n"); grid = -1; return; }
        int per_cu = 0;
        if (hipOccupancyMaxActiveBlocksPerMultiprocessor(&per_cu, (const void*)fwd_kernel, NTHR, LDS_BYTES) != hipSuccess || per_cu < 1) fprintf(stderr, "kernel_launch: occupancy query reports %d\n", per_cu);
        (void)hipGetLastError();
        grid = 256;
    }
    if (grid < 0) return;
    if (hipMemsetAsync((char*)d_ws + WS_CTL, 0, CTL_ZERO_BYTES, stream) != hipSuccess) { fprintf(stderr, "kernel_launch: memset failed\n"); return; }
    Args a{};
    for (int i = 0; i < 26; ++i) a.in[i] = (const float*)d_in[i];
    a.out = (float*)d_out; a.ws = (unsigned char*)d_ws;
#ifndef MK_SPLIT
    a.ph_lo = 0; a.ph_hi = NPHASE;
    hipLaunchKernelGGL(fwd_kernel, dim3(grid), dim3(NTHR), LDS_BYTES, stream, a);
#else
    for (int p = 0; p < NPHASE; ++p) { a.ph_lo = p; a.ph_hi = p + 1; hipLaunchKernelGGL(fwd_kernel, dim3(grid), dim3(NTHR), LDS_BYTES, stream, a); }
#endif
}
```

```cpp
#include <hip/hip_runtime.h>
#include <cstdio>
#include <cstdint>

#define GAS __attribute__((address_space(1)))
#define LAS __attribute__((address_space(3)))
typedef unsigned short bf16;
typedef unsigned v4u __attribute__((ext_vector_type(4)));
typedef unsigned v2u __attribute__((ext_vector_type(2)));
typedef float f32x4 __attribute__((ext_vector_type(4)));
typedef short bf16x8 __attribute__((ext_vector_type(8)));
typedef short v4i16_t __attribute__((ext_vector_type(4)));
typedef GAS unsigned gu32;

namespace pg8 {
#define PG8_LAS __attribute__((address_space(3)))
typedef unsigned short bf16_t;
typedef unsigned u32x4 __attribute__((ext_vector_type(4)));
typedef int i32x4 __attribute__((ext_vector_type(4)));
constexpr int BM = 256, BK = 64, HALF = 128, HTB = HALF * BK * 2, STAGE_BYTES = 8 * HTB, NXCD = 8, WGM = 8;
__host__ __device__ __forceinline__ int lds_byte(int r, int c) { const int st = (r >> 4) * 2 + (c >> 5), rr = r & 15, cc = c & 31, ob = rr * 64 + cc * 2; return st * 1024 + (ob ^ (((ob >> 9) & 1) << 5)); }
__host__ __device__ __forceinline__ void stage_rc(int b, int& R, int& C) { const int st = b / 1024, sb = b % 1024, swz = sb ^ (((sb >> 9) & 1) << 5); R = (st >> 1) * 16 + swz / 64; C = (st & 1) * 32 + (swz % 64) / 2; }
__host__ __device__ __forceinline__ int perm32(int rho) { const int n = rho >> 4, i = rho & 15; return 8 * (i >> 2) + 4 * n + (i & 3); }
struct Unit { int pm, pn; };
struct Gemm { const bf16_t* A; const bf16_t* Bt; int M, N, K; };
struct StaticOrder {
    int nM, nN, nwg, G, c;
    __host__ __device__ void init(int M, int N, int G_, int c_) { nM = M / BM; nN = N / BM; nwg = nM * nN; G = G_; c = c_; }
    __host__ __device__ bool next(int i, Unit& u) const {
        const long L = (long)i * G + c; if (L >= nwg) return false;
        int wgid = (int)L; { const int q = nwg / NXCD, r = nwg % NXCD, xcd = wgid % NXCD, off = wgid / NXCD; wgid = (xcd < r ? xcd * (q + 1) : r * (q + 1) + (xcd - r) * q) + off; }
        const int nig = WGM * nN, gid = wgid / nig, fm = gid * WGM, gsz = (nM - fm) < WGM ? (nM - fm) : WGM;
        u.pm = fm + ((wgid % nig) % gsz); u.pn = (wgid % nig) / gsz; return true;
    }
    static constexpr bool GATHER = false; const int* rowoff = nullptr; PG8_LAS int* rowt = nullptr;
    __device__ __forceinline__ void a_ready(const Unit&) const {}
    __device__ __forceinline__ void done(const Unit&) const {}
};
template <bool GATHER_> struct MoeOrderT {
    static constexpr bool GATHER = GATHER_;
    int ntiles, NT, G, c; const volatile PG8_LAS int* te; const int* rowoff; PG8_LAS int* rowt;
    __device__ bool next(int i, Unit& u) const {
        const int L = i * G + c; if (L >= ntiles * NT) return false;
        const int tile = L / NT, n = L % NT; const int e = __builtin_amdgcn_readfirstlane(te[tile]);
        u.pm = tile; u.pn = e * NT + n; return true;
    }
    __device__ __forceinline__ void a_ready(const Unit&) const {}
    __device__ __forceinline__ void done(const Unit&) const {}
};
typedef MoeOrderT<false> MoeOrder; typedef MoeOrderT<true> MoeGatherOrder;
__device__ __forceinline__ unsigned cvt_pk_bf16(float lo, float hi) { unsigned r; asm volatile("v_cvt_pk_bf16_f32 %0, %1, %2" : "=v"(r) : "v"(lo), "v"(hi)); return r; }

struct EpiBf16 {
    static constexpr int NSTAGE = 0; __device__ __forceinline__ const void* stage_src(int, const Unit&) const { return nullptr; }
    static constexpr bool PERM = true, AFTER_DRAIN = false; static constexpr int MODE = 0; typedef f32x4 acc_t;
    bf16_t* O; int ldc;
    __device__ __forceinline__ void operator()(const f32x4 (&acc)[2][2][4][2], const Unit& u, int wr, int wc, int fr, int fq, const PG8_LAS unsigned char* xl) const {
        const int row0 = u.pm * BM + wr * 64 + fr, col0 = u.pn * BM + wc * 32 + 8 * fq;
#pragma unroll
        for (int ai = 0; ai < 2; ++ai)
#pragma unroll
            for (int m = 0; m < 4; ++m) { bf16_t* rowp = O + (size_t)(row0 + ai * HALF + m * 16) * ldc + col0;
#pragma unroll
                for (int bj = 0; bj < 2; ++bj) { const f32x4 v0 = acc[ai][bj][m][0], v1 = acc[ai][bj][m][1];
                    u32x4 w; w.x = cvt_pk_bf16(v0[0], v0[1]); w.y = cvt_pk_bf16(v0[2], v0[3]); w.z = cvt_pk_bf16(v1[0], v1[1]); w.w = cvt_pk_bf16(v1[2], v1[3]);
                    *(u32x4*)(rowp + bj * HALF) = w; } }
    }
};
struct EpiResid {
    static constexpr int NSTAGE = 0; __device__ __forceinline__ const void* stage_src(int, const Unit&) const { return nullptr; }
    static constexpr bool PERM = true, AFTER_DRAIN = false; static constexpr int MODE = 0; typedef f32x4 acc_t;
    const float* res; float* out; const float* gate;
    __device__ __forceinline__ void operator()(const f32x4 (&acc)[2][2][4][2], const Unit& u, int wr, int wc, int fr, int fq, const PG8_LAS unsigned char* xl) const {
        const int row0 = u.pm * BM + wr * 64 + fr, col0 = u.pn * BM + wc * 32 + 8 * fq; const int b = (u.pm * BM) >> 13;
        f32x4 gv[2][2];
#pragma unroll
        for (int bj = 0; bj < 2; ++bj)
#pragma unroll
            for (int n = 0; n < 2; ++n) gv[bj][n] = *(const f32x4*)(gate + b * 1024 + col0 + bj * HALF + 4 * n);
#pragma unroll
        for (int ai = 0; ai < 2; ++ai)
#pragma unroll
            for (int m = 0; m < 4; ++m) { const size_t off = (size_t)(row0 + ai * HALF + m * 16) * 1024 + col0;
#pragma unroll
                for (int bj = 0; bj < 2; ++bj)
#pragma unroll
                    for (int n = 0; n < 2; ++n) { const f32x4 r4 = *(const f32x4*)(res + off + bj * HALF + 4 * n);
                        *(f32x4*)(out + off + bj * HALF + 4 * n) = r4 + gv[bj][n] * acc[ai][bj][m][n]; } }
    }
};
struct EpiSwiglu {
    static constexpr int NSTAGE = 0; __device__ __forceinline__ const void* stage_src(int, const Unit&) const { return nullptr; }
    static constexpr bool PERM = true, AFTER_DRAIN = false; static constexpr int MODE = 0; typedef f32x4 acc_t;
    bf16_t* act; const float* b1;
    __device__ __forceinline__ void operator()(const f32x4 (&acc)[2][2][4][2], const Unit& u, int wr, int wc, int fr, int fq, const PG8_LAS unsigned char* xl) const {
        const int row0 = u.pm * BM + wr * 64 + fr; const int e = u.pn >> 3, ntile = u.pn & 7;
        const int c0 = ntile * BM + wc * 32 + 8 * fq;
        f32x4 bv[2][2];
#pragma unroll
        for (int bj = 0; bj < 2; ++bj)
#pragma unroll
            for (int n = 0; n < 2; ++n) bv[bj][n] = *(const f32x4*)(b1 + e * 2048 + c0 + bj * HALF + 4 * n);
#pragma unroll
        for (int ai = 0; ai < 2; ++ai)
#pragma unroll
            for (int m = 0; m < 4; ++m) { bf16_t* rowp = act + (size_t)(row0 + ai * HALF + m * 16) * 1024 + (c0 >> 1);
#pragma unroll
                for (int bj = 0; bj < 2; ++bj) { const f32x4 v0 = acc[ai][bj][m][0] + bv[bj][0], v1 = acc[ai][bj][m][1] + bv[bj][1];
                    float o[4];
                    const float g[4] = {v0[0], v0[2], v1[0], v1[2]}, l[4] = {v0[1], v0[3], v1[1], v1[3]};
#pragma unroll
                    for (int t = 0; t < 4; ++t) { const float xg = fminf(g[t], 7.0f), xl = fminf(fmaxf(l[t], -7.0f), 7.0f);
                        o[t] = xg * __builtin_amdgcn_rcpf(1.0f + __expf(-1.702f * xg)) * (xl + 1.0f); }
                    v2u w; w.x = cvt_pk_bf16(o[0], o[1]); w.y = cvt_pk_bf16(o[2], o[3]);
                    *(v2u*)(rowp + bj * (HALF / 2)) = w; } }
    }
};
struct EpiMoeOut {
    static constexpr int NSTAGE = 0; __device__ __forceinline__ const void* stage_src(int, const Unit&) const { return nullptr; }
    static constexpr bool PERM = true, AFTER_DRAIN = false; static constexpr int MODE = 0; typedef f32x4 acc_t;
    bf16_t* yk; const float* b2; const int* srt_tok; const float* srt_gate;
    __device__ __forceinline__ void operator()(const f32x4 (&acc)[2][2][4][2], const Unit& u, int wr, int wc, int fr, int fq, const PG8_LAS unsigned char* xl) const {
        const int row0 = u.pm * BM + wr * 64 + fr; const int e = u.pn >> 2, ntile = u.pn & 3;
        const int c0 = ntile * BM + wc * 32 + 8 * fq;
        f32x4 bv[2][2];
#pragma unroll
        for (int bj = 0; bj < 2; ++bj)
#pragma unroll
            for (int n = 0; n < 2; ++n) bv[bj][n] = *(const f32x4*)(b2 + e * 1024 + c0 + bj * HALF + 4 * n);
#pragma unroll
        for (int ai = 0; ai < 2; ++ai)
#pragma unroll
            for (int m = 0; m < 4; ++m) { const int pos = row0 + ai * HALF + m * 16; const int id = srt_tok[pos]; const float gt = srt_gate[pos];
                if (id >= 0) { bf16_t* rowp = yk + (size_t)id * 1024 + c0;
#pragma unroll
                    for (int bj = 0; bj < 2; ++bj) { const f32x4 v0 = (acc[ai][bj][m][0] + bv[bj][0]) * gt, v1 = (acc[ai][bj][m][1] + bv[bj][1]) * gt;
                        u32x4 w; w.x = cvt_pk_bf16(v0[0], v0[1]); w.y = cvt_pk_bf16(v0[2], v0[3]); w.z = cvt_pk_bf16(v1[0], v1[1]); w.w = cvt_pk_bf16(v1[2], v1[3]);
                        *(u32x4*)(rowp + bj * HALF) = w; } } }
    }
};

struct EpiBf16Q {
    static constexpr bool PERM = true, AFTER_DRAIN = false; static constexpr int MODE = 1; typedef i32x4 acc_t;
    bf16_t* O; int ldc; const float* sa; const float* sb;
    static constexpr int NSTAGE = 2; __device__ __forceinline__ const void* stage_src(int k, const Unit& u) const { return k == 0 ? (const void*)(sa + u.pm * BM) : (const void*)(sb + u.pn * BM); }
    __device__ __forceinline__ void operator()(const i32x4 (&acc)[2][2][4][2], const Unit& u, int wr, int wc, int fr, int fq, const PG8_LAS unsigned char* xl) const {
        const int row0 = u.pm * BM + wr * 64 + fr, col0 = u.pn * BM + wc * 32 + 8 * fq;
        f32x4 sv[2][2];
#pragma unroll
        for (int bj = 0; bj < 2; ++bj)
#pragma unroll
            for (int n = 0; n < 2; ++n) sv[bj][n] = *(const PG8_LAS f32x4*)(xl + 1024 + (wc * 32 + 8 * fq + bj * HALF + 4 * n) * 4);
#pragma unroll
        for (int ai = 0; ai < 2; ++ai)
#pragma unroll
            for (int m = 0; m < 4; ++m) { const int row = row0 + ai * HALF + m * 16; const float s = *(const PG8_LAS float*)(xl + (wr * 64 + fr + ai * HALF + m * 16) * 4); bf16_t* rowp = O + (size_t)row * ldc + col0;
#pragma unroll
                for (int bj = 0; bj < 2; ++bj) { const f32x4 v0 = __builtin_convertvector(acc[ai][bj][m][0], f32x4) * (sv[bj][0] * s), v1 = __builtin_convertvector(acc[ai][bj][m][1], f32x4) * (sv[bj][1] * s);
                    u32x4 w; w.x = cvt_pk_bf16(v0[0], v0[1]); w.y = cvt_pk_bf16(v0[2], v0[3]); w.z = cvt_pk_bf16(v1[0], v1[1]); w.w = cvt_pk_bf16(v1[2], v1[3]);
                    *(u32x4*)(rowp + bj * HALF) = w; } }
    }
};
struct EpiSwigluQ {
    static constexpr bool PERM = true, AFTER_DRAIN = false; static constexpr int MODE = 1; typedef i32x4 acc_t;
    unsigned char* act; const float* b1; const float* sa; const float* sb;
    static constexpr int NSTAGE = 3;
    __device__ __forceinline__ const void* stage_src(int k, const Unit& u) const { const int e = u.pn >> 3, ntile = u.pn & 7;
        return k == 0 ? (const void*)(sa + u.pm * BM) : (k == 1 ? (const void*)(b1 + e * 2048 + ntile * BM) : (const void*)(sb + e * 2048 + ntile * BM)); }
    __device__ __forceinline__ void operator()(const i32x4 (&acc)[2][2][4][2], const Unit& u, int wr, int wc, int fr, int fq, const PG8_LAS unsigned char* xl) const {
        const int row0 = u.pm * BM + wr * 64 + fr; const int e = u.pn >> 3, ntile = u.pn & 7;
        const int c0 = ntile * BM + wc * 32 + 8 * fq;
        f32x4 bv[2][2], sv[2][2];
#pragma unroll
        for (int bj = 0; bj < 2; ++bj)
#pragma unroll
            for (int n = 0; n < 2; ++n) { const int cl = (wc * 32 + 8 * fq + bj * HALF + 4 * n) * 4; bv[bj][n] = *(const PG8_LAS f32x4*)(xl + 1024 + cl); sv[bj][n] = *(const PG8_LAS f32x4*)(xl + 2048 + cl); }
#pragma unroll
        for (int ai = 0; ai < 2; ++ai)
#pragma unroll
            for (int m = 0; m < 4; ++m) { const int row = row0 + ai * HALF + m * 16; const float s = *(const PG8_LAS float*)(xl + (wr * 64 + fr + ai * HALF + m * 16) * 4); unsigned char* rowp = act + (size_t)row * 1024 + (c0 >> 1);
#pragma unroll
                for (int bj = 0; bj < 2; ++bj) { const f32x4 v0 = __builtin_convertvector(acc[ai][bj][m][0], f32x4) * (sv[bj][0] * s) + bv[bj][0], v1 = __builtin_convertvector(acc[ai][bj][m][1], f32x4) * (sv[bj][1] * s) + bv[bj][1];
                    float o[4];
                    const float g[4] = {v0[0], v0[2], v1[0], v1[2]}, l[4] = {v0[1], v0[3], v1[1], v1[3]};
#pragma unroll
                    for (int t = 0; t < 4; ++t) { const float xg = fminf(g[t], 7.0f), xl = fminf(fmaxf(l[t], -7.0f), 7.0f);
                        const float tg = xg * __builtin_amdgcn_rcpf(1.0f + __builtin_amdgcn_exp2f(xg * -2.4554669595930156f)); o[t] = __builtin_fmaf(tg, xl, tg); }
                    int w = __builtin_amdgcn_cvt_pk_fp8_f32(o[0], o[1], 0, false); w = __builtin_amdgcn_cvt_pk_fp8_f32(o[2], o[3], w, true);
                    *(int*)(rowp + bj * (HALF / 2)) = w; } }
    }
};
struct EpiMoeOutF8 {
    static constexpr bool PERM = true, AFTER_DRAIN = false; static constexpr int MODE = 2; typedef f32x4 acc_t;
    unsigned char* yk; const float* b2; const float* sb; const int* srt_tok; const float* srt_gate;
    static constexpr int NSTAGE = 4;
    __device__ __forceinline__ const void* stage_src(int k, const Unit& u) const { const int e = u.pn >> 2, ntile = u.pn & 3;
        return k == 0 ? (const void*)(b2 + e * 1024 + ntile * BM) : (k == 1 ? (const void*)(sb + e * 1024 + ntile * BM) : (k == 2 ? (const void*)(srt_tok + u.pm * BM) : (const void*)(srt_gate + u.pm * BM))); }
    __device__ __forceinline__ void operator()(const f32x4 (&acc)[2][2][4][2], const Unit& u, int wr, int wc, int fr, int fq, const PG8_LAS unsigned char* xl) const {
        const int row0 = u.pm * BM + wr * 64 + fr; const int e = u.pn >> 2, ntile = u.pn & 3;
        const int c0 = ntile * BM + wc * 32 + 8 * fq;
#pragma unroll
        for (int bj = 0; bj < 2; ++bj) { f32x4 bv[2], sv[2];
#pragma unroll
            for (int n = 0; n < 2; ++n) { const int cl = (wc * 32 + 8 * fq + bj * HALF + 4 * n) * 4; bv[n] = *(const PG8_LAS f32x4*)(xl + cl); sv[n] = *(const PG8_LAS f32x4*)(xl + 1024 + cl); }
#pragma unroll
            for (int ai = 0; ai < 2; ++ai)
#pragma unroll
                for (int m = 0; m < 4; ++m) { const int rl = (wr * 64 + fr + ai * HALF + m * 16) * 4; const int id = *(const PG8_LAS int*)(xl + 2048 + rl); const float gt = *(const PG8_LAS float*)(xl + 3072 + rl);
                    if (id >= 0) { const f32x4 v0 = (acc[ai][bj][m][0] * sv[0] + bv[0]) * gt, v1 = (acc[ai][bj][m][1] * sv[1] + bv[1]) * gt;
                        int w0 = __builtin_amdgcn_cvt_pk_fp8_f32(v0[0], v0[1], 0, false); w0 = __builtin_amdgcn_cvt_pk_fp8_f32(v0[2], v0[3], w0, true);
                        int w1 = __builtin_amdgcn_cvt_pk_fp8_f32(v1[0], v1[1], 0, false); w1 = __builtin_amdgcn_cvt_pk_fp8_f32(v1[2], v1[3], w1, true);
                        v2u w; w.x = (unsigned)w0; w.y = (unsigned)w1;
                        *(v2u*)(yk + (size_t)id * 1024 + c0 + bj * HALF) = w; } }
            asm volatile("" ::: "memory"); }
    }
};


typedef int i32x8 __attribute__((ext_vector_type(8)));
struct Frag2 { bf16x8 h[2]; };
template <int MODE> struct FragOps { typedef Frag2 frag_t;
    static __device__ __forceinline__ Frag2 load(const PG8_LAS unsigned char* p) { Frag2 f; f.h[0] = *(const PG8_LAS bf16x8*)p; f.h[1] = *(const PG8_LAS bf16x8*)(p + 1024); return f; } };
template <> struct FragOps<2> { typedef i32x8 frag_t;
    static __device__ __forceinline__ i32x8 load(const PG8_LAS unsigned char* p) { const i32x4 lo = *(const PG8_LAS i32x4*)p, hi = *(const PG8_LAS i32x4*)(p + 1024); return __builtin_shufflevector(lo, hi, 0, 1, 2, 3, 4, 5, 6, 7); } };
template <int MODE> struct Mma;
template <> struct Mma<0> { static __device__ __forceinline__ f32x4 run(const Frag2& a, const Frag2& b, f32x4 c) { c = __builtin_amdgcn_mfma_f32_16x16x32_bf16(a.h[0], b.h[0], c, 0, 0, 0); return __builtin_amdgcn_mfma_f32_16x16x32_bf16(a.h[1], b.h[1], c, 0, 0, 0); } };
template <> struct Mma<1> { static __device__ __forceinline__ i32x4 run(const Frag2& a, const Frag2& b, i32x4 c) { c = __builtin_amdgcn_mfma_i32_16x16x64_i8(__builtin_bit_cast(i32x4, a.h[0]), __builtin_bit_cast(i32x4, b.h[0]), c, 0, 0, 0);
        return __builtin_amdgcn_mfma_i32_16x16x64_i8(__builtin_bit_cast(i32x4, a.h[1]), __builtin_bit_cast(i32x4, b.h[1]), c, 0, 0, 0); } };
template <> struct Mma<2> { static __device__ __forceinline__ f32x4 run(const i32x8& a, const i32x8& b, f32x4 c) {
        asm volatile("v_mfma_scale_f32_16x16x128_f8f6f4 %0, %1, %2, %0, %3, %3 op_sel_hi:[0,0,0]" : "+v"(c) : "v"(a), "v"(b), "v"(0x7F7F7F7F)); return c; } };

template <class Epi, class Sched, bool ALIGN_EPI = false, bool SP2 = false>
__device__ __forceinline__ void gemm_phase(PG8_LAS unsigned char* lds, const Gemm g, const Sched& S, const Epi& E, PG8_LAS unsigned char* xlds = nullptr) {
    const int tid = threadIdx.x, wid = __builtin_amdgcn_readfirstlane(tid >> 6), lane = tid & 63, wr = wid >> 2, wc = wid & 3, fr = lane & 15, fq = lane >> 4;
    constexpr int MODE = Epi::MODE; typedef typename Epi::acc_t acc_t;
    const int rowb = MODE ? g.K : g.K * 2, nt = rowb / (BK * 2);
    unsigned voffA[2], voffB[2];
#pragma unroll
    for (int i = 0; i < 2; ++i) { int R, C; stage_rc(tid * 16 + i * 8192, R, C); const int Rb = Epi::PERM ? ((R & ~31) + perm32(R & 31)) : R;
        voffA[i] = (unsigned)(R * rowb + C * 2); voffB[i] = (unsigned)(Rb * rowb + C * 2); }
    const size_t kstep = (size_t)(BK * 2);
    const size_t hstep = (size_t)HALF * rowb;
    const size_t tstep = 2 * hstep;
    const unsigned ldsw = (unsigned)wid * 1024u;
    const int aoff = lds_byte(wr * 64 + fr, fq * 8), boff = lds_byte(wc * 32 + fr, fq * 8);
    constexpr bool GATHER = Sched::GATHER;
    int gR[2]; unsigned gC[2]; unsigned gA[2][2], gN[2][2];
#pragma unroll
    for (int i = 0; i < 2; ++i) { int R, C; stage_rc(tid * 16 + i * 8192, R, C); gR[i] = R; gC[i] = (unsigned)(C * 2);
#pragma unroll
        for (int h = 0; h < 2; ++h) { gA[h][i] = 0u; gN[h][i] = 0u; } }
#define PG8_SA(b, h) (((b) * 2 + (h)) * HTB)
#define PG8_SB(b, h) ((4 + (b) * 2 + (h)) * HTB)
#define PG8_STAGE(bufoff, gbase, voff) do { _Pragma("unroll") for (int _i = 0; _i < 2; ++_i) \
        __builtin_amdgcn_global_load_lds((const unsigned*)((const char*)(gbase) + (voff)[_i]), (PG8_LAS unsigned*)(lds + (bufoff) + ldsw + _i * 8192), 16, 0, 0); } while (0)
#define PG8_STA(bufoff, h, nxsel, kb) do { if constexpr (GATHER) { unsigned o_[2] = {(nxsel) ? gN[h][0] : gA[h][0], (nxsel) ? gN[h][1] : gA[h][1]}; PG8_STAGE(bufoff, (const char*)g.A + (kb), o_); } \
        else { PG8_STAGE(bufoff, ((nxsel) ? nA : cA) + (size_t)(h) * hstep + (kb), voffA); } } while (0)
#define PG8_ROWT_ISSUE(slot, pm) do { if constexpr (GATHER) { if (wid < 4) __builtin_amdgcn_global_load_lds((const unsigned*)(S.rowoff + (size_t)(pm) * BM + wid * 64 + lane), (PG8_LAS unsigned*)(S.rowt + (slot) * 256 + wid * 64), 4, 0, 0); } } while (0)
#define PG8_ROWT_READ(dst, slot) do { if constexpr (GATHER) { _Pragma("unroll") for (int h_ = 0; h_ < 2; ++h_) _Pragma("unroll") for (int i_ = 0; i_ < 2; ++i_) dst[h_][i_] = (unsigned)S.rowt[(slot) * 256 + h_ * HALF + gR[i_]] + gC[i_]; } } while (0)
#define PG8_EPI_ISSUE(slot, U) do { if constexpr (Epi::NSTAGE > 0) { if (wid < Epi::NSTAGE) __builtin_amdgcn_global_load_lds((const unsigned*)((const char*)E.stage_src(wid, U) + lane * 16), (PG8_LAS unsigned*)(xlds + (slot) * 4096 + wid * 1024), 16, 0, 0); } } while (0)
#define PG8_LDA(dst, b, h) do { _Pragma("unroll") for (int m = 0; m < 4; ++m) dst[m] = FragOps<MODE>::load(lds + PG8_SA(b, h) + aoff + m * 2048); } while (0)
#define PG8_LDB(dst, b, h) do { _Pragma("unroll") for (int n = 0; n < 2; ++n) dst[n] = FragOps<MODE>::load(lds + PG8_SB(b, h) + boff + n * 2048); } while (0)
#define PG8_MMA(ai, bj, At, Bt) do { __builtin_amdgcn_s_setprio(1); _Pragma("unroll") for (int m = 0; m < 4; ++m) _Pragma("unroll") for (int n = 0; n < 2; ++n) \
        acc[ai][bj][m][n] = Mma<MODE>::run(Bt[n], At[m], acc[ai][bj][m][n]); __builtin_amdgcn_s_setprio(0); } while (0)
#define PG8_WAIT_V(n) asm volatile("s_waitcnt vmcnt(" #n ")" ::: "memory")
#define PG8_WAIT_L(n) asm volatile("s_waitcnt lgkmcnt(" #n ")" ::: "memory")
#define PG8_BAR __builtin_amdgcn_s_barrier()
#define PG8_SCHED __builtin_amdgcn_sched_barrier(0)
    Unit cur, nxt; int ui = 0;
    if (!S.next(0, cur)) return;
    acc_t acc[2][2][4][2];
#pragma unroll
    for (int a = 0; a < 2; ++a)
#pragma unroll
        for (int b = 0; b < 2; ++b)
#pragma unroll
            for (int m = 0; m < 4; ++m)
#pragma unroll
                for (int n = 0; n < 2; ++n) acc[a][b][m][n] = (acc_t)0;
    typename FragOps<MODE>::frag_t At[4], B0[2], B1[2];
    const char* cA = (const char*)g.A + (size_t)cur.pm * tstep; const char* cB = (const char*)g.Bt + (size_t)cur.pn * tstep; const char* nA = cA;
    S.a_ready(cur);
    PG8_EPI_ISSUE(0, cur);
    if constexpr (GATHER) { PG8_ROWT_ISSUE(0, cur.pm); PG8_WAIT_V(0); __syncthreads(); PG8_ROWT_READ(gA, 0); PG8_WAIT_L(0); }
    if constexpr (SP2) {
        PG8_STAGE(PG8_SB(0, 0), cB, voffB); PG8_STAGE(PG8_SB(0, 1), cB + hstep, voffB); PG8_STA(PG8_SA(0, 0), 0, false, 0); PG8_STA(PG8_SA(0, 1), 1, false, 0);
        if (wr == 1) PG8_BAR;
        PG8_WAIT_V(2); PG8_BAR;
        PG8_STAGE(PG8_SB(1, 0), cB + kstep, voffB); PG8_STA(PG8_SA(1, 0), 0, false, kstep); PG8_STAGE(PG8_SB(1, 1), cB + hstep + kstep, voffB);
        PG8_WAIT_V(6); PG8_BAR;
    } else {
        PG8_STAGE(PG8_SB(0, 0), cB, voffB); PG8_STAGE(PG8_SA(0, 0), cA, voffA); PG8_STAGE(PG8_SB(0, 1), cB + hstep, voffB); PG8_STAGE(PG8_SA(0, 1), cA + hstep, voffA);
        if (wr == 1) PG8_BAR;
        PG8_WAIT_V(4); PG8_BAR;
        PG8_STAGE(PG8_SB(1, 0), cB + kstep, voffB); PG8_STAGE(PG8_SA(1, 0), cA + kstep, voffA); PG8_STAGE(PG8_SB(1, 1), cB + hstep + kstep, voffB);
        PG8_WAIT_V(6); PG8_BAR;
    }
    for (;;) {
        const bool has_next = S.next(ui + 1, nxt);
        nA = has_next ? (const char*)g.A + (size_t)nxt.pm * tstep : cA; const char* nB = has_next ? (const char*)g.Bt + (size_t)nxt.pn * tstep : cB;
        if (has_next) { PG8_EPI_ISSUE((ui + 1) % 3, nxt); }
        if (has_next) PG8_ROWT_ISSUE((ui + 1) & 1, nxt.pm);
#pragma unroll 1
        for (int t = 0; t < nt; t += 2) {
            const bool last = (t == nt - 2);
            const char* a1 = cA + (size_t)(t + 1) * kstep;
            const char* a2 = last ? nA : cA + (size_t)(t + 2) * kstep; const char* b2 = last ? nB : cB + (size_t)(t + 2) * kstep;
            const char* a3 = a2 + kstep; const char* b3 = b2 + kstep;
            const size_t kb1 = (size_t)(t + 1) * kstep, kb2 = last ? 0 : (size_t)(t + 2) * kstep, kb3 = kb2 + kstep;
            if (last && has_next) S.a_ready(nxt);
            if constexpr (GATHER) { if (last) { if (has_next) { PG8_ROWT_READ(gN, (ui + 1) & 1); } else {
#pragma unroll
                        for (int h_ = 0; h_ < 2; ++h_) { gN[h_][0] = gA[h_][0]; gN[h_][1] = gA[h_][1]; } } } }
            if constexpr (SP2) {
            PG8_LDB(B0, 0, 0); PG8_LDB(B1, 0, 1); PG8_SCHED; PG8_LDA(At, 0, 0); PG8_STA(PG8_SA(1, 1), 1, false, kb1);
            PG8_WAIT_V(8); PG8_WAIT_L(0); PG8_BAR; PG8_MMA(0, 0, At, B0); PG8_MMA(0, 1, At, B1); PG8_BAR; PG8_SCHED;
            PG8_LDA(At, 0, 1); PG8_STAGE(PG8_SB(0, 0), b2, voffB); PG8_STAGE(PG8_SB(0, 1), b2 + hstep, voffB); PG8_STA(PG8_SA(0, 0), 0, last, kb2);
            PG8_WAIT_V(8); PG8_WAIT_L(0); PG8_BAR; PG8_MMA(1, 0, At, B0); PG8_MMA(1, 1, At, B1); PG8_BAR; PG8_SCHED;
            PG8_LDB(B0, 1, 0); PG8_LDB(B1, 1, 1); PG8_SCHED; PG8_LDA(At, 1, 0); PG8_STA(PG8_SA(0, 1), 1, last, kb2);
            PG8_WAIT_V(8); PG8_WAIT_L(0); PG8_BAR; PG8_MMA(0, 0, At, B0); PG8_MMA(0, 1, At, B1); PG8_BAR; PG8_SCHED;
            PG8_LDA(At, 1, 1); PG8_STAGE(PG8_SB(1, 0), b3, voffB); PG8_STAGE(PG8_SB(1, 1), b3 + hstep, voffB); PG8_STA(PG8_SA(1, 0), 0, last, kb3);
            PG8_WAIT_V(8); PG8_WAIT_L(0); PG8_BAR; PG8_MMA(1, 0, At, B0); PG8_MMA(1, 1, At, B1); PG8_BAR; PG8_SCHED;
            } else {
            PG8_LDB(B0, 0, 0); PG8_SCHED; PG8_LDA(At, 0, 0); PG8_STAGE(PG8_SA(1, 1), a1 + hstep, voffA);
            PG8_WAIT_L(8); PG8_BAR; PG8_WAIT_L(0); PG8_MMA(0, 0, At, B0); PG8_BAR; PG8_SCHED;
            PG8_LDB(B1, 0, 1); PG8_STAGE(PG8_SB(0, 0), b2, voffB);
            PG8_BAR; PG8_WAIT_L(0); PG8_MMA(0, 1, At, B1); PG8_BAR;
            PG8_LDA(At, 0, 1); PG8_STAGE(PG8_SA(0, 0), a2, voffA);
            PG8_BAR; PG8_WAIT_L(0); PG8_MMA(1, 0, At, B0); PG8_BAR; PG8_SCHED;
            PG8_STAGE(PG8_SB(0, 1), b2 + hstep, voffB);
            PG8_WAIT_V(6); PG8_BAR; PG8_MMA(1, 1, At, B1); PG8_BAR;
            PG8_LDB(B0, 1, 0); PG8_SCHED; PG8_LDA(At, 1, 0); PG8_STAGE(PG8_SA(0, 1), a2 + hstep, voffA);
            PG8_WAIT_L(8); PG8_BAR; PG8_WAIT_L(0); PG8_MMA(0, 0, At, B0); PG8_BAR; PG8_SCHED;
            PG8_LDB(B1, 1, 1); PG8_STAGE(PG8_SB(1, 0), b3, voffB);
            PG8_BAR; PG8_WAIT_L(0); PG8_MMA(0, 1, At, B1); PG8_BAR;
            PG8_LDA(At, 1, 1); PG8_STAGE(PG8_SA(1, 0), a3, voffA);
            PG8_BAR; PG8_WAIT_L(0); PG8_MMA(1, 0, At, B0); PG8_BAR; PG8_SCHED;
            PG8_STAGE(PG8_SB(1, 1), b3 + hstep, voffB);
            PG8_WAIT_V(6); PG8_BAR; PG8_MMA(1, 1, At, B1); PG8_BAR;
            }
        }
        if constexpr (ALIGN_EPI) { if (wr == 0) PG8_BAR; }
        if constexpr (!Epi::AFTER_DRAIN) { E(acc, cur, wr, wc, fr, fq, xlds + (ui % 3) * 4096); S.done(cur); }
        if (!has_next) break;
#pragma unroll
        for (int a = 0; a < 2; ++a)
#pragma unroll
            for (int b = 0; b < 2; ++b)
#pragma unroll
                for (int m = 0; m < 4; ++m)
#pragma unroll
                    for (int n = 0; n < 2; ++n) acc[a][b][m][n] = (acc_t)0;
        cur = nxt; cA = nA; cB = nB; ++ui;
        if constexpr (GATHER) {
#pragma unroll
            for (int h_ = 0; h_ < 2; ++h_) { gA[h_][0] = gN[h_][0]; gA[h_][1] = gN[h_][1]; } }
        if constexpr (ALIGN_EPI) { if (wr == 1) PG8_BAR; }
    }
    PG8_WAIT_V(0);
    if constexpr (!ALIGN_EPI) { if (wr == 0) PG8_BAR; }
    PG8_BAR;
#undef PG8_SA
#undef PG8_SB
#undef PG8_STAGE
#undef PG8_STA
#undef PG8_EPI_ISSUE
#undef PG8_ROWT_ISSUE
#undef PG8_ROWT_READ
#undef PG8_LDA
#undef PG8_LDB
#undef PG8_MMA
#undef PG8_WAIT_V
#undef PG8_WAIT_L
#undef PG8_BAR
#undef PG8_SCHED
}
}

constexpr int NWAVES = 8, NTHR = 512;
constexpr int BATCH = 2, SEQ = 8192, T = BATCH * SEQ, D = 1024;
constexpr int DI = 2048, SH = 32, HP = 64, NGRP = 4, NS = 128, CHK = 128, NCH = SEQ / CHK;
constexpr int IN_DIM = 5152, XW = 5120, XOFF = 2048, BOFF = 4096, COFF = 4608, CONVD = 3072;
constexpr int QH = 16, KVH = 4, HD = 64, QKVW = 1536;
constexpr int NE = 32, TOPK = 4, FF = 1024, NA = T * TOPK, MTILE = 256, CAP = NA + NE * MTILE, MAXTILES = CAP / MTILE;
constexpr float EPS = 1e-6f;

constexpr size_t MiB = 1u << 20;
constexpr size_t WS_CTL = 0, CTL_ZERO_BYTES = 32768;
constexpr size_t WS_MODP = 1 * MiB;
constexpr size_t WS_MISC = 2 * MiB;
constexpr size_t MISC_CNT = 0, MISC_TE = 65536, MISC_NT = 65536 + 2048, MISC_CDEC = 131072, MISC_GATE = 262144;
constexpr size_t WS_WSC = 3 * MiB;
constexpr size_t WSC_W1 = 0, WSC_IN = 524288, WSC_QKV = 524288 + 32768, WSC_W2 = 524288 + 65536;
constexpr size_t HS_OFF = 16 * MiB, XGS_OFF = 80 * MiB;
constexpr size_t WS_WIN = 4 * MiB, WS_WOUT = 14 * MiB, WS_WQKV = 18 * MiB, WS_WAO = 21 * MiB;
constexpr size_t WS_W1 = 32 * MiB, WS_W2 = 288 * MiB;
constexpr size_t WS_H = 416 * MiB, WS_ZX = 448 * MiB, WS_DT = 608 * MiB, WS_ST = 610 * MiB, WS_Y = 674 * MiB;
constexpr size_t WS_X1 = 738 * MiB, WS_X2 = 802 * MiB, WS_X3 = 866 * MiB;
constexpr size_t WS_ASG = 930 * MiB;
constexpr size_t WS_SRT = 931 * MiB;
constexpr size_t WS_XG = 932 * MiB, WS_ACT = 1076 * MiB, WS_YK = 1220 * MiB, WS_QKV = 1348 * MiB, WS_AO = 1396 * MiB;
constexpr size_t WS_XT = 1428 * MiB, WS_BT = 1492 * MiB, WS_BN = 1508 * MiB, WS_CN = 1524 * MiB, WS_END = 1540 * MiB;
constexpr int CW_TMO = 0, CW_CODE = 1, CW_BAR = 4096;

constexpr int RING_OFF = 0, RING_BYTES = 131072;
constexpr int LDSCTL_OFF = RING_BYTES, MISC_OFF = LDSCTL_OFF + 320, TE_OFF = MISC_OFF + 128;
constexpr int ROWT_OFF = TE_OFF + 1280;
constexpr int EPIX_OFF = ROWT_OFF + 2048;
constexpr int LDS_BYTES = 147456;
static_assert(EPIX_OFF + 3 * 4096 <= LDS_BYTES && (EPIX_OFF & 15) == 0, "LDS map");
static_assert(TE_OFF + 4 * (MAXTILES + 4) <= LDS_BYTES, "LDS map");

#define LDS_WAIT() asm volatile("s_waitcnt lgkmcnt(0)" ::: "memory")
#define VM_WAIT() asm volatile("s_waitcnt vmcnt(0)" ::: "memory")
__device__ __forceinline__ unsigned f2bf(float f) { unsigned u = __builtin_bit_cast(unsigned, f); return (u + 0x7fffu + ((u >> 16) & 1u)) >> 16; }
typedef float f32x2_t __attribute__((ext_vector_type(2)));
typedef __bf16 bf16x2_t __attribute__((ext_vector_type(2)));
__device__ __forceinline__ unsigned pk2(float lo, float hi) { const f32x2_t v = {lo, hi}; const bf16x2_t b = __builtin_convertvector(v, bf16x2_t); return __builtin_bit_cast(unsigned, b); }
__device__ __forceinline__ float bf2f(unsigned h) { return __builtin_bit_cast(float, h << 16); }
__device__ __forceinline__ float bflo(unsigned w) { return __builtin_bit_cast(float, w << 16); }
__device__ __forceinline__ float bfhi(unsigned w) { return __builtin_bit_cast(float, w & 0xffff0000u); }
__device__ __forceinline__ bf16x8 pack8(const float (&o)[8]) { v4u w; w.x = pk2(o[0], o[1]); w.y = pk2(o[2], o[3]); w.z = pk2(o[4], o[5]); w.w = pk2(o[6], o[7]); return __builtin_bit_cast(bf16x8, w); }
__device__ __forceinline__ float rcp_f(float x) { return __builtin_amdgcn_rcpf(x); }
__device__ __forceinline__ float rsq_f(float x) { return __builtin_amdgcn_rsqf(x); }
__device__ __forceinline__ float silu_f(float x) { return x * rcp_f(1.0f + __expf(-x)); }
__device__ __forceinline__ float wave_sum(float v) {
#pragma unroll
    for (int o = 1; o < 64; o <<= 1) v += __shfl_xor(v, o);
    return v;
}
#define MFMA16(a, b, c) __builtin_amdgcn_mfma_f32_16x16x32_bf16((a), (b), (c), 0, 0, 0)

#define XB_TMO      128
#define XB_XCNT(j)  (256  + 64 * (j))
#define XB_XSUB(j)  (1280 + 64 * (j))
#define XB_XGEN(j)  (2304 + 64 * (j))
#define XB_TOP      3328
#define XB_TOPGEN   3392
#define XCD_BAR_WORDS 3456
#define XB_SPIN_CAP (1u << 18)
__device__ __forceinline__ unsigned xb_ld(unsigned* p)              { return __hip_atomic_load(p, __ATOMIC_RELAXED, __HIP_MEMORY_SCOPE_AGENT); }
__device__ __forceinline__ unsigned xb_add(unsigned* p, unsigned v) { return __hip_atomic_fetch_add(p, v, __ATOMIC_RELAXED, __HIP_MEMORY_SCOPE_AGENT); }
__device__ __forceinline__ unsigned xb_xcc_id() { return (unsigned)__builtin_amdgcn_s_getreg((3 << 11) | 20) & 0xFu; }
#define XB_SPIN(cond, bar) do { unsigned _sp = 0; while (cond) { __builtin_amdgcn_s_sleep(1); \
    if ((++_sp & 255u) == 0u) { if (xb_ld(&(bar)[XB_TMO])) break; if (_sp > XB_SPIN_CAP) { atomicAdd(&(bar)[XB_TMO], 1u); break; } } } } while (0)
struct XcdBarrier { unsigned* bar; unsigned x; volatile LAS unsigned* st; };
__device__ __forceinline__ XcdBarrier xcd_barrier_post(unsigned* bar, volatile LAS unsigned* st) {
    XcdBarrier b; b.bar = bar; b.x = xb_xcc_id(); b.st = st;
    if (threadIdx.x == 0) (void)xb_add(&bar[XB_XCNT(b.x)], 1u);
    return b;
}
__device__ __forceinline__ void xcd_barrier_complete(unsigned* bar, unsigned x, unsigned& nloc, unsigned& nx) {
    const unsigned G = gridDim.x * gridDim.y * gridDim.z;
    unsigned sum, cnt, mine, sp = 0u;
    for (;;) {
        sum = 0u; cnt = 0u; mine = 0u;
#pragma unroll
        for (unsigned j = 0; j < 16; ++j) { const unsigned c = xb_ld(&bar[XB_XCNT(j)]); sum += c; cnt += (c > 0u) ? 1u : 0u; mine = (j == x) ? c : mine; }
        if (sum == G) break;
        __builtin_amdgcn_s_sleep(1);
        if ((++sp & 255u) == 0u) { if (xb_ld(&bar[XB_TMO])) break; if (sp > XB_SPIN_CAP) { atomicAdd(&bar[XB_TMO], 1u); break; } }
    }
    nloc = mine > 0u ? mine : 1u; nx = cnt > 0u ? cnt : 1u;
}
__device__ __forceinline__ void xcd_barrier(const XcdBarrier& b) {
    asm volatile("s_waitcnt vmcnt(0)" ::: "memory");
    __syncthreads();
    if (threadIdx.x == 0) {
        unsigned* bar = b.bar;
        __builtin_amdgcn_s_waitcnt(0);
        unsigned nloc = b.st[0], nx = b.st[1];
        if (nloc == 0u) { xcd_barrier_complete(bar, b.x, nloc, nx); b.st[0] = nloc; b.st[1] = nx; }
        const unsigned old = xb_add(&bar[XB_XSUB(b.x)], 1u);
        const unsigned gen = old / nloc;
        if (old + 1u == (gen + 1u) * nloc) {
            __builtin_amdgcn_fence(__ATOMIC_RELEASE, "agent");
            asm volatile("s_waitcnt vmcnt(0)" ::: "memory");
            const unsigned og = xb_add(&bar[XB_TOP], 1u);
            const unsigned tg = og / nx;
            if (og + 1u == (tg + 1u) * nx) xb_add(&bar[XB_TOPGEN], 1u);
            else XB_SPIN(xb_ld(&bar[XB_TOPGEN]) == tg, bar);
            __builtin_amdgcn_fence(__ATOMIC_ACQUIRE, "agent");
            xb_add(&bar[XB_XGEN(b.x)], 1u);
            asm volatile("s_waitcnt vmcnt(0)" ::: "memory");
        } else {
            XB_SPIN(xb_ld(&bar[XB_XGEN(b.x)]) == gen, bar);
            __builtin_amdgcn_fence(__ATOMIC_ACQUIRE, "agent");
            asm volatile("s_waitcnt vmcnt(0)" ::: "memory");
        }
    }
    __syncthreads();
}

struct Args { const float* in[26]; float* out; unsigned char* ws; int ph_lo, ph_hi; };
enum { I_X = 0, I_C, I_ADAW, I_ADAB, I_N1G, I_N2G, I_MINW, I_MCONVW, I_MCONVB, I_MDTB, I_MALOG, I_MD, I_MNG, I_MOUTW, I_AQKVW, I_AQNG, I_AKNG, I_ASINK, I_AOUTW, I_RELB, I_RW, I_RB, I_EW1, I_EB1, I_EW2, I_EB2 };

__device__ __forceinline__ void p0_transpose_item(const float* __restrict__ W, int ldw, int K, int nblk, bf16* WT, LAS float* scr, int item, int lane) {
    const int kb = item / nblk, nb = item % nblk, k0 = 64 * kb, n0 = 32 * nb;
    float tv[32];
#pragma unroll
    for (int i = 0; i < 32; ++i) { const int kk = 2 * i + (lane >> 5); tv[i] = W[(size_t)(k0 + kk) * ldw + n0 + (lane & 31)]; }
#pragma unroll
    for (int i = 0; i < 32; ++i) { const int kk = 2 * i + (lane >> 5); scr[kk * 33 + (lane & 31)] = tv[i]; }
    LDS_WAIT(); asm volatile("" ::: "memory");
    const int c = lane & 7;
#pragma unroll
    for (int j = 0; j < 4; ++j) { const int n = (lane >> 3) + 8 * j; const LAS float* s = scr + (8 * c) * 33 + n;
        v4u o; o.x = pk2(s[0 * 33], s[1 * 33]); o.y = pk2(s[2 * 33], s[3 * 33]); o.z = pk2(s[4 * 33], s[5 * 33]); o.w = pk2(s[6 * 33], s[7 * 33]);
        *(GAS v4u*)(WT + (size_t)(n0 + n) * K + k0 + 8 * c) = o; }
    LDS_WAIT(); asm volatile("" ::: "memory");
}
__device__ __forceinline__ void p0_prologue(const Args& a, LAS unsigned char* lds, int wave, int lane) {
    unsigned char* ws = a.ws; const int blk = blockIdx.x, G = gridDim.x;
    float* modp = (float*)(ws + WS_MODP);
    const float* __restrict__ cin = a.in[I_C]; const float* __restrict__ adaw = a.in[I_ADAW];
    if (wave < 2) {
        for (int it = wave * G + blk; it < 384; it += 2 * G) {
            const int kc = it & 7, rest = it >> 3, l = rest / 24, nb = rest % 24;
            f32x4 a0 = {0.f, 0.f, 0.f, 0.f}, a1 = {0.f, 0.f, 0.f, 0.f};
            const float* wp = adaw + ((size_t)l * 1024 + kc * 128) * 6144 + nb * 256 + lane * 4;
#pragma unroll 32
            for (int k = 0; k < 128; ++k) { const f32x4 w = *(const f32x4*)(wp + (size_t)k * 6144);
                const float c0 = silu_f(cin[kc * 128 + k]), c1 = silu_f(cin[1024 + kc * 128 + k]); a0 += w * c0; a1 += w * c1; }
            *(f32x4*)(modp + ((size_t)(kc * 2 + l) * 2 + 0) * 6144 + nb * 256 + lane * 4) = a0;
            *(f32x4*)(modp + ((size_t)(kc * 2 + l) * 2 + 1) * 6144 + nb * 256 + lane * 4) = a1;
        }
    } else {
        LAS float* scr = (LAS float*)(lds + RING_OFF + wave * 16384);
        constexpr int I1 = 32 * 32, I3 = 16 * 32;
        constexpr int NITEMS = I1 + I3;
        for (int it = (wave - 2) * G + blk; it < NITEMS; it += 6 * G) {
            int r = it;
            if (r < I1) { p0_transpose_item(a.in[I_MOUTW], 1024, 2048, 32, (bf16*)(ws + WS_WOUT), scr, r, lane); continue; } r -= I1;
            { p0_transpose_item(a.in[I_AOUTW], 1024, 1024, 32, (bf16*)(ws + WS_WAO), scr, r, lane); }
        }
    }
}
struct QItem { const float* W; int ldw, n0; signed char* outq; float* sc; int f8; };
__device__ __forceinline__ QItem quant_decode(const Args& a, int it) {
    unsigned char* ws = a.ws; float* wsc = (float*)(ws + WS_WSC); QItem q; q.f8 = 0;
    constexpr int Q2 = 160;
    if (it < Q2) { q.W = a.in[I_MINW]; q.ldw = IN_DIM; q.n0 = 32 * it; q.outq = (signed char*)(ws + WS_WIN); q.sc = wsc + WSC_IN / 4; }
    else { q.W = a.in[I_AQKVW]; q.ldw = 1536; q.n0 = 32 * (it - Q2); q.outq = (signed char*)(ws + WS_WQKV); q.sc = wsc + WSC_QKV / 4; }
    return q;
}
__device__ __forceinline__ void quant_load(const QItem& q, int wave, int lane, float (&vals)[64]) {
    const int n = lane & 31, kh = lane >> 5; const float* __restrict__ wp = q.W + (size_t)(128 * wave + kh) * q.ldw + q.n0 + n;
#pragma unroll
    for (int i = 0; i < 64; ++i) vals[i] = wp[(size_t)(2 * i) * q.ldw];
}
__device__ __forceinline__ void quant_finish(const QItem& q, const float (&vals)[64], LAS unsigned char* lds, int wave, int lane) {
    LAS float* AMX = (LAS float*)(lds + 36864);
    LAS unsigned char* Tt = lds + wave * 4224;
    const int n = lane & 31, kh = lane >> 5; float am = 0.f;
#pragma unroll
    for (int i = 0; i < 64; ++i) am = fmaxf(am, fabsf(vals[i]));
    am = fmaxf(am, __shfl_xor(am, 32));
    if (lane < 32) AMX[wave * 32 + n] = am;
    __syncthreads();
    float amt = 0.f;
#pragma unroll
    for (int w = 0; w < 8; ++w) amt = fmaxf(amt, AMX[w * 32 + n]);
    const float qmax = q.f8 ? 448.0f : 127.0f;
    const float inv = amt > 0.f ? qmax / amt : 0.f;
    if (wave == 0 && lane < 32) q.sc[q.n0 + n] = amt > 0.f ? amt / qmax : 1.0f;
    if (q.f8) {
#pragma unroll
        for (int i = 0; i < 64; ++i) { const float x = vals[i] * inv; Tt[n * 132 + 2 * i + kh] = (unsigned char)(__builtin_amdgcn_cvt_pk_fp8_f32(x, x, 0, false) & 255); }
    } else {
#pragma unroll
        for (int i = 0; i < 64; ++i) Tt[n * 132 + 2 * i + kh] = (unsigned char)((int)__builtin_rintf(vals[i] * inv) & 255);
    }
    LDS_WAIT(); asm volatile("" ::: "memory");
    { const int rn = lane >> 1, half = lane & 1; const LAS unsigned* src = (const LAS unsigned*)(Tt + rn * 132 + 64 * half);
        v4u o[4];
#pragma unroll
        for (int qd = 0; qd < 4; ++qd) { o[qd].x = src[4 * qd]; o[qd].y = src[4 * qd + 1]; o[qd].z = src[4 * qd + 2]; o[qd].w = src[4 * qd + 3]; }
#pragma unroll
        for (int qd = 0; qd < 4; ++qd) *(v4u*)(q.outq + (size_t)(q.n0 + rn) * 1024 + 128 * wave + 64 * half + 16 * qd) = o[qd]; }
    __syncthreads();
}
__device__ __forceinline__ void p0_quant(const Args& a, LAS unsigned char* lds, int wave, int lane) {
    constexpr int NQ = 160 + 48;
    __syncthreads();
    float va[64], vb[64];
    int it = blockIdx.x;
    if (it < NQ) { const QItem q0 = quant_decode(a, it); quant_load(q0, wave, lane, va); }
#pragma unroll 1
    for (; it < NQ; it += gridDim.x) {
        const int nx = it + gridDim.x;
        if (nx < NQ) { const QItem qn = quant_decode(a, nx); quant_load(qn, wave, lane, vb); }
        const QItem q = quant_decode(a, it);
        quant_finish(q, va, lds, wave, lane);
#pragma unroll
        for (int i = 0; i < 64; ++i) va[i] = vb[i];
    }
}
constexpr int BG_N = 2048 + 1024;
__device__ __forceinline__ QItem bg_decode(const Args& a, int j, int matbase) {
    unsigned char* ws = a.ws; float* wsc = (float*)(ws + WS_WSC); QItem q;
    if (j < 2048) { const int mat = matbase + (j >> 6), nb = j & 63;
        q.W = a.in[I_EW1] + (size_t)mat * 1024 * 2048; q.ldw = 2048; q.n0 = 32 * nb; q.outq = (signed char*)(ws + WS_W1) + (size_t)mat * 2048 * 1024; q.sc = wsc + WSC_W1 / 4 + mat * 2048; q.f8 = 0; }
    else { const int g = j - 2048, mat = matbase + (g >> 5), nb = g & 31;
        q.W = a.in[I_EW2] + (size_t)mat * 1024 * 1024; q.ldw = 1024; q.n0 = 32 * nb; q.outq = (signed char*)(ws + WS_W2) + (size_t)mat * 1024 * 1024; q.sc = wsc + WSC_W2 / 4 + mat * 1024; q.f8 = 1; }
    return q;
}
__device__ __forceinline__ void bg_run(const Args& a, LAS unsigned char* lds, int first, int count, int step, int wave, int lane, int matbase = 32) {
    if (first > BG_N) first = BG_N;
    __syncthreads();
    float va[64], vb[64];
    int j = first, left = count;
    if (j >= BG_N) left = 0;
    if (left > 0) { const QItem q0 = bg_decode(a, j, matbase); quant_load(q0, wave, lane, va); }
#pragma unroll 1
    for (; left > 0; --left, j += step) {
        const int nx = j + step; const bool more = (left > 1) && (nx < BG_N);
        if (more) { const QItem qn = bg_decode(a, nx, matbase); quant_load(qn, wave, lane, vb); }
        const QItem q = bg_decode(a, j, matbase);
        quant_finish(q, va, lds, wave, lane);
        if (!more) break;
#pragma unroll
        for (int i = 0; i < 64; ++i) va[i] = vb[i];
    }
    __syncthreads();
}
__device__ __forceinline__ float modval(const Args& a, int l, int b, int idx) {
    const float* modp = (const float*)(a.ws + WS_MODP);
    float s = a.in[I_ADAB][l * 6144 + idx];
#pragma unroll
    for (int kc = 0; kc < 8; ++kc) s += modp[((size_t)(kc * 2 + l) * 2 + b) * 6144 + idx];
    return s;
}

constexpr int NP_MOD = 0, NP_HI = 16384, NP_LO = NP_HI + 16 * 1032 * 2, NP_PART = NP_LO + 16 * 1032 * 2, NP_LOG = NP_PART + 16384, NP_AE = NP_LOG + 2048, NP_AG = NP_AE + 1024, NP_TOPV = NP_AG + 1024, NP_END = NP_TOPV + 256;
static_assert(NP_END <= RING_BYTES, "norm phase LDS");
template <int MODE, bool COMBINE, bool NORM>
__device__ __forceinline__ void norm_phase(const Args& a, LAS unsigned char* lds, int layer, int which, const float* xin, const float* cgate, const unsigned char* yk, float* xout,
                                           const float* __restrict__ Wsk, int ldw, const float* __restrict__ bsk, int tid, int wave, int lane) {
    unsigned char* ws = a.ws;
    LAS float* MOD = (LAS float*)(lds + NP_MOD);
    LAS bf16* HI = (LAS bf16*)(lds + NP_HI); LAS bf16* LO = (LAS bf16*)(lds + NP_LO);
    LAS float* PART = (LAS float*)(lds + NP_PART); LAS float* LOG = (LAS float*)(lds + NP_LOG);
    LAS int* AE = (LAS int*)(lds + NP_AE); LAS float* AG = (LAS float*)(lds + NP_AG); LAS float* TOPV = (LAS float*)(lds + NP_TOPV);
    signed char* H8 = (signed char*)(ws + WS_H); float* hscale = (float*)(ws + WS_H + HS_OFF);
    const int rb = blockIdx.x;
    if (NORM) {
        const float* ng = a.in[which ? I_N2G : I_N1G] + layer * 1024;
        for (int idx = tid; idx < 2048; idx += NTHR) { const int b = idx >> 10, col = idx & 1023;
            const float sh = modval(a, layer, b, which * 3072 + col), sc = modval(a, layer, b, which * 3072 + 1024 + col);
            MOD[(b * 2 + 0) * 1024 + col] = ng[col] * (1.0f + sc); MOD[(b * 2 + 1) * 1024 + col] = sh; }
    }
    const int fi = lane & 15, fq = lane >> 4;
    bf16x8 Bh[2][4], Bl[2][4];
    if (MODE != 2) {
#pragma unroll
        for (int s = 0; s < 4; ++s)
#pragma unroll
            for (int nt = 0; nt < 2; ++nt) { float hi[8], lo[8];
#pragma unroll
                for (int e = 0; e < 8; ++e) { const float w = Wsk[(size_t)(128 * wave + 32 * s + 8 * fq + e) * ldw + 16 * nt + fi]; const float h = bf2f(f2bf(w)); hi[e] = h; lo[e] = w - h; }
                Bh[nt][s] = pack8(hi); Bl[nt][s] = pack8(lo); }
    }
    __syncthreads();
    f32x4 vn[2][4]; unsigned yn[2][4][4];
#define NP_LOAD_TILE(tlx) do { _Pragma("unroll") for (int rr_ = 0; rr_ < 2; ++rr_) { const int m_ = 64 * rb + 16 * (tlx) + 8 * rr_ + wave; \
        _Pragma("unroll") for (int j = 0; j < 4; ++j) { vn[rr_][j] = *(const f32x4*)(xin + (size_t)m_ * 1024 + 4 * lane + 256 * j); \
            if (COMBINE) { _Pragma("unroll") for (int k = 0; k < 4; ++k) yn[rr_][j][k] = *(const unsigned*)(yk + ((size_t)m_ * 4 + k) * 1024 + 4 * lane + 256 * j); } } } } while (0)
    NP_LOAD_TILE(0);
#pragma unroll 1
    for (int tl = 0; tl < 4; ++tl) {
        f32x4 vc[2][4]; unsigned yc[2][4][4];
#pragma unroll
        for (int rr = 0; rr < 2; ++rr)
#pragma unroll
            for (int j = 0; j < 4; ++j) { vc[rr][j] = vn[rr][j];
                if (COMBINE) {
#pragma unroll
                    for (int k = 0; k < 4; ++k) yc[rr][j][k] = yn[rr][j][k]; } }
        if (tl < 3) NP_LOAD_TILE(tl + 1);
#pragma unroll
        for (int rr = 0; rr < 2; ++rr) {
            const int lr = 8 * rr + wave, m = 64 * rb + 16 * tl + lr, b = m >> 13;
            f32x4 v[4];
#pragma unroll
            for (int j = 0; j < 4; ++j) v[j] = vc[rr][j];
            if (COMBINE) {
#pragma unroll
                for (int j = 0; j < 4; ++j) { const int col = 4 * lane + 256 * j; const f32x4 g = *(const f32x4*)(cgate + b * 1024 + col);
                    f32x4 s = {0.f, 0.f, 0.f, 0.f};
#pragma unroll
                    for (int k = 0; k < 4; ++k) { const unsigned y = yc[rr][j][k]; const f32x2_t lo = __builtin_amdgcn_cvt_pk_f32_fp8((int)y, false), hi = __builtin_amdgcn_cvt_pk_f32_fp8((int)y, true); s += (f32x4){lo[0], lo[1], hi[0], hi[1]}; }
                    v[j] += g * s; *(f32x4*)(xout + (size_t)m * 1024 + col) = v[j]; }
            }
            if (NORM) {
                float ss = 0.f;
#pragma unroll
                for (int j = 0; j < 4; ++j) ss += (v[j].x * v[j].x + v[j].y * v[j].y) + (v[j].z * v[j].z + v[j].w * v[j].w);
                const float r = rsq_f(wave_sum(ss) * (1.0f / 1024.0f) + EPS);
                float am = 0.f;
#pragma unroll
                for (int j = 0; j < 4; ++j) { const int col = 4 * lane + 256 * j;
                    const f32x4 A = *(const LAS f32x4*)(MOD + (b * 2 + 0) * 1024 + col), S = *(const LAS f32x4*)(MOD + (b * 2 + 1) * 1024 + col);
                    const f32x4 h = v[j] * r * A + S; v[j] = h;
                    am = fmaxf(fmaxf(am, fmaxf(fabsf(h.x), fabsf(h.y))), fmaxf(fabsf(h.z), fabsf(h.w)));
                    if (MODE != 2) { v2u hw; hw.x = pk2(h.x, h.y); hw.y = pk2(h.z, h.w);
                        const f32x4 hr = {bflo(hw.x), bfhi(hw.x), bflo(hw.y), bfhi(hw.y)}; const f32x4 l4 = h - hr;
                        v2u lw; lw.x = pk2(l4.x, l4.y); lw.y = pk2(l4.z, l4.w);
                        *(LAS v2u*)(HI + lr * 1032 + col) = hw; *(LAS v2u*)(LO + lr * 1032 + col) = lw; } }
#pragma unroll
                for (int o = 1; o < 64; o <<= 1) am = fmaxf(am, __shfl_xor(am, o));
                const float inv = am > 0.f ? 127.0f / am : 0.f;
#pragma unroll
                for (int j = 0; j < 4; ++j) { const int col = 4 * lane + 256 * j;
                    const int q0 = (int)__builtin_rintf(v[j].x * inv), q1 = (int)__builtin_rintf(v[j].y * inv), q2 = (int)__builtin_rintf(v[j].z * inv), q3 = (int)__builtin_rintf(v[j].w * inv);
                    *(unsigned*)(H8 + (size_t)m * 1024 + col) = (unsigned)(q0 & 255) | ((unsigned)(q1 & 255) << 8) | ((unsigned)(q2 & 255) << 16) | ((unsigned)q3 << 24); }
                if (lane == 0) hscale[m] = am * (1.0f / 127.0f);
            }
        }
        if (MODE != 2) {
            __syncthreads();
            f32x4 acc[2] = {{0.f, 0.f, 0.f, 0.f}, {0.f, 0.f, 0.f, 0.f}};
#pragma unroll
            for (int s = 0; s < 4; ++s) { const int k0 = 128 * wave + 32 * s + 8 * fq;
                const bf16x8 ah = *(const LAS bf16x8*)(HI + fi * 1032 + k0), al = *(const LAS bf16x8*)(LO + fi * 1032 + k0);
#pragma unroll
                for (int nt = 0; nt < 2; ++nt) { acc[nt] = MFMA16(ah, Bh[nt][s], acc[nt]); acc[nt] = MFMA16(al, Bh[nt][s], acc[nt]); acc[nt] = MFMA16(ah, Bl[nt][s], acc[nt]); } }
#pragma unroll
            for (int nt = 0; nt < 2; ++nt)
#pragma unroll
                for (int r = 0; r < 4; ++r) PART[(wave * 16 + 4 * fq + r) * 32 + 16 * nt + fi] = acc[nt][r];
            __syncthreads();
            { const int lr = tid >> 5, n = tid & 31; float s = bsk[n];
#pragma unroll
                for (int w = 0; w < 8; ++w) s += PART[(w * 16 + lr) * 32 + n];
                if (MODE == 0) { const float sp = fmaxf(s, 0.f) + log1pf(__expf(-fabsf(s))); ((float*)(ws + WS_DT))[(size_t)(64 * rb + 16 * tl + lr) * 32 + n] = sp; }
                else LOG[lr * 32 + n] = s; }
            if (MODE == 1) {
                __syncthreads();
                { const int lr = tid >> 5, n = tid & 31; const float sv = LOG[lr * 32 + n]; int rank = 0;
#pragma unroll
                    for (int n2 = 0; n2 < 32; ++n2) { const float o = LOG[lr * 32 + n2]; rank += (o > sv || (o == sv && n2 < n)) ? 1 : 0; }
                    if (rank < 4) { TOPV[lr * 4 + rank] = sv; AE[(16 * tl + lr) * 4 + rank] = n; } }
                __syncthreads();
                if (tid < 64) { const int row = tid >> 2, k = tid & 3; const float v0 = TOPV[row * 4], v1 = TOPV[row * 4 + 1], v2 = TOPV[row * 4 + 2], v3 = TOPV[row * 4 + 3];
                    const float e0 = 1.0f, e1 = __expf(v1 - v0), e2 = __expf(v2 - v0), e3 = __expf(v3 - v0); const float sum = (e0 + e1) + (e2 + e3);
                    const float ek = k == 0 ? e0 : (k == 1 ? e1 : (k == 2 ? e2 : e3));
                    AG[(16 * tl + row) * 4 + k] = ek / sum; }
            }
        }
    }
    if (MODE == 1) {
        __syncthreads();
        int* asg_e = (int*)(ws + WS_ASG); float* asg_g = (float*)(ws + WS_ASG + 262144); int* asg_r = (int*)(ws + WS_ASG + 524288);
        int* cntblk = (int*)(ws + WS_MISC + MISC_CNT);
        LAS int* WC = (LAS int*)(lds + NP_PART);
        int e_mine = 0, rank_w = 0;
        if (wave < 4) { e_mine = AE[tid];
#pragma unroll 4
            for (int e = 0; e < 32; ++e) { const unsigned long long mb = __ballot(e_mine == e); if (e_mine == e) rank_w = __popcll(mb & ((1ull << lane) - 1ull)); if (lane == 0) WC[wave * 32 + e] = __popcll(mb); } }
        __syncthreads();
        if (wave < 4) { int base = 0;
#pragma unroll
            for (int w = 0; w < 3; ++w) base += (w < wave) ? WC[w * 32 + e_mine] : 0;
            asg_e[rb * 256 + tid] = e_mine; asg_g[rb * 256 + tid] = AG[tid]; asg_r[rb * 256 + tid] = base + rank_w; }
        else if (tid < 288) { const int e = tid - 256; cntblk[rb * 32 + e] = (WC[e] + WC[32 + e]) + (WC[64 + e] + WC[96 + e]); }
    }
    __syncthreads();
}

__device__ __forceinline__ void moe_scatter(const Args& a, LAS unsigned char* lds, int tid, int wave, int lane) {
    unsigned char* ws = a.ws; const int rb = blockIdx.x, G = gridDim.x;
    LAS int* PARTS = (LAS int*)(lds + 0); LAS int* TOT = (LAS int*)(lds + 4096); LAS int* BASE = (LAS int*)(lds + 4224); LAS int* PS = (LAS int*)(lds + 4352); LAS int* POS = (LAS int*)(lds + 4608);
    const int* cntblk = (const int*)(ws + WS_MISC + MISC_CNT);
    const int* asg_e = (const int*)(ws + WS_ASG); const float* asg_g = (const float*)(ws + WS_ASG + 262144); const int* asg_r = (const int*)(ws + WS_ASG + 524288);
    int* srt_tok = (int*)(ws + WS_SRT); float* srt_gate = (float*)(ws + WS_SRT + 524288);
    int* rowoff = (int*)(ws + WS_XG); float* xgs = (float*)(ws + WS_XG + XGS_OFF); const float* hscale = (const float*)(ws + WS_H + HS_OFF);
    { const int e = tid & 31, part = tid >> 5; int tot = 0, base = 0;
        for (int bb = part * 16; bb < part * 16 + 16; ++bb) { if (bb < G) { const int c = cntblk[bb * 32 + e]; tot += c; if (bb < rb) base += c; } }
        PARTS[(part * 32 + e) * 2] = tot; PARTS[(part * 32 + e) * 2 + 1] = base; }
    __syncthreads();
    if (tid < 32) { int tot = 0, base = 0; for (int p = 0; p < 16; ++p) { tot += PARTS[(p * 32 + tid) * 2]; base += PARTS[(p * 32 + tid) * 2 + 1]; } TOT[tid] = tot; BASE[tid] = base; }
    __syncthreads();
    if (tid == 0) { int ps = 0; for (int e = 0; e < 32; ++e) { PS[e] = ps; ps += ((TOT[e] + MTILE - 1) / MTILE) * MTILE; } PS[32] = ps; }
    __syncthreads();
    if (tid < 256) { const int aidx = rb * 256 + tid; const int e = asg_e[aidx]; const int pos = PS[e] + BASE[e] + asg_r[aidx];
        srt_tok[pos] = aidx; srt_gate[pos] = asg_g[aidx]; rowoff[pos] = (aidx >> 2) * 1024; xgs[pos] = hscale[aidx >> 2]; }
    if (rb < 32) { const int e = rb; const int p0 = PS[e] + TOT[e], p1 = PS[e + 1];
        for (int pos = p0 + tid; pos < p1; pos += NTHR) { srt_tok[pos] = -1; srt_gate[pos] = 0.f; xgs[pos] = 0.f; rowoff[pos] = 0; } }
    if (rb == 0) { int* te = (int*)(ws + WS_MISC + MISC_TE);
        if (tid < MAXTILES) { const int r0 = tid * MTILE; int e = 0; for (int j = 0; j < 32; ++j) e += (PS[j + 1] <= r0) ? 1 : 0; te[tid] = (r0 < PS[32]) ? e : 31; }
        if (tid == 0) *(int*)(ws + WS_MISC + MISC_NT) = PS[32] / MTILE; }
    __syncthreads();
    __syncthreads();
}
__device__ __forceinline__ void load_tile_table(const Args& a, LAS unsigned char* lds, int tid) {
    const int* te = (const int*)(a.ws + WS_MISC + MISC_TE);
    LAS int* TE = (LAS int*)(lds + TE_OFF);
    if (tid < MAXTILES) TE[tid] = te[tid];
    if (tid == MAXTILES) TE[MAXTILES] = *(const int*)(a.ws + WS_MISC + MISC_NT);
    __syncthreads();
}

#define OPAQUE(x) asm volatile("" : "+v"(x))
__device__ __forceinline__ void conv_load(const bf16* __restrict__ ZX, int tok0, int l0, int zc0, int lane, v4u (&raw)[11]) {
    const int chunk = lane & 7, run = lane >> 3; const int zc = zc0 + 8 * chunk;
    const bf16* __restrict__ base = ZX - 3 * XW; unsigned off = (unsigned)((tok0 + l0 + 8 * run) * XW + zc);
#pragma unroll
    for (int e = 0; e < 11; ++e) { raw[e] = *(const v4u*)(base + off); off += XW; OPAQUE(off); }
}
__device__ __forceinline__ void conv_finish(const Args& a, bool first, int l0, int zc0, bf16* outT, bf16* outN, int lane, v4u (&raw)[11], LAS bf16* ldsT = nullptr, int ldsS = 0, int ldsL = 0) {
    const int chunk = lane & 7, run = lane >> 3; const int zc = zc0 + 8 * chunk, ch = zc - XOFF;
    const float* __restrict__ cw = a.in[I_MCONVW]; const float* __restrict__ cbp = a.in[I_MCONVB];
    if (first && l0 == 0 && run == 0) { raw[0] = (v4u){0u, 0u, 0u, 0u}; raw[1] = (v4u){0u, 0u, 0u, 0u}; raw[2] = (v4u){0u, 0u, 0u, 0u}; }
    float w[4][8], cb[8];
#pragma unroll
    for (int j = 0; j < 4; ++j) { const f32x4 t0 = *(const f32x4*)(cw + j * CONVD + ch), t1 = *(const f32x4*)(cw + j * CONVD + ch + 4);
        w[j][0] = t0.x; w[j][1] = t0.y; w[j][2] = t0.z; w[j][3] = t0.w; w[j][4] = t1.x; w[j][5] = t1.y; w[j][6] = t1.z; w[j][7] = t1.w; }
    { const f32x4 t0 = *(const f32x4*)(cbp + ch), t1 = *(const f32x4*)(cbp + ch + 4); cb[0] = t0.x; cb[1] = t0.y; cb[2] = t0.z; cb[3] = t0.w; cb[4] = t1.x; cb[5] = t1.y; cb[6] = t1.z; cb[7] = t1.w; }
    unsigned P[4][8];
#pragma unroll
    for (int rp = 0; rp < 4; ++rp) { float o[2][8];
#pragma unroll
        for (int rr = 0; rr < 2; ++rr) { const int r = 2 * rp + rr;
#pragma unroll
            for (int cx = 0; cx < 8; ++cx) o[rr][cx] = cb[cx];
#pragma unroll
            for (int j = 0; j < 4; ++j) { const v4u x = raw[r + j];
                const float xv[8] = {bflo(x.x), bfhi(x.x), bflo(x.y), bfhi(x.y), bflo(x.z), bfhi(x.z), bflo(x.w), bfhi(x.w)};
#pragma unroll
                for (int cx = 0; cx < 8; ++cx) o[rr][cx] += w[j][cx] * xv[cx]; }
#pragma unroll
            for (int cx = 0; cx < 8; ++cx) o[rr][cx] = silu_f(o[rr][cx]); }
#pragma unroll
        for (int cx = 0; cx < 8; ++cx) P[rp][cx] = pk2(o[0][cx], o[1][cx]); }
    if (outT) {
#pragma unroll
        for (int cx = 0; cx < 8; ++cx) { v4u t = {P[0][cx], P[1][cx], P[2][cx], P[3][cx]}; *(v4u*)(outT + (8 * chunk + cx) * 128 + l0 + 8 * run) = t; } }
    if (ldsS != 0) {
#pragma unroll
        for (int cx = 0; cx < 8; ++cx) { v4u t = {P[0][cx], P[1][cx], P[2][cx], P[3][cx]}; *(LAS v4u*)(ldsT + (8 * chunk + cx) * ldsS + ldsL + 8 * run) = t; } }
    if (outN) {
#pragma unroll
        for (int rp = 0; rp < 4; ++rp) { v4u e0, e1;
            e0.x = (P[rp][0] & 0xffffu) | (P[rp][1] << 16); e0.y = (P[rp][2] & 0xffffu) | (P[rp][3] << 16); e0.z = (P[rp][4] & 0xffffu) | (P[rp][5] << 16); e0.w = (P[rp][6] & 0xffffu) | (P[rp][7] << 16);
            e1.x = (P[rp][0] >> 16) | (P[rp][1] & 0xffff0000u); e1.y = (P[rp][2] >> 16) | (P[rp][3] & 0xffff0000u); e1.z = (P[rp][4] >> 16) | (P[rp][5] & 0xffff0000u); e1.w = (P[rp][6] >> 16) | (P[rp][7] & 0xffff0000u);
            *(v4u*)(outN + (l0 + 8 * run + 2 * rp) * 128 + 8 * chunk) = e0; *(v4u*)(outN + (l0 + 8 * run + 2 * rp + 1) * 128 + 8 * chunk) = e1; } }
}
__device__ __forceinline__ void head_scan(const float* __restrict__ DT, int tok0, int hh, float Ah, int lane, float& d0, float& d1, float& acs0, float& acs1, float& total) {
    d0 = DT[(size_t)(tok0 + 2 * lane) * 32 + hh]; d1 = DT[(size_t)(tok0 + 2 * lane + 1) * 32 + hh];
    const float a0 = d0 * Ah, a1 = a0 + d1 * Ah;
    float v = a1;
#pragma unroll
    for (int o = 1; o < 64; o <<= 1) { const float t = __shfl_up(v, o); if (lane >= o) v += t; }
    acs0 = v - a1 + a0; acs1 = v; total = __shfl(v, 63);
}
__device__ __forceinline__ void ssd_states(const Args& a, LAS unsigned char* lds, int tid, int wave, int lane) {
    unsigned char* ws = a.ws;
    const bf16* __restrict__ ZX = (const bf16*)(ws + WS_ZX); const float* __restrict__ DT = (const float*)(ws + WS_DT);
    bf16* ST = (bf16*)(ws + WS_ST); float* CDEC = (float*)(ws + WS_MISC + MISC_CDEC);
    bf16* XT = (bf16*)(ws + WS_XT); bf16* BT = (bf16*)(ws + WS_BT); bf16* BN = (bf16*)(ws + WS_BN); bf16* CN = (bf16*)(ws + WS_CN);
    LAS bf16* BTs = (LAS bf16*)(lds + 0);
    LAS bf16* XTs = (LAS bf16*)(lds + 34816 + wave * 9216);
    LAS float* WL = (LAS float*)(lds + 34816 + 8 * 9216 + wave * 512);
    const int fi = lane & 15, fq = lane >> 4;
    for (int u = (int)((blockIdx.x & 7) * (gridDim.x >> 3) + (blockIdx.x >> 3)); u < BATCH * NCH * NGRP; u += gridDim.x) {
        const int b = u >> 8, c = (u >> 2) & 63, g = u & 3; const int tok0 = b * SEQ + c * CHK; const bool first = (c == 0);
        const size_t cg = (size_t)((b * NCH + c) * NGRP + g);
        const int hh = 8 * g + wave; const float Ah = -__expf(a.in[I_MALOG][hh]);
        { float d0, d1, acs0, acs1, total; head_scan(DT, tok0, hh, Ah, lane, d0, d1, acs0, acs1, total);
            WL[2 * lane] = d0 * __expf(total - acs0); WL[2 * lane + 1] = d1 * __expf(total - acs1);
            if (lane == 0) CDEC[(b * NCH + c) * SH + hh] = __expf(total); }
        { const int rh = wave & 1, cb2 = (wave & 3) >> 1; const bool isC = wave >= 4;
            const int zc0 = (isC ? COFF : BOFF) + g * 128 + 64 * cb2;
            v4u raw[11]; conv_load(ZX, tok0, 64 * rh, zc0, lane, raw);
            conv_finish(a, first, 64 * rh, zc0, nullptr, (isC ? CN : BN) + cg * 16384 + 64 * cb2, lane, raw, BTs + (64 * cb2) * 136, isC ? 0 : 136, 64 * rh); }
        bf16x8 Xf[4][4];
        bf16* xtg = XT + ((size_t)((b * NCH + c) * SH + hh)) * 8192;
#pragma unroll
        for (int rh = 0; rh < 2; ++rh) {
            { v4u raw[11]; conv_load(ZX, tok0, 64 * rh, XOFF + hh * 64, lane, raw);
                conv_finish(a, first, 64 * rh, XOFF + hh * 64, xtg, nullptr, lane, raw, XTs, 72, 0); }
            LDS_WAIT(); asm volatile("" ::: "memory");
#pragma unroll
            for (int pt = 0; pt < 4; ++pt)
#pragma unroll
                for (int k2 = 0; k2 < 2; ++k2) { const int ll = 32 * k2 + 8 * fq, l0 = 64 * rh + ll; const v4u x = *(const LAS v4u*)(XTs + (16 * pt + fi) * 72 + ll);
                    const f32x4 s0 = *(const LAS f32x4*)(WL + l0), s1 = *(const LAS f32x4*)(WL + l0 + 4);
                    const float o[8] = {bflo(x.x) * s0.x, bfhi(x.x) * s0.y, bflo(x.y) * s0.z, bfhi(x.y) * s0.w, bflo(x.z) * s1.x, bfhi(x.z) * s1.y, bflo(x.w) * s1.z, bfhi(x.w) * s1.w};
                    Xf[pt][2 * rh + k2] = pack8(o); }
            LDS_WAIT(); asm volatile("" ::: "memory");
        }
        __syncthreads();
        bf16* stp = ST + ((size_t)((b * NCH + c) * SH + hh)) * 8192;
#pragma unroll 1
        for (int nh = 0; nh < 2; ++nh) {
            f32x4 acc[4][4];
#pragma unroll
            for (int n4 = 0; n4 < 4; ++n4)
#pragma unroll
                for (int pt = 0; pt < 4; ++pt) acc[n4][pt] = (f32x4){0.f, 0.f, 0.f, 0.f};
#pragma unroll
            for (int ks = 0; ks < 4; ++ks)
#pragma unroll
                for (int n4 = 0; n4 < 4; ++n4) { const bf16x8 af = *(const LAS bf16x8*)(BTs + (16 * (4 * nh + n4) + fi) * 136 + 32 * ks + 8 * fq);
#pragma unroll
                    for (int pt = 0; pt < 4; ++pt) acc[n4][pt] = MFMA16(af, Xf[pt][ks], acc[n4][pt]); }
#pragma unroll
            for (int n4 = 0; n4 < 4; ++n4)
#pragma unroll
                for (int pt = 0; pt < 4; ++pt) { v2u w; w.x = pk2(acc[n4][pt][0], acc[n4][pt][1]); w.y = pk2(acc[n4][pt][2], acc[n4][pt][3]);
                    *(v2u*)(stp + (16 * pt + fi) * 128 + 16 * (4 * nh + n4) + 4 * fq) = w; }
            asm volatile("" ::: "memory");
        }
        __syncthreads();
    }
}

__device__ __forceinline__ void ssd_scan(const Args& a, int tid) {
    unsigned char* ws = a.ws; bf16* ST = (bf16*)(ws + WS_ST); const float* CDEC = (const float*)(ws + WS_MISC + MISC_CDEC);
    for (int e4 = blockIdx.x * NTHR + tid; e4 < BATCH * SH * 2048; e4 += gridDim.x * NTHR) {
        const int b = e4 >> 16, rem = e4 & 65535, hh = rem >> 11, off = (rem & 2047) * 4;
        f32x4 h = {0.f, 0.f, 0.f, 0.f};
        bf16* p = ST + ((size_t)(b * NCH) * SH + hh) * 8192 + off;
        for (int c0 = 0; c0 < NCH; c0 += 8) { v2u s[8]; float dc[8];
#pragma unroll
            for (int j = 0; j < 8; ++j) { s[j] = *(const v2u*)(p + (size_t)(c0 + j) * SH * 8192); dc[j] = CDEC[(b * NCH + c0 + j) * SH + hh]; }
#pragma unroll
            for (int j = 0; j < 8; ++j) { v2u o; o.x = pk2(h.x, h.y); o.y = pk2(h.z, h.w); *(v2u*)(p + (size_t)(c0 + j) * SH * 8192) = o;
                const f32x4 sv = {bflo(s[j].x), bfhi(s[j].x), bflo(s[j].y), bfhi(s[j].y)}; h = h * dc[j] + sv; } }
    }
}

constexpr int S3_CC = 0, S3_BC = 34816, S3_CB = 69632, S3_TAB = 104448, S3_WV = 109568, S3_RMS = 117760, S3_END = 121856;
static_assert(S3_END <= RING_BYTES, "S3 LDS");
__device__ __forceinline__ void ssd_out(const Args& a, LAS unsigned char* lds, int tid, int wave, int lane) {
    unsigned char* ws = a.ws;
    const bf16* __restrict__ ZX = (const bf16*)(ws + WS_ZX); const float* __restrict__ DT = (const float*)(ws + WS_DT);
    const bf16* ST = (const bf16*)(ws + WS_ST); bf16* Y = (bf16*)(ws + WS_Y);
    LAS bf16* Cc = (LAS bf16*)(lds + S3_CC); LAS bf16* Bc = (LAS bf16*)(lds + S3_BC); LAS bf16* CB = (LAS bf16*)(lds + S3_CB);
    LAS float* ACS = (LAS float*)(lds + S3_WV + wave * 1024); LAS float* DTW = ACS + 128;
    LAS float* RMS = (LAS float*)(lds + S3_RMS);
    const int fi = lane & 15, fq = lane >> 4;
    const int u0 = (int)((blockIdx.x & 7) * (gridDim.x >> 3) + (blockIdx.x >> 3));
    v4u bcn[4], ccn[4];
#define S3_LOAD_BC(uu) do { const int b_ = (uu) >> 8, c_ = ((uu) >> 2) & 63, g_ = (uu) & 3; const size_t cg_ = (size_t)((b_ * NCH + c_) * NGRP + g_); \
        const bf16* bn_ = (const bf16*)(ws + WS_BN) + cg_ * 16384; const bf16* cn_ = (const bf16*)(ws + WS_CN) + cg_ * 16384; \
        _Pragma("unroll") for (int i = 0; i < 4; ++i) { const int idx = tid + NTHR * i, row = idx >> 4, c8 = (idx & 15) * 8; bcn[i] = *(const v4u*)(bn_ + row * 128 + c8); ccn[i] = *(const v4u*)(cn_ + row * 128 + c8); } } while (0)
    if (u0 < BATCH * NCH * NGRP) S3_LOAD_BC(u0);
    for (int u = u0; u < BATCH * NCH * NGRP; u += gridDim.x) {
        const int b = u >> 8, c = (u >> 2) & 63, g = u & 3; const int tok0 = b * SEQ + c * CHK;
        {
#pragma unroll
            for (int i = 0; i < 4; ++i) { const int idx = tid + NTHR * i, row = idx >> 4, c8 = (idx & 15) * 8;
                *(LAS v4u*)(Bc + row * 136 + c8) = bcn[i]; *(LAS v4u*)(Cc + row * 136 + c8) = ccn[i]; } }
        const int hh = 8 * g + wave; const float Ah = -__expf(a.in[I_MALOG][hh]); const float Dh = a.in[I_MD][hh];
        { float d0, d1, acs0, acs1, total; head_scan(DT, tok0, hh, Ah, lane, d0, d1, acs0, acs1, total);
            ACS[2 * lane] = acs0; ACS[2 * lane + 1] = acs1; DTW[2 * lane] = d0; DTW[2 * lane + 1] = d1; }
        bf16x8 Xf[4][4];
        { const bf16* xth = (const bf16*)(ws + WS_XT) + ((size_t)((b * NCH + c) * SH + hh)) * 8192;
#pragma unroll
            for (int pt = 0; pt < 4; ++pt)
#pragma unroll
                for (int ks = 0; ks < 4; ++ks) Xf[pt][ks] = *(const bf16x8*)(xth + (16 * pt + fi) * 128 + 32 * ks + 8 * fq); }
        __syncthreads();
        if (u + (int)gridDim.x < BATCH * NCH * NGRP) S3_LOAD_BC(u + (int)gridDim.x);
        { const int lt = wave;
#pragma unroll 1
            for (int st = 0; st < 8; ++st) { if (st <= lt) { f32x4 cacc = {0.f, 0.f, 0.f, 0.f};
#pragma unroll
                for (int kn = 0; kn < 4; ++kn) { const bf16x8 af = *(const LAS bf16x8*)(Bc + (16 * st + fi) * 136 + 32 * kn + 8 * fq), bfr = *(const LAS bf16x8*)(Cc + (16 * lt + fi) * 136 + 32 * kn + 8 * fq);
                    cacc = MFMA16(af, bfr, cacc); }
                v2u w; w.x = pk2(cacc[0], cacc[1]); w.y = pk2(cacc[2], cacc[3]);
                *(LAS v2u*)(CB + (16 * lt + fi) * 136 + 16 * st + 4 * fq) = w; } } }
        __syncthreads();
        const bf16* sth = ST + ((size_t)((b * NCH + c) * SH + hh)) * 8192;
        const float* __restrict__ ng = a.in[I_MNG];
#pragma unroll 1
        for (int lhi = 0; lhi < 4; ++lhi) {
            int lh = lhi; asm volatile("" : "+s"(lh));
            int fio = fi, fqo = fq; asm volatile("" : "+v"(fio), "+v"(fqo));
            f32x4 acc[4][2];
#pragma unroll
            for (int pt = 0; pt < 4; ++pt)
#pragma unroll
                for (int l4 = 0; l4 < 2; ++l4) acc[pt][l4] = (f32x4){0.f, 0.f, 0.f, 0.f};
            bf16x8 ah0[4], ah1[4];
#pragma unroll
            for (int pt = 0; pt < 4; ++pt) { ah0[pt] = *(const bf16x8*)(sth + (16 * pt + fio) * 128 + 8 * fqo); ah1[pt] = *(const bf16x8*)(sth + (16 * pt + fio) * 128 + 32 + 8 * fqo); }
#pragma unroll
            for (int kn = 0; kn < 4; ++kn) { bf16x8 bfr[2];
#pragma unroll
                for (int l4 = 0; l4 < 2; ++l4) bfr[l4] = *(const LAS bf16x8*)(Cc + (16 * (2 * lh + l4) + fio) * 136 + 32 * kn + 8 * fqo);
#pragma unroll
                for (int pt = 0; pt < 4; ++pt) { const bf16x8 ah = (kn & 1) ? ah1[pt] : ah0[pt];
#pragma unroll
                    for (int l4 = 0; l4 < 2; ++l4) acc[pt][l4] = MFMA16(ah, bfr[l4], acc[pt][l4]); }
                if (kn < 2) {
#pragma unroll
                    for (int pt = 0; pt < 4; ++pt) { const bf16x8 t = *(const bf16x8*)(sth + (16 * pt + fio) * 128 + 32 * (kn + 2) + 8 * fqo); if (kn & 1) ah1[pt] = t; else ah0[pt] = t; } }
                asm volatile("" ::: "memory"); }
#pragma unroll
            for (int l4 = 0; l4 < 2; ++l4) { const float ea = __expf(ACS[16 * (2 * lh + l4) + fio]);
#pragma unroll
                for (int pt = 0; pt < 4; ++pt) acc[pt][l4] *= ea; }
            v2u zq[2][4];
#pragma unroll
            for (int l4 = 0; l4 < 2; ++l4)
#pragma unroll
                for (int pt = 0; pt < 4; ++pt) zq[l4][pt] = *(const v2u*)(ZX + (size_t)(tok0 + 16 * (2 * lh + l4) + fio) * XW + hh * 64 + 16 * pt + 4 * fqo);
#pragma unroll
            for (int l4 = 0; l4 < 2; ++l4) { const int lt = 2 * lh + l4, l = 16 * lt + fio; const float al = ACS[l];
#pragma unroll
                for (int ks = 0; ks < 4; ++ks) { if (32 * ks <= 16 * lt + 15) { const int s0 = 32 * ks + 8 * fqo;
                    const v4u cb8 = *(const LAS v4u*)(CB + l * 136 + s0);
                    const f32x4 as0 = *(const LAS f32x4*)(ACS + s0), as1 = *(const LAS f32x4*)(ACS + s0 + 4), dt0 = *(const LAS f32x4*)(DTW + s0), dt1 = *(const LAS f32x4*)(DTW + s0 + 4);
                    const float cbv[8] = {bflo(cb8.x), bfhi(cb8.x), bflo(cb8.y), bfhi(cb8.y), bflo(cb8.z), bfhi(cb8.z), bflo(cb8.w), bfhi(cb8.w)};
                    const float asv[8] = {as0.x, as0.y, as0.z, as0.w, as1.x, as1.y, as1.z, as1.w}, dtv[8] = {dt0.x, dt0.y, dt0.z, dt0.w, dt1.x, dt1.y, dt1.z, dt1.w};
                    float mv[8];
#pragma unroll
                    for (int e = 0; e < 8; ++e) { const int s = s0 + e; float v = (s <= l) ? cbv[e] * __expf(al - asv[e]) * dtv[e] : 0.f; if (s == l) v += Dh; mv[e] = v; }
                    const bf16x8 mf = pack8(mv);
#pragma unroll
                    for (int pt = 0; pt < 4; ++pt) acc[pt][l4] = MFMA16(Xf[pt][ks], mf, acc[pt][l4]); asm volatile("" ::: "memory"); } } }
#pragma unroll
            for (int l4 = 0; l4 < 2; ++l4) { const int l = 16 * (2 * lh + l4) + fio; float ssq = 0.f;
#pragma unroll
                for (int pt = 0; pt < 4; ++pt) { const v2u z = zq[l4][pt];
                    const float zv[4] = {bflo(z.x), bfhi(z.x), bflo(z.y), bfhi(z.y)};
#pragma unroll
                    for (int r = 0; r < 4; ++r) { const float yv = acc[pt][l4][r] * silu_f(zv[r]); acc[pt][l4][r] = yv; ssq += yv * yv; } }
                ssq += __shfl_xor(ssq, 16); ssq += __shfl_xor(ssq, 32);
                if (fqo == 0) RMS[wave * 128 + l] = ssq; asm volatile("" ::: "memory"); }
            __syncthreads();
#pragma unroll
            for (int l4 = 0; l4 < 2; ++l4) { const int l = 16 * (2 * lh + l4) + fio; float tot = 0.f;
#pragma unroll
                for (int w = 0; w < 8; ++w) tot += RMS[w * 128 + l];
                const float rstd = rsq_f(tot * (1.0f / 512.0f) + EPS);
#pragma unroll
                for (int pt = 0; pt < 4; ++pt) { const int col = hh * 64 + 16 * pt + 4 * fqo; const f32x4 gv = *(const f32x4*)(ng + col);
                    v2u w; w.x = pk2(acc[pt][l4][0] * rstd * gv.x, acc[pt][l4][1] * rstd * gv.y); w.y = pk2(acc[pt][l4][2] * rstd * gv.z, acc[pt][l4][3] * rstd * gv.w);
                    *(v2u*)(Y + (size_t)(tok0 + l) * DI + col) = w; } }
        }
        __syncthreads();
    }
}

constexpr int AT_K = 0, AT_V = 36864, AT_TAB = 73728, AT_END = 75776;
__device__ __forceinline__ void attn_phase(const Args& a, LAS unsigned char* lds, int tid, int wave, int lane) {
    unsigned char* ws = a.ws;
    const bf16* __restrict__ QKV = (const bf16*)(ws + WS_QKV); bf16* AO = (bf16*)(ws + WS_AO);
    LAS bf16* Ks = (LAS bf16*)(lds + AT_K); LAS bf16* Vs = (LAS bf16*)(lds + AT_V); LAS float* TAB = (LAS float*)(lds + AT_TAB);
    const float* __restrict__ qg = a.in[I_AQNG]; const float* __restrict__ kg = a.in[I_AKNG];
    const int fi = lane & 15, fq = lane >> 4;
    const int u0 = (int)((blockIdx.x & 7) * (gridDim.x >> 3) + (blockIdx.x >> 3));
    v4u kxn[4], vxn[4];
#define AT_LOAD_KV(uu) do { const int b_ = (uu) >> 8, nb_ = ((uu) >> 2) & 63, g_ = (uu) & 3; const int key_ = tid >> 1, half_ = tid & 1; \
        const bf16* kp_ = QKV + (ptrdiff_t)(b_ * SEQ + nb_ * 128 - 128 + key_) * QKVW + 1024 + g_ * 64 + 32 * half_; \
        _Pragma("unroll") for (int j = 0; j < 4; ++j) { kxn[j] = *(const v4u*)(kp_ + 8 * j); vxn[j] = *(const v4u*)(kp_ + 256 + 8 * j); } } while (0)
    if (u0 < BATCH * 64 * KVH) AT_LOAD_KV(u0);
    for (int u = u0; u < BATCH * 64 * KVH; u += gridDim.x) {
        const int b = u >> 8, nb = (u >> 2) & 63, g = u & 3; const int tokq0 = b * SEQ + nb * 128;
        { const int key = tid >> 1, half = tid & 1; const bool valid = (nb > 0) || (key >= 128);
            v4u kx[4], vx[4];
            {
#pragma unroll
                for (int j = 0; j < 4; ++j) { kx[j] = kxn[j]; vx[j] = vxn[j]; }
                if (!valid) {
#pragma unroll
                    for (int j = 0; j < 4; ++j) { kx[j] = (v4u){0u, 0u, 0u, 0u}; vx[j] = (v4u){0u, 0u, 0u, 0u}; } } }
            float kf[32]; float ss = 0.f;
#pragma unroll
            for (int j = 0; j < 4; ++j) { kf[8 * j + 0] = bflo(kx[j].x); kf[8 * j + 1] = bfhi(kx[j].x); kf[8 * j + 2] = bflo(kx[j].y); kf[8 * j + 3] = bfhi(kx[j].y);
                kf[8 * j + 4] = bflo(kx[j].z); kf[8 * j + 5] = bfhi(kx[j].z); kf[8 * j + 6] = bflo(kx[j].w); kf[8 * j + 7] = bfhi(kx[j].w); }
#pragma unroll
            for (int e = 0; e < 32; ++e) ss += kf[e] * kf[e];
            ss += __shfl_xor(ss, 1);
            const float r = rsq_f(ss * (1.0f / 64.0f) + EPS);
#pragma unroll
            for (int j = 0; j < 4; ++j) { float o[8];
#pragma unroll
                for (int e = 0; e < 8; ++e) o[e] = kf[8 * j + e] * r * kg[32 * half + 8 * j + e];
                *(LAS bf16x8*)(Ks + key * 72 + 32 * half + 8 * j) = pack8(o);
                *(LAS v4u*)(Vs + key * 72 + 32 * half + 8 * j) = vx[j]; } }
        { const int r = tid >> 7, dist = tid & 127; int bucket;
            if (dist < 16) bucket = dist; else { bucket = 16 + (int)(logf((float)dist / 16.0f) / logf(8.0f) * 16.0f); bucket = bucket < 31 ? bucket : 31; }
            TAB[r * 128 + dist] = a.in[I_RELB][bucket * 16 + 4 * g + r]; }
        __syncthreads();
        if (u + (int)gridDim.x < BATCH * 64 * KVH) AT_LOAD_KV(u + (int)gridDim.x);
        const int r = wave >> 1, hf = wave & 1, h = 4 * g + r; const float sink = a.in[I_ASINK][h];
        for (int qt = 0; qt < 4; ++qt) {
            const int qi0 = 64 * hf + 16 * qt;
            bf16x8 Qf[2];
            { const bf16* qp = QKV + (size_t)(tokq0 + qi0 + fi) * QKVW + h * 64 + 8 * fq;
                const v4u q0 = *(const v4u*)qp, q1 = *(const v4u*)(qp + 32);
                float f0[8] = {bflo(q0.x), bfhi(q0.x), bflo(q0.y), bfhi(q0.y), bflo(q0.z), bfhi(q0.z), bflo(q0.w), bfhi(q0.w)};
                float f1[8] = {bflo(q1.x), bfhi(q1.x), bflo(q1.y), bfhi(q1.y), bflo(q1.z), bfhi(q1.z), bflo(q1.w), bfhi(q1.w)};
                float ss = 0.f;
#pragma unroll
                for (int e = 0; e < 8; ++e) ss += f0[e] * f0[e] + f1[e] * f1[e];
                ss += __shfl_xor(ss, 16); ss += __shfl_xor(ss, 32);
                const float rs = 0.125f * rsq_f(ss * (1.0f / 64.0f) + EPS);
#pragma unroll
                for (int e = 0; e < 8; ++e) { f0[e] *= rs * qg[8 * fq + e]; f1[e] *= rs * qg[32 + 8 * fq + e]; }
                Qf[0] = pack8(f0); Qf[1] = pack8(f1); }
            const int kt0 = (qi0 >> 4) < 6 ? (qi0 >> 4) : 6;
            f32x4 s[10];
#pragma unroll
            for (int kt = 0; kt < 10; ++kt) { const LAS bf16* kp = Ks + (16 * (kt0 + kt) + fi) * 72 + 8 * fq;
                f32x4 z = {0.f, 0.f, 0.f, 0.f};
                z = MFMA16(*(const LAS bf16x8*)kp, Qf[0], z); z = MFMA16(*(const LAS bf16x8*)(kp + 32), Qf[1], z); s[kt] = z; }
            const int qi = qi0 + fi; float mx = -__builtin_inff();
#pragma unroll
            for (int kt = 0; kt < 10; ++kt)
#pragma unroll
                for (int rr = 0; rr < 4; ++rr) { const int kj = 16 * (kt0 + kt) + 4 * fq + rr; const int dist = qi + 128 - kj;
                    const bool valid = (dist >= 0) && (dist < 128) && ((nb > 0) || (kj >= 128));
                    const float sc = valid ? s[kt][rr] + TAB[r * 128 + (dist & 127)] : -__builtin_inff();
                    s[kt][rr] = sc; mx = fmaxf(mx, sc); }
            mx = fmaxf(mx, __shfl_xor(mx, 16)); mx = fmaxf(mx, __shfl_xor(mx, 32)); mx = fmaxf(mx, sink);
            float sum = 0.f;
#pragma unroll
            for (int kt = 0; kt < 10; ++kt)
#pragma unroll
                for (int rr = 0; rr < 4; ++rr) { const float p = __expf(s[kt][rr] - mx); s[kt][rr] = p; sum += p; }
            sum += __shfl_xor(sum, 16); sum += __shfl_xor(sum, 32);
            const float inv = rcp_f(sum + __expf(sink - mx));
            f32x4 o[4];
#pragma unroll
            for (int dt = 0; dt < 4; ++dt) o[dt] = (f32x4){0.f, 0.f, 0.f, 0.f};
#pragma unroll
            for (int kk = 0; kk < 5; ++kk) {
                const float pv[8] = {s[2 * kk][0], s[2 * kk][1], s[2 * kk][2], s[2 * kk][3], s[2 * kk + 1][0], s[2 * kk + 1][1], s[2 * kk + 1][2], s[2 * kk + 1][3]};
                const bf16x8 pf = pack8(pv);
#pragma unroll
                for (int dt = 0; dt < 4; ++dt) {
                    const LAS bf16* vp0 = Vs + (16 * (kt0 + 2 * kk) + 4 * fq + (fi >> 2)) * 72 + 16 * dt + 4 * (fi & 3);
                    const v4i16_t t0 = __builtin_amdgcn_ds_read_tr16_b64_v4i16((LAS v4i16_t*)vp0);
                    const v4i16_t t1 = __builtin_amdgcn_ds_read_tr16_b64_v4i16((LAS v4i16_t*)(vp0 + 16 * 72));
                    const bf16x8 vf = {t0[0], t0[1], t0[2], t0[3], t1[0], t1[1], t1[2], t1[3]};
                    o[dt] = MFMA16(vf, pf, o[dt]); } }
            bf16* op = AO + (size_t)(tokq0 + qi) * 1024 + h * 64 + 4 * fq;
#pragma unroll
            for (int dt = 0; dt < 4; ++dt) { v2u w; w.x = pk2(o[dt][0] * inv, o[dt][1] * inv); w.y = pk2(o[dt][2] * inv, o[dt][3] * inv); *(v2u*)(op + 16 * dt) = w; }
        }
        __syncthreads();
    }
}

constexpr int NPHASE = 20;
constexpr int BG6_PER = 8, BG6 = 256 * BG6_PER;
constexpr int BGQ9 = 4, BGQ10 = 3, BGQ12 = 3;
__device__ __forceinline__ int bg_done9(int nt) { const int r = (nt * 8) & 255; return BG6 + (r ? (256 - r) * BGQ9 : 0); }
__device__ __forceinline__ int bg_done10(int nt) { const int r = (nt * 4) & 255; return bg_done9(nt) + (r ? (256 - r) * BGQ10 : 0); }
__global__ void __launch_bounds__(NTHR, 2) fwd_kernel(Args args) {
    extern __shared__ __attribute__((aligned(16))) unsigned char lds_raw[];
    LAS unsigned char* lds = (LAS unsigned char*)lds_raw;
    volatile LAS unsigned* MISC = (volatile LAS unsigned*)(lds + MISC_OFF);
    const int tid = threadIdx.x, lane = tid & 63, wave = __builtin_amdgcn_readfirstlane(tid >> 6);
    const int G = gridDim.x;
    unsigned char* ws = args.ws;
    gu32* ctl = (gu32*)(ws + WS_CTL);
    for (int u = tid; u < (LDS_BYTES - LDSCTL_OFF) / 4; u += NTHR) ((LAS unsigned*)(lds + LDSCTL_OFF))[u] = 0u;
    __syncthreads();
    XcdBarrier bar = xcd_barrier_post((unsigned*)(ctl + CW_BAR), MISC + 8);
    const int lo = args.ph_lo, hi = args.ph_hi;
    int nt_l0 = 256;
#ifndef PROBE_MASK
#define PROBE_MASK 0
#endif
#define PROBE_REP(k) ((int)(((unsigned)PROBE_MASK >> (k)) & 1u))
#define PHASE(k, ...) do { if (IN(k)) { __VA_ARGS__ } if (IN(k) && PROBE_REP(k)) { __VA_ARGS__ } } while (0)
#ifdef ONLYMASK
#define IN(k) (((ONLYMASK >> (k)) & 1) && lo <= (k) && (k) < hi)
#else
#define IN(k) (lo <= (k) && (k) < hi)
#endif
#define SEAM(k) do { if (IN(k) && IN((k) + 1)) xcd_barrier(bar); } while (0)
    bf16* H = (bf16*)(ws + WS_H);
    float* X1 = (float*)(ws + WS_X1); float* X2 = (float*)(ws + WS_X2); float* X3 = (float*)(ws + WS_X3);
    float* GATE = (float*)(ws + WS_MISC + MISC_GATE);
    const unsigned char* YK = (const unsigned char*)(ws + WS_YK);

    PHASE(0,  p0_prologue(args, lds, wave, lane); p0_quant(args, lds, wave, lane); ); SEAM(0);
    PHASE(1,
        { const int gid = blockIdx.x * NTHR + tid; if (gid < 8192) { const int l = gid >> 12, w = (gid >> 11) & 1, b = (gid >> 10) & 1, col = gid & 1023; GATE[gid] = modval(args, l, b, (w ? 5120 : 2048) + col); } }
        norm_phase<0, false, true>(args, lds, 0, 0, args.in[I_X], nullptr, nullptr, nullptr, args.in[I_MINW] + XW, IN_DIM, args.in[I_MDTB], tid, wave, lane);
    ); SEAM(1);
    PHASE(2,  const bool grpA_ = (((int)blockIdx.x >> 3) & 1) == 0;
        if (grpA_) bg_run(args, lds, (int)blockIdx.x, 12, 256, wave, lane, 0);
        pg8::Gemm g{H, (const bf16*)(ws + WS_WIN), T, XW, D}; pg8::StaticOrder S; S.init(T, XW, G, (int)blockIdx.x);
        pg8::EpiBf16Q E{(bf16*)(ws + WS_ZX), XW, (const float*)(ws + WS_H + HS_OFF), (const float*)(ws + WS_WSC + WSC_IN)};
        pg8::gemm_phase<pg8::EpiBf16Q, pg8::StaticOrder, true, true>(lds + RING_OFF, g, S, E, lds + EPIX_OFF);
        if (!grpA_) bg_run(args, lds, (int)blockIdx.x, 12, 256, wave, lane, 0); ); SEAM(2);
    PHASE(3,  ssd_states(args, lds, tid, wave, lane); ); SEAM(3);
    PHASE(4,  ssd_scan(args, tid); ); SEAM(4);
    PHASE(5,  ssd_out(args, lds, tid, wave, lane); ); SEAM(5);
    PHASE(6,  const bool grpA6_ = (((int)blockIdx.x >> 3) & 1) == 0;
        if (!grpA6_) bg_run(args, lds, (int)blockIdx.x, BG6_PER, 256, wave, lane, 32);
        pg8::Gemm g{(const bf16*)(ws + WS_Y), (const bf16*)(ws + WS_WOUT), T, D, DI}; pg8::StaticOrder S; S.init(T, D, G, (int)blockIdx.x);
        pg8::EpiResid E{args.in[I_X], X1, GATE + (0 * 2 + 0) * 2048};
        pg8::gemm_phase<pg8::EpiResid, pg8::StaticOrder, true, true>(lds + RING_OFF, g, S, E);
        if (grpA6_) bg_run(args, lds, (int)blockIdx.x, BG6_PER, 256, wave, lane, 32); ); SEAM(6);
#define MOE_PHASES(layer, pb, xres) \
    PHASE(pb,  norm_phase<1, false, true>(args, lds, layer, 1, xres, nullptr, nullptr, nullptr, args.in[I_RW] + (size_t)(layer) * 1024 * 32, 32, args.in[I_RB] + (layer) * 32, tid, wave, lane); ); SEAM(pb); \
    PHASE((pb) + 1,  moe_scatter(args, lds, tid, wave, lane); \
        if ((layer) == 1) { const int d_ = bg_done10(nt_l0) + 128 * BGQ12; bg_run(args, lds, d_ + (int)blockIdx.x, 16, 256, wave, lane); } ); SEAM((pb) + 1); \
    PHASE((pb) + 2,  load_tile_table(args, lds, tid); \
        const volatile LAS int* TE = (const volatile LAS int*)(lds + TE_OFF); \
        pg8::Gemm g{(const bf16*)(ws + WS_H), (const bf16*)(ws + WS_W1 + (size_t)(layer) * 32 * 2048 * 1024), CAP, 32 * 2048, D}; \
        pg8::MoeGatherOrder S{(int)TE[MAXTILES], 8, G, (int)((blockIdx.x & 7) * 32 + (blockIdx.x >> 3)), TE, (const int*)(ws + WS_XG), (LAS int*)(lds + ROWT_OFF)}; \
        pg8::EpiSwigluQ E{(unsigned char*)(ws + WS_ACT), args.in[I_EB1] + (size_t)(layer) * 32 * 2048, (const float*)(ws + WS_XG + XGS_OFF), (const float*)(ws + WS_WSC + WSC_W1) + (size_t)(layer) * 32 * 2048}; \
        pg8::gemm_phase<pg8::EpiSwigluQ, pg8::MoeGatherOrder, true, true>(lds + RING_OFF, g, S, E, lds + EPIX_OFF); \
        if ((layer) == 0) { const int nt_ = (int)TE[MAXTILES]; nt_l0 = nt_; const int r_ = (nt_ * 8) & 255, vc_ = (int)((blockIdx.x & 7) * 32 + (blockIdx.x >> 3)); if (r_ && vc_ >= r_) bg_run(args, lds, BG6 + (vc_ - r_) * BGQ9, BGQ9, 1, wave, lane); } ); SEAM((pb) + 2); \
    PHASE((pb) + 3,  load_tile_table(args, lds, tid); \
        const volatile LAS int* TE = (const volatile LAS int*)(lds + TE_OFF); \
        pg8::Gemm g{(const bf16*)(ws + WS_ACT), (const bf16*)(ws + WS_W2 + (size_t)(layer) * 32 * 1024 * 1024), CAP, 32 * 1024, FF}; \
        pg8::MoeOrder S{(int)TE[MAXTILES], 4, G, (int)((blockIdx.x & 7) * 32 + (blockIdx.x >> 3)), TE, nullptr, nullptr}; \
        pg8::EpiMoeOutF8 E{(unsigned char*)(ws + WS_YK), args.in[I_EB2] + (size_t)(layer) * 32 * 1024, (const float*)(ws + WS_WSC + WSC_W2) + (size_t)(layer) * 32 * 1024, (const int*)(ws + WS_SRT), (const float*)(ws + WS_SRT + 524288)}; \
        pg8::gemm_phase<pg8::EpiMoeOutF8, pg8::MoeOrder, true, true>(lds + RING_OFF, g, S, E, lds + EPIX_OFF); \
        if ((layer) == 0) { const int nt_ = (int)TE[MAXTILES]; const int r_ = (nt_ * 4) & 255, vc_ = (int)((blockIdx.x & 7) * 32 + (blockIdx.x >> 3)); if (r_ && vc_ >= r_) bg_run(args, lds, bg_done9(nt_) + (vc_ - r_) * BGQ10, BGQ10, 1, wave, lane); } ); SEAM((pb) + 3);

    MOE_PHASES(0, 7, X1)
    PHASE(11,  norm_phase<2, true, true>(args, lds, 1, 0, X1, GATE + (0 * 2 + 1) * 2048, YK, X2, nullptr, 0, nullptr, tid, wave, lane); ); SEAM(11);
    PHASE(12,  pg8::Gemm g{H, (const bf16*)(ws + WS_WQKV), T, QKVW, D}; pg8::StaticOrder S; S.init(T, QKVW, G, (int)blockIdx.x);
        pg8::EpiBf16Q E{(bf16*)(ws + WS_QKV), QKVW, (const float*)(ws + WS_H + HS_OFF), (const float*)(ws + WS_WSC + WSC_QKV)};
        pg8::gemm_phase<pg8::EpiBf16Q, pg8::StaticOrder, true, true>(lds + RING_OFF, g, S, E, lds + EPIX_OFF);
        if ((int)blockIdx.x >= 128) bg_run(args, lds, bg_done10(nt_l0) + ((int)blockIdx.x - 128) * BGQ12, BGQ12, 1, wave, lane); ); SEAM(12);
    PHASE(13,  attn_phase(args, lds, tid, wave, lane); ); SEAM(13);
    PHASE(14,  pg8::Gemm g{(const bf16*)(ws + WS_AO), (const bf16*)(ws + WS_WAO), T, D, D}; pg8::StaticOrder S; S.init(T, D, G, (int)blockIdx.x);
        pg8::EpiResid E{X2, X3, GATE + (1 * 2 + 0) * 2048};
        pg8::gemm_phase<pg8::EpiResid, pg8::StaticOrder, true, true>(lds + RING_OFF, g, S, E); ); SEAM(14);
    MOE_PHASES(1, 15, X3)
    PHASE(19,  norm_phase<2, true, false>(args, lds, 1, 0, X3, GATE + (1 * 2 + 1) * 2048, YK, args.out, nullptr, 0, nullptr, tid, wave, lane); );
#undef MOE_PHASES
#undef IN
#undef SEAM
}

extern "C" void kernel_launch(void* const* d_in, const int* in_sizes, int n_in, void* d_out, int out_size, void* d_ws, size_t ws_size, hipStream_t stream) {
    static int grid = 0;
    if (grid == 0) {
        if (n_in != 26 || in_sizes[0] != T * D || out_size != T * D || ws_size < WS_END) { fprintf(stderr, "kernel_launch: unexpected shapes (n_in %d, in0 %d, out %d, ws %zu)\n", n_in, n_in > 0 ? in_sizes[0] : -1, out_size, ws_size); grid = -1; return; }
        if (hipFuncSetAttribute((const void*)fwd_kernel, hipFuncAttributeMaxDynamicSharedMemorySize, LDS_BYTES) != hipSuccess) { fprintf(stderr, "kernel_launch: hipFuncSetAttribute failed\n"); grid = -1; return; }
        int per_cu = 0;
        if (hipOccupancyMaxActiveBlocksPerMultiprocessor(&per_cu, (const void*)fwd_kernel, NTHR, LDS_BYTES) != hipSuccess || per_cu < 1) fprintf(stderr, "kernel_launch: occupancy query reports %d\n", per_cu);
        (void)hipGetLastError();
        grid = 256;
    }
    if (grid < 0) return;
    if (hipMemsetAsync((char*)d_ws + WS_CTL, 0, CTL_ZERO_BYTES, stream) != hipSuccess) { fprintf(stderr, "kernel_launch: memset failed\n"); return; }
    Args a{};
    for (int i = 0; i < 26; ++i) a.in[i] = (const float*)d_in[i];
    a.out = (float*)d_out; a.ws = (unsigned char*)d_ws;
#ifndef MK_SPLIT
    a.ph_lo = 0; a.ph_hi = NPHASE;
    hipLaunchKernelGGL(fwd_kernel, dim3(grid), dim3(NTHR), LDS_BYTES, stream, a);
#else
    for (int p = 0; p < NPHASE; ++p) { a.ph_lo = p; a.ph_hi = p + 1; hipLaunchKernelGGL(fwd_kernel, dim3(grid), dim3(NTHR), LDS_BYTES, stream, a); }
#endif
}
```

```cpp
#include <hip/hip_runtime.h>
#include <cstdio>
#include <cstdint>

#define GAS __attribute__((address_space(1)))
#define LAS __attribute__((address_space(3)))
typedef unsigned short bf16;
typedef unsigned v4u __attribute__((ext_vector_type(4)));
typedef unsigned v2u __attribute__((ext_vector_type(2)));
typedef float f32x4 __attribute__((ext_vector_type(4)));
typedef short bf16x8 __attribute__((ext_vector_type(8)));
typedef short v4i16_t __attribute__((ext_vector_type(4)));
typedef GAS unsigned gu32;

namespace pg8 {
#define PG8_LAS __attribute__((address_space(3)))
typedef unsigned short bf16_t;
typedef unsigned u32x4 __attribute__((ext_vector_type(4)));
typedef int i32x4 __attribute__((ext_vector_type(4)));
constexpr int BM = 256, BK = 64, HALF = 128, HTB = HALF * BK * 2, STAGE_BYTES = 8 * HTB, NXCD = 8, WGM = 8;
__host__ __device__ __forceinline__ int lds_byte(int r, int c) { const int st = (r >> 4) * 2 + (c >> 5), rr = r & 15, cc = c & 31, ob = rr * 64 + cc * 2; return st * 1024 + (ob ^ (((ob >> 9) & 1) << 5)); }
__host__ __device__ __forceinline__ void stage_rc(int b, int& R, int& C) { const int st = b / 1024, sb = b % 1024, swz = sb ^ (((sb >> 9) & 1) << 5); R = (st >> 1) * 16 + swz / 64; C = (st & 1) * 32 + (swz % 64) / 2; }
__host__ __device__ __forceinline__ int perm32(int rho) { const int n = rho >> 4, i = rho & 15; return 8 * (i >> 2) + 4 * n + (i & 3); }
struct Unit { int pm, pn; };
struct Gemm { const bf16_t* A; const bf16_t* Bt; int M, N, K; };
struct StaticOrder {
    int nM, nN, nwg, G, c;
    __host__ __device__ void init(int M, int N, int G_, int c_) { nM = M / BM; nN = N / BM; nwg = nM * nN; G = G_; c = c_; }
    __host__ __device__ bool next(int i, Unit& u) const {
        const long L = (long)i * G + c; if (L >= nwg) return false;
        int wgid = (int)L; { const int q = nwg / NXCD, r = nwg % NXCD, xcd = wgid % NXCD, off = wgid / NXCD; wgid = (xcd < r ? xcd * (q + 1) : r * (q + 1) + (xcd - r) * q) + off; }
        const int nig = WGM * nN, gid = wgid / nig, fm = gid * WGM, gsz = (nM - fm) < WGM ? (nM - fm) : WGM;
        u.pm = fm + ((wgid % nig) % gsz); u.pn = (wgid % nig) / gsz; return true;
    }
    static constexpr bool GATHER = false; const int* rowoff = nullptr; PG8_LAS int* rowt = nullptr;
    __device__ __forceinline__ void a_ready(const Unit&) const {}
    __device__ __forceinline__ void done(const Unit&) const {}
};
template <bool GATHER_> struct MoeOrderT {
    static constexpr bool GATHER = GATHER_;
    int ntiles, NT, G, c; const volatile PG8_LAS int* te; const int* rowoff; PG8_LAS int* rowt;
    __device__ bool next(int i, Unit& u) const {
        const int L = i * G + c; if (L >= ntiles * NT) return false;
        const int tile = L / NT, n = L % NT; const int e = __builtin_amdgcn_readfirstlane(te[tile]);
        u.pm = tile; u.pn = e * NT + n; return true;
    }
    __device__ __forceinline__ void a_ready(const Unit&) const {}
    __device__ __forceinline__ void done(const Unit&) const {}
};
typedef MoeOrderT<false> MoeOrder; typedef MoeOrderT<true> MoeGatherOrder;
__device__ __forceinline__ unsigned cvt_pk_bf16(float lo, float hi) { unsigned r; asm volatile("v_cvt_pk_bf16_f32 %0, %1, %2" : "=v"(r) : "v"(lo), "v"(hi)); return r; }

struct EpiBf16 {
    static constexpr int NSTAGE = 0; __device__ __forceinline__ const void* stage_src(int, const Unit&) const { return nullptr; }
    static constexpr bool PERM = true, AFTER_DRAIN = false; static constexpr int MODE = 0; typedef f32x4 acc_t;
    bf16_t* O; int ldc;
    __device__ __forceinline__ void operator()(const f32x4 (&acc)[2][2][4][2], const Unit& u, int wr, int wc, int fr, int fq, const PG8_LAS unsigned char* xl) const {
        const int row0 = u.pm * BM + wr * 64 + fr, col0 = u.pn * BM + wc * 32 + 8 * fq;
#pragma unroll
        for (int ai = 0; ai < 2; ++ai)
#pragma unroll
            for (int m = 0; m < 4; ++m) { bf16_t* rowp = O + (size_t)(row0 + ai * HALF + m * 16) * ldc + col0;
#pragma unroll
                for (int bj = 0; bj < 2; ++bj) { const f32x4 v0 = acc[ai][bj][m][0], v1 = acc[ai][bj][m][1];
                    u32x4 w; w.x = cvt_pk_bf16(v0[0], v0[1]); w.y = cvt_pk_bf16(v0[2], v0[3]); w.z = cvt_pk_bf16(v1[0], v1[1]); w.w = cvt_pk_bf16(v1[2], v1[3]);
                    *(u32x4*)(rowp + bj * HALF) = w; } }
    }
};
struct EpiResid {
    static constexpr int NSTAGE = 0; __device__ __forceinline__ const void* stage_src(int, const Unit&) const { return nullptr; }
    static constexpr bool PERM = true, AFTER_DRAIN = false; static constexpr int MODE = 0; typedef f32x4 acc_t;
    const float* res; float* out; const float* gate;
    __device__ __forceinline__ void operator()(const f32x4 (&acc)[2][2][4][2], const Unit& u, int wr, int wc, int fr, int fq, const PG8_LAS unsigned char* xl) const {
        const int row0 = u.pm * BM + wr * 64 + fr, col0 = u.pn * BM + wc * 32 + 8 * fq; const int b = (u.pm * BM) >> 13;
        f32x4 gv[2][2];
#pragma unroll
        for (int bj = 0; bj < 2; ++bj)
#pragma unroll
            for (int n = 0; n < 2; ++n) gv[bj][n] = *(const f32x4*)(gate + b * 1024 + col0 + bj * HALF + 4 * n);
#pragma unroll
        for (int ai = 0; ai < 2; ++ai)
#pragma unroll
            for (int m = 0; m < 4; ++m) { const size_t off = (size_t)(row0 + ai * HALF + m * 16) * 1024 + col0;
#pragma unroll
                for (int bj = 0; bj < 2; ++bj)
#pragma unroll
                    for (int n = 0; n < 2; ++n) { const f32x4 r4 = *(const f32x4*)(res + off + bj * HALF + 4 * n);
                        *(f32x4*)(out + off + bj * HALF + 4 * n) = r4 + gv[bj][n] * acc[ai][bj][m][n]; } }
    }
};
struct EpiSwiglu {
    static constexpr int NSTAGE = 0; __device__ __forceinline__ const void* stage_src(int, const Unit&) const { return nullptr; }
    static constexpr bool PERM = true, AFTER_DRAIN = false; static constexpr int MODE = 0; typedef f32x4 acc_t;
    bf16_t* act; const float* b1;
    __device__ __forceinline__ void operator()(const f32x4 (&acc)[2][2][4][2], const Unit& u, int wr, int wc, int fr, int fq, const PG8_LAS unsigned char* xl) const {
        const int row0 = u.pm * BM + wr * 64 + fr; const int e = u.pn >> 3, ntile = u.pn & 7;
        const int c0 = ntile * BM + wc * 32 + 8 * fq;
        f32x4 bv[2][2];
#pragma unroll
        for (int bj = 0; bj < 2; ++bj)
#pragma unroll
            for (int n = 0; n < 2; ++n) bv[bj][n] = *(const f32x4*)(b1 + e * 2048 + c0 + bj * HALF + 4 * n);
#pragma unroll
        for (int ai = 0; ai < 2; ++ai)
#pragma unroll
            for (int m = 0; m < 4; ++m) { bf16_t* rowp = act + (size_t)(row0 + ai * HALF + m * 16) * 1024 + (c0 >> 1);
#pragma unroll
                for (int bj = 0; bj < 2; ++bj) { const f32x4 v0 = acc[ai][bj][m][0] + bv[bj][0], v1 = acc[ai][bj][m][1] + bv[bj][1];
                    float o[4];
                    const float g[4] = {v0[0], v0[2], v1[0], v1[2]}, l[4] = {v0[1], v0[3], v1[1], v1[3]};
#pragma unroll
                    for (int t = 0; t < 4; ++t) { const float xg = fminf(g[t], 7.0f), xl = fminf(fmaxf(l[t], -7.0f), 7.0f);
                        o[t] = xg * __builtin_amdgcn_rcpf(1.0f + __expf(-1.702f * xg)) * (xl + 1.0f); }
                    v2u w; w.x = cvt_pk_bf16(o[0], o[1]); w.y = cvt_pk_bf16(o[2], o[3]);
                    *(v2u*)(rowp + bj * (HALF / 2)) = w; } }
    }
};
struct EpiMoeOut {
    static constexpr int NSTAGE = 0; __device__ __forceinline__ const void* stage_src(int, const Unit&) const { return nullptr; }
    static constexpr bool PERM = true, AFTER_DRAIN = false; static constexpr int MODE = 0; typedef f32x4 acc_t;
    bf16_t* yk; const float* b2; const int* srt_tok; const float* srt_gate;
    __device__ __forceinline__ void operator()(const f32x4 (&acc)[2][2][4][2], const Unit& u, int wr, int wc, int fr, int fq, const PG8_LAS unsigned char* xl) const {
        const int row0 = u.pm * BM + wr * 64 + fr; const int e = u.pn >> 2, ntile = u.pn & 3;
        const int c0 = ntile * BM + wc * 32 + 8 * fq;
        f32x4 bv[2][2];
#pragma unroll
        for (int bj = 0; bj < 2; ++bj)
#pragma unroll
            for (int n = 0; n < 2; ++n) bv[bj][n] = *(const f32x4*)(b2 + e * 1024 + c0 + bj * HALF + 4 * n);
#pragma unroll
        for (int ai = 0; ai < 2; ++ai)
#pragma unroll
            for (int m = 0; m < 4; ++m) { const int pos = row0 + ai * HALF + m * 16; const int id = srt_tok[pos]; const float gt = srt_gate[pos];
                if (id >= 0) { bf16_t* rowp = yk + (size_t)id * 1024 + c0;
#pragma unroll
                    for (int bj = 0; bj < 2; ++bj) { const f32x4 v0 = (acc[ai][bj][m][0] + bv[bj][0]) * gt, v1 = (acc[ai][bj][m][1] + bv[bj][1]) * gt;
                        u32x4 w; w.x = cvt_pk_bf16(v0[0], v0[1]); w.y = cvt_pk_bf16(v0[2], v0[3]); w.z = cvt_pk_bf16(v1[0], v1[1]); w.w = cvt_pk_bf16(v1[2], v1[3]);
                        *(u32x4*)(rowp + bj * HALF) = w; } } }
    }
};

struct EpiBf16Q {
    static constexpr bool PERM = true, AFTER_DRAIN = false; static constexpr int MODE = 1; typedef i32x4 acc_t;
    bf16_t* O; int ldc; const float* sa; const float* sb;
    static constexpr int NSTAGE = 2; __device__ __forceinline__ const void* stage_src(int k, const Unit& u) const { return k == 0 ? (const void*)(sa + u.pm * BM) : (const void*)(sb + u.pn * BM); }
    __device__ __forceinline__ void operator()(const i32x4 (&acc)[2][2][4][2], const Unit& u, int wr, int wc, int fr, int fq, const PG8_LAS unsigned char* xl) const {
        const int row0 = u.pm * BM + wr * 64 + fr, col0 = u.pn * BM + wc * 32 + 8 * fq;
        f32x4 sv[2][2];
#pragma unroll
        for (int bj = 0; bj < 2; ++bj)
#pragma unroll
            for (int n = 0; n < 2; ++n) sv[bj][n] = *(const PG8_LAS f32x4*)(xl + 1024 + (wc * 32 + 8 * fq + bj * HALF + 4 * n) * 4);
#pragma unroll
        for (int ai = 0; ai < 2; ++ai)
#pragma unroll
            for (int m = 0; m < 4; ++m) { const int row = row0 + ai * HALF + m * 16; const float s = *(const PG8_LAS float*)(xl + (wr * 64 + fr + ai * HALF + m * 16) * 4); bf16_t* rowp = O + (size_t)row * ldc + col0;
#pragma unroll
                for (int bj = 0; bj < 2; ++bj) { const f32x4 v0 = __builtin_convertvector(acc[ai][bj][m][0], f32x4) * (sv[bj][0] * s), v1 = __builtin_convertvector(acc[ai][bj][m][1], f32x4) * (sv[bj][1] * s);
                    u32x4 w; w.x = cvt_pk_bf16(v0[0], v0[1]); w.y = cvt_pk_bf16(v0[2], v0[3]); w.z = cvt_pk_bf16(v1[0], v1[1]); w.w = cvt_pk_bf16(v1[2], v1[3]);
                    *(u32x4*)(rowp + bj * HALF) = w; } }
    }
};
__device__ __forceinline__ void xpose4(unsigned& r0, unsigned& r1, unsigned& r2, unsigned& r3) {
    { const auto t = __builtin_amdgcn_permlane32_swap(r0, r2, false, false); r0 = t[0]; r2 = t[1]; }
    { const auto t = __builtin_amdgcn_permlane32_swap(r1, r3, false, false); r1 = t[0]; r3 = t[1]; }
    { const auto t = __builtin_amdgcn_permlane16_swap(r0, r1, false, false); r0 = t[0]; r1 = t[1]; }
    { const auto t = __builtin_amdgcn_permlane16_swap(r2, r3, false, false); r2 = t[0]; r3 = t[1]; }
}
struct EpiSwigluQ {
    static constexpr bool PERM = true, AFTER_DRAIN = false; static constexpr int MODE = 1; typedef i32x4 acc_t;
    unsigned char* act; const float* b1; const float* sa; const float* sb;
    static constexpr int NSTAGE = 3;
    __device__ __forceinline__ const void* stage_src(int k, const Unit& u) const { const int e = u.pn >> 3, ntile = u.pn & 7;
        return k == 0 ? (const void*)(sa + u.pm * BM) : (k == 1 ? (const void*)(b1 + e * 2048 + ntile * BM) : (const void*)(sb + e * 2048 + ntile * BM)); }
    __device__ __forceinline__ void operator()(const i32x4 (&acc)[2][2][4][2], const Unit& u, int wr, int wc, int fr, int fq, const PG8_LAS unsigned char* xl) const {
        const int row0 = u.pm * BM + wr * 64 + fr; const int e = u.pn >> 3, ntile = u.pn & 7;
        const int c0 = ntile * BM + wc * 32 + 8 * fq;
        f32x4 bv[2][2], sv[2][2];
#pragma unroll
        for (int bj = 0; bj < 2; ++bj)
#pragma unroll
            for (int n = 0; n < 2; ++n) { const int cl = (wc * 32 + 8 * fq + bj * HALF + 4 * n) * 4; bv[bj][n] = *(const PG8_LAS f32x4*)(xl + 1024 + cl); sv[bj][n] = *(const PG8_LAS f32x4*)(xl + 2048 + cl); }
#pragma unroll
        for (int ai = 0; ai < 2; ++ai) { unsigned w4[2][4];
#pragma unroll
            for (int m = 0; m < 4; ++m) { const float s = *(const PG8_LAS float*)(xl + (wr * 64 + fr + ai * HALF + m * 16) * 4);
#pragma unroll
                for (int bj = 0; bj < 2; ++bj) { const f32x4 v0 = __builtin_convertvector(acc[ai][bj][m][0], f32x4) * (sv[bj][0] * s) + bv[bj][0], v1 = __builtin_convertvector(acc[ai][bj][m][1], f32x4) * (sv[bj][1] * s) + bv[bj][1];
                    float o[4];
                    const float g[4] = {v0[0], v0[2], v1[0], v1[2]}, l[4] = {v0[1], v0[3], v1[1], v1[3]};
#pragma unroll
                    for (int t = 0; t < 4; ++t) { const float xg = fminf(g[t], 7.0f), xl = fminf(fmaxf(l[t], -7.0f), 7.0f);
                        const float tg = xg * __builtin_amdgcn_rcpf(1.0f + __builtin_amdgcn_exp2f(xg * -2.4554669595930156f)); o[t] = __builtin_fmaf(tg, xl, tg); }
                    int w = __builtin_amdgcn_cvt_pk_fp8_f32(o[0], o[1], 0, false); w = __builtin_amdgcn_cvt_pk_fp8_f32(o[2], o[3], w, true);
                    w4[bj][m] = (unsigned)w; } }
            unsigned char* rowp = act + (size_t)(row0 + ai * HALF + 16 * fq) * 1024 + ((ntile * BM + wc * 32) >> 1);
#pragma unroll
            for (int bj = 0; bj < 2; ++bj) { xpose4(w4[bj][0], w4[bj][1], w4[bj][2], w4[bj][3]);
                u32x4 o4; o4.x = w4[bj][0]; o4.y = w4[bj][1]; o4.z = w4[bj][2]; o4.w = w4[bj][3];
                *(u32x4*)(rowp + bj * (HALF / 2)) = o4; } }
    }
};
struct EpiMoeOutF8 {
    static constexpr bool PERM = true, AFTER_DRAIN = false; static constexpr int MODE = 2; typedef f32x4 acc_t;
    unsigned char* yk; const float* b2; const float* sb; const int* srt_tok; const float* srt_gate;
    static constexpr int NSTAGE = 4;
    __device__ __forceinline__ const void* stage_src(int k, const Unit& u) const { const int e = u.pn >> 2, ntile = u.pn & 3;
        return k == 0 ? (const void*)(b2 + e * 1024 + ntile * BM) : (k == 1 ? (const void*)(sb + e * 1024 + ntile * BM) : (k == 2 ? (const void*)(srt_tok + u.pm * BM) : (const void*)(srt_gate + u.pm * BM))); }
    __device__ __forceinline__ void operator()(const f32x4 (&acc)[2][2][4][2], const Unit& u, int wr, int wc, int fr, int fq, const PG8_LAS unsigned char* xl) const {
        const int row0 = u.pm * BM + wr * 64 + fr; const int e = u.pn >> 2, ntile = u.pn & 3;
        const int c0 = ntile * BM + wc * 32 + 8 * fq;
#pragma unroll
        for (int bj = 0; bj < 2; ++bj) { f32x4 bv[2], sv[2];
#pragma unroll
            for (int n = 0; n < 2; ++n) { const int cl = (wc * 32 + 8 * fq + bj * HALF + 4 * n) * 4; bv[n] = *(const PG8_LAS f32x4*)(xl + cl); sv[n] = *(const PG8_LAS f32x4*)(xl + 1024 + cl); }
#pragma unroll
            for (int ai = 0; ai < 2; ++ai)
#pragma unroll
                for (int m = 0; m < 4; ++m) { const int rl = (wr * 64 + fr + ai * HALF + m * 16) * 4; const int id = *(const PG8_LAS int*)(xl + 2048 + rl); const float gt = *(const PG8_LAS float*)(xl + 3072 + rl);
                    if (id >= 0) { const f32x4 v0 = (acc[ai][bj][m][0] * sv[0] + bv[0]) * gt, v1 = (acc[ai][bj][m][1] * sv[1] + bv[1]) * gt;
                        int w0 = __builtin_amdgcn_cvt_pk_fp8_f32(v0[0], v0[1], 0, false); w0 = __builtin_amdgcn_cvt_pk_fp8_f32(v0[2], v0[3], w0, true);
                        int w1 = __builtin_amdgcn_cvt_pk_fp8_f32(v1[0], v1[1], 0, false); w1 = __builtin_amdgcn_cvt_pk_fp8_f32(v1[2], v1[3], w1, true);
                        v2u w; w.x = (unsigned)w0; w.y = (unsigned)w1;
                        *(v2u*)(yk + (size_t)id * 1024 + c0 + bj * HALF) = w; } }
            asm volatile("" ::: "memory"); }
    }
};


typedef int i32x8 __attribute__((ext_vector_type(8)));
struct Frag2 { bf16x8 h[2]; };
template <int MODE> struct FragOps { typedef Frag2 frag_t;
    static __device__ __forceinline__ Frag2 load(const PG8_LAS unsigned char* p) { Frag2 f; f.h[0] = *(const PG8_LAS bf16x8*)p; f.h[1] = *(const PG8_LAS bf16x8*)(p + 1024); return f; } };
template <> struct FragOps<2> { typedef i32x8 frag_t;
    static __device__ __forceinline__ i32x8 load(const PG8_LAS unsigned char* p) { const i32x4 lo = *(const PG8_LAS i32x4*)p, hi = *(const PG8_LAS i32x4*)(p + 1024); return __builtin_shufflevector(lo, hi, 0, 1, 2, 3, 4, 5, 6, 7); } };
template <int MODE> struct Mma;
template <> struct Mma<0> { static __device__ __forceinline__ f32x4 run(const Frag2& a, const Frag2& b, f32x4 c) { c = __builtin_amdgcn_mfma_f32_16x16x32_bf16(a.h[0], b.h[0], c, 0, 0, 0); return __builtin_amdgcn_mfma_f32_16x16x32_bf16(a.h[1], b.h[1], c, 0, 0, 0); } };
template <> struct Mma<1> { static __device__ __forceinline__ i32x4 run(const Frag2& a, const Frag2& b, i32x4 c) { c = __builtin_amdgcn_mfma_i32_16x16x64_i8(__builtin_bit_cast(i32x4, a.h[0]), __builtin_bit_cast(i32x4, b.h[0]), c, 0, 0, 0);
        return __builtin_amdgcn_mfma_i32_16x16x64_i8(__builtin_bit_cast(i32x4, a.h[1]), __builtin_bit_cast(i32x4, b.h[1]), c, 0, 0, 0); } };
template <> struct Mma<2> { static __device__ __forceinline__ f32x4 run(const i32x8& a, const i32x8& b, f32x4 c) {
        asm volatile("v_mfma_scale_f32_16x16x128_f8f6f4 %0, %1, %2, %0, %3, %3 op_sel_hi:[0,0,0]" : "+v"(c) : "v"(a), "v"(b), "v"(0x7F7F7F7F)); return c; } };

template <class Epi, class Sched, bool ALIGN_EPI = false, bool SP2 = false>
__device__ __forceinline__ void gemm_phase(PG8_LAS unsigned char* lds, const Gemm g, const Sched& S, const Epi& E, PG8_LAS unsigned char* xlds = nullptr) {
    const int tid = threadIdx.x, wid = __builtin_amdgcn_readfirstlane(tid >> 6), lane = tid & 63, wr = wid >> 2, wc = wid & 3, fr = lane & 15, fq = lane >> 4;
    constexpr int MODE = Epi::MODE; typedef typename Epi::acc_t acc_t;
    const int rowb = MODE ? g.K : g.K * 2, nt = rowb / (BK * 2);
    unsigned voffA[2], voffB[2];
#pragma unroll
    for (int i = 0; i < 2; ++i) { int R, C; stage_rc(tid * 16 + i * 8192, R, C); const int Rb = Epi::PERM ? ((R & ~31) + perm32(R & 31)) : R;
        voffA[i] = (unsigned)(R * rowb + C * 2); voffB[i] = (unsigned)(Rb * rowb + C * 2); }
    const size_t kstep = (size_t)(BK * 2);
    const size_t hstep = (size_t)HALF * rowb;
    const size_t tstep = 2 * hstep;
    const unsigned ldsw = (unsigned)wid * 1024u;
    const int aoff = lds_byte(wr * 64 + fr, fq * 8), boff = lds_byte(wc * 32 + fr, fq * 8);
    constexpr bool GATHER = Sched::GATHER;
    int gR[2]; unsigned gC[2]; unsigned gA[2][2], gN[2][2];
#pragma unroll
    for (int i = 0; i < 2; ++i) { int R, C; stage_rc(tid * 16 + i * 8192, R, C); gR[i] = R; gC[i] = (unsigned)(C * 2);
#pragma unroll
        for (int h = 0; h < 2; ++h) { gA[h][i] = 0u; gN[h][i] = 0u; } }
#define PG8_SA(b, h) (((b) * 2 + (h)) * HTB)
#define PG8_SB(b, h) ((4 + (b) * 2 + (h)) * HTB)
#define PG8_STAGE(bufoff, gbase, voff) do { _Pragma("unroll") for (int _i = 0; _i < 2; ++_i) \
        __builtin_amdgcn_global_load_lds((const unsigned*)((const char*)(gbase) + (voff)[_i]), (PG8_LAS unsigned*)(lds + (bufoff) + ldsw + _i * 8192), 16, 0, 0); } while (0)
#define PG8_STA(bufoff, h, nxsel, kb) do { if constexpr (GATHER) { unsigned o_[2] = {(nxsel) ? gN[h][0] : gA[h][0], (nxsel) ? gN[h][1] : gA[h][1]}; PG8_STAGE(bufoff, (const char*)g.A + (kb), o_); } \
        else { PG8_STAGE(bufoff, ((nxsel) ? nA : cA) + (size_t)(h) * hstep + (kb), voffA); } } while (0)
#define PG8_ROWT_ISSUE(slot, pm) do { if constexpr (GATHER) { if (wid < 4) __builtin_amdgcn_global_load_lds((const unsigned*)(S.rowoff + (size_t)(pm) * BM + wid * 64 + lane), (PG8_LAS unsigned*)(S.rowt + (slot) * 256 + wid * 64), 4, 0, 0); } } while (0)
#define PG8_ROWT_READ(dst, slot) do { if constexpr (GATHER) { _Pragma("unroll") for (int h_ = 0; h_ < 2; ++h_) _Pragma("unroll") for (int i_ = 0; i_ < 2; ++i_) dst[h_][i_] = (unsigned)S.rowt[(slot) * 256 + h_ * HALF + gR[i_]] + gC[i_]; } } while (0)
#define PG8_EPI_ISSUE(slot, U) do { if constexpr (Epi::NSTAGE > 0) { if (wid < Epi::NSTAGE) __builtin_amdgcn_global_load_lds((const unsigned*)((const char*)E.stage_src(wid, U) + lane * 16), (PG8_LAS unsigned*)(xlds + (slot) * 4096 + wid * 1024), 16, 0, 0); } } while (0)
#define PG8_LDA(dst, b, h) do { _Pragma("unroll") for (int m = 0; m < 4; ++m) dst[m] = FragOps<MODE>::load(lds + PG8_SA(b, h) + aoff + m * 2048); } while (0)
#define PG8_LDB(dst, b, h) do { _Pragma("unroll") for (int n = 0; n < 2; ++n) dst[n] = FragOps<MODE>::load(lds + PG8_SB(b, h) + boff + n * 2048); } while (0)
#define PG8_MMA(ai, bj, At, Bt) do { __builtin_amdgcn_s_setprio(1); _Pragma("unroll") for (int m = 0; m < 4; ++m) _Pragma("unroll") for (int n = 0; n < 2; ++n) \
        acc[ai][bj][m][n] = Mma<MODE>::run(Bt[n], At[m], acc[ai][bj][m][n]); __builtin_amdgcn_s_setprio(0); } while (0)
#define PG8_WAIT_V(n) asm volatile("s_waitcnt vmcnt(" #n ")" ::: "memory")
#define PG8_WAIT_L(n) asm volatile("s_waitcnt lgkmcnt(" #n ")" ::: "memory")
#define PG8_BAR __builtin_amdgcn_s_barrier()
#define PG8_SCHED __builtin_amdgcn_sched_barrier(0)
    Unit cur, nxt; int ui = 0;
    if (!S.next(0, cur)) return;
    acc_t acc[2][2][4][2];
#pragma unroll
    for (int a = 0; a < 2; ++a)
#pragma unroll
        for (int b = 0; b < 2; ++b)
#pragma unroll
            for (int m = 0; m < 4; ++m)
#pragma unroll
                for (int n = 0; n < 2; ++n) acc[a][b][m][n] = (acc_t)0;
    typename FragOps<MODE>::frag_t At[4], B0[2], B1[2];
    const char* cA = (const char*)g.A + (size_t)cur.pm * tstep; const char* cB = (const char*)g.Bt + (size_t)cur.pn * tstep; const char* nA = cA;
    S.a_ready(cur);
    PG8_EPI_ISSUE(0, cur);
    if constexpr (GATHER) { PG8_ROWT_ISSUE(0, cur.pm); PG8_WAIT_V(0); __syncthreads(); PG8_ROWT_READ(gA, 0); PG8_WAIT_L(0); }
    if constexpr (SP2) {
        PG8_STAGE(PG8_SB(0, 0), cB, voffB); PG8_STAGE(PG8_SB(0, 1), cB + hstep, voffB); PG8_STA(PG8_SA(0, 0), 0, false, 0); PG8_STA(PG8_SA(0, 1), 1, false, 0);
        if (wr == 1) PG8_BAR;
        PG8_WAIT_V(2); PG8_BAR;
        PG8_STAGE(PG8_SB(1, 0), cB + kstep, voffB); PG8_STA(PG8_SA(1, 0), 0, false, kstep); PG8_STAGE(PG8_SB(1, 1), cB + hstep + kstep, voffB);
        PG8_WAIT_V(6); PG8_BAR;
    } else {
        PG8_STAGE(PG8_SB(0, 0), cB, voffB); PG8_STAGE(PG8_SA(0, 0), cA, voffA); PG8_STAGE(PG8_SB(0, 1), cB + hstep, voffB); PG8_STAGE(PG8_SA(0, 1), cA + hstep, voffA);
        if (wr == 1) PG8_BAR;
        PG8_WAIT_V(4); PG8_BAR;
        PG8_STAGE(PG8_SB(1, 0), cB + kstep, voffB); PG8_STAGE(PG8_SA(1, 0), cA + kstep, voffA); PG8_STAGE(PG8_SB(1, 1), cB + hstep + kstep, voffB);
        PG8_WAIT_V(6); PG8_BAR;
    }
    for (;;) {
        const bool has_next = S.next(ui + 1, nxt);
        nA = has_next ? (const char*)g.A + (size_t)nxt.pm * tstep : cA; const char* nB = has_next ? (const char*)g.Bt + (size_t)nxt.pn * tstep : cB;
        if (has_next) { PG8_EPI_ISSUE((ui + 1) % 3, nxt); }
        if (has_next) PG8_ROWT_ISSUE((ui + 1) & 1, nxt.pm);
#pragma unroll 1
        for (int t = 0; t < nt; t += 2) {
            const bool last = (t == nt - 2);
            const char* a1 = cA + (size_t)(t + 1) * kstep;
            const char* a2 = last ? nA : cA + (size_t)(t + 2) * kstep; const char* b2 = last ? nB : cB + (size_t)(t + 2) * kstep;
            const char* a3 = a2 + kstep; const char* b3 = b2 + kstep;
            const size_t kb1 = (size_t)(t + 1) * kstep, kb2 = last ? 0 : (size_t)(t + 2) * kstep, kb3 = kb2 + kstep;
            if (last && has_next) S.a_ready(nxt);
            if constexpr (GATHER) { if (last) { if (has_next) { PG8_ROWT_READ(gN, (ui + 1) & 1); } else {
#pragma unroll
                        for (int h_ = 0; h_ < 2; ++h_) { gN[h_][0] = gA[h_][0]; gN[h_][1] = gA[h_][1]; } } } }
            if constexpr (SP2) {
            PG8_LDB(B0, 0, 0); PG8_LDB(B1, 0, 1); PG8_SCHED; PG8_LDA(At, 0, 0); PG8_STA(PG8_SA(1, 1), 1, false, kb1);
            PG8_WAIT_V(8); PG8_WAIT_L(0); PG8_BAR; PG8_MMA(0, 0, At, B0); PG8_MMA(0, 1, At, B1); PG8_BAR; PG8_SCHED;
            PG8_LDA(At, 0, 1); PG8_STAGE(PG8_SB(0, 0), b2, voffB); PG8_STAGE(PG8_SB(0, 1), b2 + hstep, voffB); PG8_STA(PG8_SA(0, 0), 0, last, kb2);
            PG8_WAIT_V(8); PG8_WAIT_L(0); PG8_BAR; PG8_MMA(1, 0, At, B0); PG8_MMA(1, 1, At, B1); PG8_BAR; PG8_SCHED;
            PG8_LDB(B0, 1, 0); PG8_LDB(B1, 1, 1); PG8_SCHED; PG8_LDA(At, 1, 0); PG8_STA(PG8_SA(0, 1), 1, last, kb2);
            PG8_WAIT_V(8); PG8_WAIT_L(0); PG8_BAR; PG8_MMA(0, 0, At, B0); PG8_MMA(0, 1, At, B1); PG8_BAR; PG8_SCHED;
            PG8_LDA(At, 1, 1); PG8_STAGE(PG8_SB(1, 0), b3, voffB); PG8_STAGE(PG8_SB(1, 1), b3 + hstep, voffB); PG8_STA(PG8_SA(1, 0), 0, last, kb3);
            PG8_WAIT_V(8); PG8_WAIT_L(0); PG8_BAR; PG8_MMA(1, 0, At, B0); PG8_MMA(1, 1, At, B1); PG8_BAR; PG8_SCHED;
            } else {
            PG8_LDB(B0, 0, 0); PG8_SCHED; PG8_LDA(At, 0, 0); PG8_STAGE(PG8_SA(1, 1), a1 + hstep, voffA);
            PG8_WAIT_L(8); PG8_BAR; PG8_WAIT_L(0); PG8_MMA(0, 0, At, B0); PG8_BAR; PG8_SCHED;
            PG8_LDB(B1, 0, 1); PG8_STAGE(PG8_SB(0, 0), b2, voffB);
            PG8_BAR; PG8_WAIT_L(0); PG8_MMA(0, 1, At, B1); PG8_BAR;
            PG8_LDA(At, 0, 1); PG8_STAGE(PG8_SA(0, 0), a2, voffA);
            PG8_BAR; PG8_WAIT_L(0); PG8_MMA(1, 0, At, B0); PG8_BAR; PG8_SCHED;
            PG8_STAGE(PG8_SB(0, 1), b2 + hstep, voffB);
            PG8_WAIT_V(6); PG8_BAR; PG8_MMA(1, 1, At, B1); PG8_BAR;
            PG8_LDB(B0, 1, 0); PG8_SCHED; PG8_LDA(At, 1, 0); PG8_STAGE(PG8_SA(0, 1), a2 + hstep, voffA);
            PG8_WAIT_L(8); PG8_BAR; PG8_WAIT_L(0); PG8_MMA(0, 0, At, B0); PG8_BAR; PG8_SCHED;
            PG8_LDB(B1, 1, 1); PG8_STAGE(PG8_SB(1, 0), b3, voffB);
            PG8_BAR; PG8_WAIT_L(0); PG8_MMA(0, 1, At, B1); PG8_BAR;
            PG8_LDA(At, 1, 1); PG8_STAGE(PG8_SA(1, 0), a3, voffA);
            PG8_BAR; PG8_WAIT_L(0); PG8_MMA(1, 0, At, B0); PG8_BAR; PG8_SCHED;
            PG8_STAGE(PG8_SB(1, 1), b3 + hstep, voffB);
            PG8_WAIT_V(6); PG8_BAR; PG8_MMA(1, 1, At, B1); PG8_BAR;
            }
        }
        if constexpr (ALIGN_EPI) { if (wr == 0) PG8_BAR; }
        if constexpr (!Epi::AFTER_DRAIN) { E(acc, cur, wr, wc, fr, fq, xlds + (ui % 3) * 4096); S.done(cur); }
        if (!has_next) break;
#pragma unroll
        for (int a = 0; a < 2; ++a)
#pragma unroll
            for (int b = 0; b < 2; ++b)
#pragma unroll
                for (int m = 0; m < 4; ++m)
#pragma unroll
                    for (int n = 0; n < 2; ++n) acc[a][b][m][n] = (acc_t)0;
        cur = nxt; cA = nA; cB = nB; ++ui;
        if constexpr (GATHER) {
#pragma unroll
            for (int h_ = 0; h_ < 2; ++h_) { gA[h_][0] = gN[h_][0]; gA[h_][1] = gN[h_][1]; } }
        if constexpr (ALIGN_EPI) { if (wr == 1) PG8_BAR; }
    }
    PG8_WAIT_V(0);
    if constexpr (!ALIGN_EPI) { if (wr == 0) PG8_BAR; }
    PG8_BAR;
#undef PG8_SA
#undef PG8_SB
#undef PG8_STAGE
#undef PG8_STA
#undef PG8_EPI_ISSUE
#undef PG8_ROWT_ISSUE
#undef PG8_ROWT_READ
#undef PG8_LDA
#undef PG8_LDB
#undef PG8_MMA
#undef PG8_WAIT_V
#undef PG8_WAIT_L
#undef PG8_BAR
#undef PG8_SCHED
}
}

constexpr int NWAVES = 8, NTHR = 512;
constexpr int BATCH = 2, SEQ = 8192, T = BATCH * SEQ, D = 1024;
constexpr int DI = 2048, SH = 32, HP = 64, NGRP = 4, NS = 128, CHK = 128, NCH = SEQ / CHK;
constexpr int IN_DIM = 5152, XW = 5120, XOFF = 2048, BOFF = 4096, COFF = 4608, CONVD = 3072;
constexpr int QH = 16, KVH = 4, HD = 64, QKVW = 1536;
constexpr int NE = 32, TOPK = 4, FF = 1024, NA = T * TOPK, MTILE = 256, CAP = NA + NE * MTILE, MAXTILES = CAP / MTILE;
constexpr float EPS = 1e-6f;

constexpr size_t MiB = 1u << 20;
constexpr size_t WS_CTL = 0, CTL_ZERO_BYTES = 32768;
constexpr size_t WS_MODP = 1 * MiB;
constexpr size_t WS_MISC = 2 * MiB;
constexpr size_t MISC_CNT = 0, MISC_TE = 65536, MISC_NT = 65536 + 2048, MISC_CDEC = 131072, MISC_GATE = 262144;
constexpr size_t WS_WSC = 3 * MiB;
constexpr size_t WSC_W1 = 0, WSC_IN = 524288, WSC_QKV = 524288 + 32768, WSC_W2 = 524288 + 65536;
constexpr size_t HS_OFF = 16 * MiB, XGS_OFF = 80 * MiB;
constexpr size_t WS_WIN = 4 * MiB, WS_WOUT = 14 * MiB, WS_WQKV = 18 * MiB, WS_WAO = 21 * MiB;
constexpr size_t WS_W1 = 32 * MiB, WS_W2 = 288 * MiB;
constexpr size_t WS_H = 416 * MiB, WS_ZX = 448 * MiB, WS_DT = 608 * MiB, WS_ST = 610 * MiB, WS_Y = 674 * MiB;
constexpr size_t WS_X1 = 738 * MiB, WS_X2 = 802 * MiB, WS_X3 = 866 * MiB;
constexpr size_t WS_ASG = 930 * MiB;
constexpr size_t WS_SRT = 931 * MiB;
constexpr size_t WS_XG = 932 * MiB, WS_ACT = 1076 * MiB, WS_YK = 1220 * MiB, WS_QKV = 1348 * MiB, WS_AO = 1396 * MiB;
constexpr size_t WS_XT = 1428 * MiB, WS_BT = 1492 * MiB, WS_BN = 1508 * MiB, WS_CN = 1524 * MiB, WS_END = 1540 * MiB;
constexpr int CW_TMO = 0, CW_CODE = 1, CW_BAR = 4096;

constexpr int RING_OFF = 0, RING_BYTES = 131072;
constexpr int LDSCTL_OFF = RING_BYTES, MISC_OFF = LDSCTL_OFF + 320, TE_OFF = MISC_OFF + 128;
constexpr int ROWT_OFF = TE_OFF + 1280;
constexpr int EPIX_OFF = ROWT_OFF + 2048;
constexpr int LDS_BYTES = 147456;
static_assert(EPIX_OFF + 3 * 4096 <= LDS_BYTES && (EPIX_OFF & 15) == 0, "LDS map");
static_assert(TE_OFF + 4 * (MAXTILES + 4) <= LDS_BYTES, "LDS map");

#define LDS_WAIT() asm volatile("s_waitcnt lgkmcnt(0)" ::: "memory")
#define VM_WAIT() asm volatile("s_waitcnt vmcnt(0)" ::: "memory")
__device__ __forceinline__ unsigned f2bf(float f) { unsigned u = __builtin_bit_cast(unsigned, f); return (u + 0x7fffu + ((u >> 16) & 1u)) >> 16; }
typedef float f32x2_t __attribute__((ext_vector_type(2)));
typedef __bf16 bf16x2_t __attribute__((ext_vector_type(2)));
__device__ __forceinline__ unsigned pk2(float lo, float hi) { const f32x2_t v = {lo, hi}; const bf16x2_t b = __builtin_convertvector(v, bf16x2_t); return __builtin_bit_cast(unsigned, b); }
__device__ __forceinline__ float bf2f(unsigned h) { return __builtin_bit_cast(float, h << 16); }
__device__ __forceinline__ float bflo(unsigned w) { return __builtin_bit_cast(float, w << 16); }
__device__ __forceinline__ float bfhi(unsigned w) { return __builtin_bit_cast(float, w & 0xffff0000u); }
__device__ __forceinline__ bf16x8 pack8(const float (&o)[8]) { v4u w; w.x = pk2(o[0], o[1]); w.y = pk2(o[2], o[3]); w.z = pk2(o[4], o[5]); w.w = pk2(o[6], o[7]); return __builtin_bit_cast(bf16x8, w); }
__device__ __forceinline__ float rcp_f(float x) { return __builtin_amdgcn_rcpf(x); }
__device__ __forceinline__ float rsq_f(float x) { return __builtin_amdgcn_rsqf(x); }
__device__ __forceinline__ float silu_f(float x) { return x * rcp_f(1.0f + __expf(-x)); }
__device__ __forceinline__ float wave_sum(float v) {
#pragma unroll
    for (int o = 1; o < 64; o <<= 1) v += __shfl_xor(v, o);
    return v;
}
#define MFMA16(a, b, c) __builtin_amdgcn_mfma_f32_16x16x32_bf16((a), (b), (c), 0, 0, 0)

#define XB_TMO      128
#define XB_XCNT(j)  (256  + 64 * (j))
#define XB_XSUB(j)  (1280 + 64 * (j))
#define XB_XGEN(j)  (2304 + 64 * (j))
#define XB_TOP      3328
#define XB_TOPGEN   3392
#define XCD_BAR_WORDS 3456
#define XB_SPIN_CAP (1u << 18)
__device__ __forceinline__ unsigned xb_ld(unsigned* p)              { return __hip_atomic_load(p, __ATOMIC_RELAXED, __HIP_MEMORY_SCOPE_AGENT); }
__device__ __forceinline__ unsigned xb_add(unsigned* p, unsigned v) { return __hip_atomic_fetch_add(p, v, __ATOMIC_RELAXED, __HIP_MEMORY_SCOPE_AGENT); }
__device__ __forceinline__ unsigned xb_xcc_id() { return (unsigned)__builtin_amdgcn_s_getreg((3 << 11) | 20) & 0xFu; }
#define XB_SPIN(cond, bar) do { unsigned _sp = 0; while (cond) { __builtin_amdgcn_s_sleep(1); \
    if ((++_sp & 255u) == 0u) { if (xb_ld(&(bar)[XB_TMO])) break; if (_sp > XB_SPIN_CAP) { atomicAdd(&(bar)[XB_TMO], 1u); break; } } } } while (0)
struct XcdBarrier { unsigned* bar; unsigned x; volatile LAS unsigned* st; };
__device__ __forceinline__ XcdBarrier xcd_barrier_post(unsigned* bar, volatile LAS unsigned* st) {
    XcdBarrier b; b.bar = bar; b.x = xb_xcc_id(); b.st = st;
    if (threadIdx.x == 0) (void)xb_add(&bar[XB_XCNT(b.x)], 1u);
    return b;
}
__device__ __forceinline__ void xcd_barrier_complete(unsigned* bar, unsigned x, unsigned& nloc, unsigned& nx) {
    const unsigned G = gridDim.x * gridDim.y * gridDim.z;
    unsigned sum, cnt, mine, sp = 0u;
    for (;;) {
        sum = 0u; cnt = 0u; mine = 0u;
#pragma unroll
        for (unsigned j = 0; j < 16; ++j) { const unsigned c = xb_ld(&bar[XB_XCNT(j)]); sum += c; cnt += (c > 0u) ? 1u : 0u; mine = (j == x) ? c : mine; }
        if (sum == G) break;
        __builtin_amdgcn_s_sleep(1);
        if ((++sp & 255u) == 0u) { if (xb_ld(&bar[XB_TMO])) break; if (sp > XB_SPIN_CAP) { atomicAdd(&bar[XB_TMO], 1u); break; } }
    }
    nloc = mine > 0u ? mine : 1u; nx = cnt > 0u ? cnt : 1u;
}
__device__ __forceinline__ void xcd_barrier(const XcdBarrier& b) {
    asm volatile("s_waitcnt vmcnt(0)" ::: "memory");
    __syncthreads();
    if (threadIdx.x == 0) {
        unsigned* bar = b.bar;
        __builtin_amdgcn_s_waitcnt(0);
        unsigned nloc = b.st[0], nx = b.st[1];
        if (nloc == 0u) { xcd_barrier_complete(bar, b.x, nloc, nx); b.st[0] = nloc; b.st[1] = nx; }
        const unsigned old = xb_add(&bar[XB_XSUB(b.x)], 1u);
        const unsigned gen = old / nloc;
        if (old + 1u == (gen + 1u) * nloc) {
            __builtin_amdgcn_fence(__ATOMIC_RELEASE, "agent");
            asm volatile("s_waitcnt vmcnt(0)" ::: "memory");
            const unsigned og = xb_add(&bar[XB_TOP], 1u);
            const unsigned tg = og / nx;
            if (og + 1u == (tg + 1u) * nx) xb_add(&bar[XB_TOPGEN], 1u);
            else XB_SPIN(xb_ld(&bar[XB_TOPGEN]) == tg, bar);
            __builtin_amdgcn_fence(__ATOMIC_ACQUIRE, "agent");
            xb_add(&bar[XB_XGEN(b.x)], 1u);
            asm volatile("s_waitcnt vmcnt(0)" ::: "memory");
        } else {
            XB_SPIN(xb_ld(&bar[XB_XGEN(b.x)]) == gen, bar);
            __builtin_amdgcn_fence(__ATOMIC_ACQUIRE, "agent");
            asm volatile("s_waitcnt vmcnt(0)" ::: "memory");
        }
    }
    __syncthreads();
}

struct Args { const float* in[26]; float* out; unsigned char* ws; int ph_lo, ph_hi; };
enum { I_X = 0, I_C, I_ADAW, I_ADAB, I_N1G, I_N2G, I_MINW, I_MCONVW, I_MCONVB, I_MDTB, I_MALOG, I_MD, I_MNG, I_MOUTW, I_AQKVW, I_AQNG, I_AKNG, I_ASINK, I_AOUTW, I_RELB, I_RW, I_RB, I_EW1, I_EB1, I_EW2, I_EB2 };

__device__ __forceinline__ void p0_transpose_item(const float* __restrict__ W, int ldw, int K, int nblk, bf16* WT, LAS float* scr, int item, int lane) {
    const int kb = item / nblk, nb = item % nblk, k0 = 64 * kb, n0 = 32 * nb;
    float tv[32];
#pragma unroll
    for (int i = 0; i < 32; ++i) { const int kk = 2 * i + (lane >> 5); tv[i] = W[(size_t)(k0 + kk) * ldw + n0 + (lane & 31)]; }
#pragma unroll
    for (int i = 0; i < 32; ++i) { const int kk = 2 * i + (lane >> 5); scr[kk * 33 + (lane & 31)] = tv[i]; }
    LDS_WAIT(); asm volatile("" ::: "memory");
    const int c = lane & 7;
#pragma unroll
    for (int j = 0; j < 4; ++j) { const int n = (lane >> 3) + 8 * j; const LAS float* s = scr + (8 * c) * 33 + n;
        v4u o; o.x = pk2(s[0 * 33], s[1 * 33]); o.y = pk2(s[2 * 33], s[3 * 33]); o.z = pk2(s[4 * 33], s[5 * 33]); o.w = pk2(s[6 * 33], s[7 * 33]);
        *(GAS v4u*)(WT + (size_t)(n0 + n) * K + k0 + 8 * c) = o; }
    LDS_WAIT(); asm volatile("" ::: "memory");
}
__device__ __forceinline__ void p0_prologue(const Args& a, LAS unsigned char* lds, int wave, int lane) {
    unsigned char* ws = a.ws; const int blk = blockIdx.x, G = gridDim.x;
    float* modp = (float*)(ws + WS_MODP);
    const float* __restrict__ cin = a.in[I_C]; const float* __restrict__ adaw = a.in[I_ADAW];
    if (wave < 2) {
        for (int it = wave * G + blk; it < 384; it += 2 * G) {
            const int kc = it & 7, rest = it >> 3, l = rest / 24, nb = rest % 24;
            f32x4 a0 = {0.f, 0.f, 0.f, 0.f}, a1 = {0.f, 0.f, 0.f, 0.f};
            const float* wp = adaw + ((size_t)l * 1024 + kc * 128) * 6144 + nb * 256 + lane * 4;
#pragma unroll 32
            for (int k = 0; k < 128; ++k) { const f32x4 w = *(const f32x4*)(wp + (size_t)k * 6144);
                const float c0 = silu_f(cin[kc * 128 + k]), c1 = silu_f(cin[1024 + kc * 128 + k]); a0 += w * c0; a1 += w * c1; }
            *(f32x4*)(modp + ((size_t)(kc * 2 + l) * 2 + 0) * 6144 + nb * 256 + lane * 4) = a0;
            *(f32x4*)(modp + ((size_t)(kc * 2 + l) * 2 + 1) * 6144 + nb * 256 + lane * 4) = a1;
        }
    } else {
        LAS float* scr = (LAS float*)(lds + RING_OFF + wave * 16384);
        constexpr int I1 = 32 * 32, I3 = 16 * 32;
        constexpr int NITEMS = I1 + I3;
        for (int it = (wave - 2) * G + blk; it < NITEMS; it += 6 * G) {
            int r = it;
            if (r < I1) { p0_transpose_item(a.in[I_MOUTW], 1024, 2048, 32, (bf16*)(ws + WS_WOUT), scr, r, lane); continue; } r -= I1;
            { p0_transpose_item(a.in[I_AOUTW], 1024, 1024, 32, (bf16*)(ws + WS_WAO), scr, r, lane); }
        }
    }
}
struct QItem { const float* W; int ldw, n0; signed char* outq; float* sc; int f8; };
__device__ __forceinline__ QItem quant_decode(const Args& a, int it) {
    unsigned char* ws = a.ws; float* wsc = (float*)(ws + WS_WSC); QItem q; q.f8 = 0;
    constexpr int Q2 = 160;
    if (it < Q2) { q.W = a.in[I_MINW]; q.ldw = IN_DIM; q.n0 = 32 * it; q.outq = (signed char*)(ws + WS_WIN); q.sc = wsc + WSC_IN / 4; }
    else { q.W = a.in[I_AQKVW]; q.ldw = 1536; q.n0 = 32 * (it - Q2); q.outq = (signed char*)(ws + WS_WQKV); q.sc = wsc + WSC_QKV / 4; }
    return q;
}
__device__ __forceinline__ void quant_load(const QItem& q, int wave, int lane, float (&vals)[64]) {
    const int n = lane & 31, kh = lane >> 5; const float* __restrict__ wp = q.W + (size_t)(128 * wave + kh) * q.ldw + q.n0 + n;
#pragma unroll
    for (int i = 0; i < 64; ++i) vals[i] = wp[(size_t)(2 * i) * q.ldw];
}
__device__ __forceinline__ void quant_finish(const QItem& q, const float (&vals)[64], LAS unsigned char* lds, int wave, int lane) {
    LAS float* AMX = (LAS float*)(lds + 36864);
    LAS unsigned char* Tt = lds + wave * 4224;
    const int n = lane & 31, kh = lane >> 5; float am = 0.f;
#pragma unroll
    for (int i = 0; i < 64; ++i) am = fmaxf(am, fabsf(vals[i]));
    am = fmaxf(am, __shfl_xor(am, 32));
    if (lane < 32) AMX[wave * 32 + n] = am;
    __syncthreads();
    float amt = 0.f;
#pragma unroll
    for (int w = 0; w < 8; ++w) amt = fmaxf(amt, AMX[w * 32 + n]);
    const float qmax = q.f8 ? 448.0f : 127.0f;
    const float inv = amt > 0.f ? qmax / amt : 0.f;
    if (wave == 0 && lane < 32) q.sc[q.n0 + n] = amt > 0.f ? amt / qmax : 1.0f;
    if (q.f8) {
#pragma unroll
        for (int i = 0; i < 64; ++i) { const float x = vals[i] * inv; Tt[n * 132 + 2 * i + kh] = (unsigned char)(__builtin_amdgcn_cvt_pk_fp8_f32(x, x, 0, false) & 255); }
    } else {
#pragma unroll
        for (int i = 0; i < 64; ++i) Tt[n * 132 + 2 * i + kh] = (unsigned char)((int)__builtin_rintf(vals[i] * inv) & 255);
    }
    LDS_WAIT(); asm volatile("" ::: "memory");
    { const int rn = lane >> 1, half = lane & 1; const LAS unsigned* src = (const LAS unsigned*)(Tt + rn * 132 + 64 * half);
        v4u o[4];
#pragma unroll
        for (int qd = 0; qd < 4; ++qd) { o[qd].x = src[4 * qd]; o[qd].y = src[4 * qd + 1]; o[qd].z = src[4 * qd + 2]; o[qd].w = src[4 * qd + 3]; }
#pragma unroll
        for (int qd = 0; qd < 4; ++qd) *(v4u*)(q.outq + (size_t)(q.n0 + rn) * 1024 + 128 * wave + 64 * half + 16 * qd) = o[qd]; }
    __syncthreads();
}
__device__ __forceinline__ void p0_quant(const Args& a, LAS unsigned char* lds, int wave, int lane) {
    constexpr int NQ = 160 + 48;
    __syncthreads();
    float va[64], vb[64];
    int it = blockIdx.x;
    if (it < NQ) { const QItem q0 = quant_decode(a, it); quant_load(q0, wave, lane, va); }
#pragma unroll 1
    for (; it < NQ; it += gridDim.x) {
        const int nx = it + gridDim.x;
        if (nx < NQ) { const QItem qn = quant_decode(a, nx); quant_load(qn, wave, lane, vb); }
        const QItem q = quant_decode(a, it);
        quant_finish(q, va, lds, wave, lane);
#pragma unroll
        for (int i = 0; i < 64; ++i) va[i] = vb[i];
    }
}
constexpr int BG_N = 2048 + 1024;
__device__ __forceinline__ QItem bg_decode(const Args& a, int j, int matbase) {
    unsigned char* ws = a.ws; float* wsc = (float*)(ws + WS_WSC); QItem q;
    if (j < 2048) { const int mat = matbase + (j >> 6), nb = j & 63;
        q.W = a.in[I_EW1] + (size_t)mat * 1024 * 2048; q.ldw = 2048; q.n0 = 32 * nb; q.outq = (signed char*)(ws + WS_W1) + (size_t)mat * 2048 * 1024; q.sc = wsc + WSC_W1 / 4 + mat * 2048; q.f8 = 0; }
    else { const int g = j - 2048, mat = matbase + (g >> 5), nb = g & 31;
        q.W = a.in[I_EW2] + (size_t)mat * 1024 * 1024; q.ldw = 1024; q.n0 = 32 * nb; q.outq = (signed char*)(ws + WS_W2) + (size_t)mat * 1024 * 1024; q.sc = wsc + WSC_W2 / 4 + mat * 1024; q.f8 = 1; }
    return q;
}
__device__ __forceinline__ void bg_run(const Args& a, LAS unsigned char* lds, int first, int count, int step, int wave, int lane, int matbase = 32) {
    if (first > BG_N) first = BG_N;
    __syncthreads();
    float va[64], vb[64];
    int j = first, left = count;
    if (j >= BG_N) left = 0;
    if (left > 0) { const QItem q0 = bg_decode(a, j, matbase); quant_load(q0, wave, lane, va); }
#pragma unroll 1
    for (; left > 0; --left, j += step) {
        const int nx = j + step; const bool more = (left > 1) && (nx < BG_N);
        if (more) { const QItem qn = bg_decode(a, nx, matbase); quant_load(qn, wave, lane, vb); }
        const QItem q = bg_decode(a, j, matbase);
        quant_finish(q, va, lds, wave, lane);
        if (!more) break;
#pragma unroll
        for (int i = 0; i < 64; ++i) va[i] = vb[i];
    }
    __syncthreads();
}
__device__ __forceinline__ float modval(const Args& a, int l, int b, int idx) {
    const float* modp = (const float*)(a.ws + WS_MODP);
    float s = a.in[I_ADAB][l * 6144 + idx];
#pragma unroll
    for (int kc = 0; kc < 8; ++kc) s += modp[((size_t)(kc * 2 + l) * 2 + b) * 6144 + idx];
    return s;
}

constexpr int NP_MOD = 0, NP_HI = 16384, NP_LO = NP_HI + 16 * 1032 * 2, NP_PART = NP_LO + 16 * 1032 * 2, NP_LOG = NP_PART + 16384, NP_AE = NP_LOG + 2048, NP_AG = NP_AE + 1024, NP_TOPV = NP_AG + 1024, NP_END = NP_TOPV + 256;
static_assert(NP_END <= RING_BYTES, "norm phase LDS");
template <int MODE, bool COMBINE, bool NORM>
__device__ __forceinline__ void norm_phase(const Args& a, LAS unsigned char* lds, int layer, int which, const float* xin, const float* cgate, const unsigned char* yk, float* xout,
                                           const float* __restrict__ Wsk, int ldw, const float* __restrict__ bsk, int tid, int wave, int lane) {
    unsigned char* ws = a.ws;
    LAS float* MOD = (LAS float*)(lds + NP_MOD);
    LAS bf16* HI = (LAS bf16*)(lds + NP_HI); LAS bf16* LO = (LAS bf16*)(lds + NP_LO);
    LAS float* PART = (LAS float*)(lds + NP_PART); LAS float* LOG = (LAS float*)(lds + NP_LOG);
    LAS int* AE = (LAS int*)(lds + NP_AE); LAS float* AG = (LAS float*)(lds + NP_AG); LAS float* TOPV = (LAS float*)(lds + NP_TOPV);
    signed char* H8 = (signed char*)(ws + WS_H); float* hscale = (float*)(ws + WS_H + HS_OFF);
    const int rb = blockIdx.x;
    if (NORM) {
        const float* ng = a.in[which ? I_N2G : I_N1G] + layer * 1024;
        for (int idx = tid; idx < 2048; idx += NTHR) { const int b = idx >> 10, col = idx & 1023;
            const float sh = modval(a, layer, b, which * 3072 + col), sc = modval(a, layer, b, which * 3072 + 1024 + col);
            MOD[(b * 2 + 0) * 1024 + col] = ng[col] * (1.0f + sc); MOD[(b * 2 + 1) * 1024 + col] = sh; }
    }
    const int fi = lane & 15, fq = lane >> 4;
    bf16x8 Bh[2][4], Bl[2][4];
    if (MODE != 2) {
#pragma unroll
        for (int s = 0; s < 4; ++s)
#pragma unroll
            for (int nt = 0; nt < 2; ++nt) { float hi[8], lo[8];
#pragma unroll
                for (int e = 0; e < 8; ++e) { const float w = Wsk[(size_t)(128 * wave + 32 * s + 8 * fq + e) * ldw + 16 * nt + fi]; const float h = bf2f(f2bf(w)); hi[e] = h; lo[e] = w - h; }
                Bh[nt][s] = pack8(hi); Bl[nt][s] = pack8(lo); }
    }
    __syncthreads();
    f32x4 vn[2][4]; unsigned yn[2][4][4];
#define NP_LOAD_TILE(tlx) do { _Pragma("unroll") for (int rr_ = 0; rr_ < 2; ++rr_) { const int m_ = 64 * rb + 16 * (tlx) + 8 * rr_ + wave; \
        _Pragma("unroll") for (int j = 0; j < 4; ++j) { vn[rr_][j] = *(const f32x4*)(xin + (size_t)m_ * 1024 + 4 * lane + 256 * j); \
            if (COMBINE) { _Pragma("unroll") for (int k = 0; k < 4; ++k) yn[rr_][j][k] = *(const unsigned*)(yk + ((size_t)m_ * 4 + k) * 1024 + 4 * lane + 256 * j); } } } } while (0)
    NP_LOAD_TILE(0);
#pragma unroll 1
    for (int tl = 0; tl < 4; ++tl) {
        f32x4 vc[2][4]; unsigned yc[2][4][4];
#pragma unroll
        for (int rr = 0; rr < 2; ++rr)
#pragma unroll
            for (int j = 0; j < 4; ++j) { vc[rr][j] = vn[rr][j];
                if (COMBINE) {
#pragma unroll
                    for (int k = 0; k < 4; ++k) yc[rr][j][k] = yn[rr][j][k]; } }
        if (tl < 3) NP_LOAD_TILE(tl + 1);
#pragma unroll
        for (int rr = 0; rr < 2; ++rr) {
            const int lr = 8 * rr + wave, m = 64 * rb + 16 * tl + lr, b = m >> 13;
            f32x4 v[4];
#pragma unroll
            for (int j = 0; j < 4; ++j) v[j] = vc[rr][j];
            if (COMBINE) {
#pragma unroll
                for (int j = 0; j < 4; ++j) { const int col = 4 * lane + 256 * j; const f32x4 g = *(const f32x4*)(cgate + b * 1024 + col);
                    f32x4 s = {0.f, 0.f, 0.f, 0.f};
#pragma unroll
                    for (int k = 0; k < 4; ++k) { const unsigned y = yc[rr][j][k]; const f32x2_t lo = __builtin_amdgcn_cvt_pk_f32_fp8((int)y, false), hi = __builtin_amdgcn_cvt_pk_f32_fp8((int)y, true); s += (f32x4){lo[0], lo[1], hi[0], hi[1]}; }
                    v[j] += g * s; *(f32x4*)(xout + (size_t)m * 1024 + col) = v[j]; }
            }
            if (NORM) {
                float ss = 0.f;
#pragma unroll
                for (int j = 0; j < 4; ++j) ss += (v[j].x * v[j].x + v[j].y * v[j].y) + (v[j].z * v[j].z + v[j].w * v[j].w);
                const float r = rsq_f(wave_sum(ss) * (1.0f / 1024.0f) + EPS);
                float am = 0.f;
#pragma unroll
                for (int j = 0; j < 4; ++j) { const int col = 4 * lane + 256 * j;
                    const f32x4 A = *(const LAS f32x4*)(MOD + (b * 2 + 0) * 1024 + col), S = *(const LAS f32x4*)(MOD + (b * 2 + 1) * 1024 + col);
                    const f32x4 h = v[j] * r * A + S; v[j] = h;
                    am = fmaxf(fmaxf(am, fmaxf(fabsf(h.x), fabsf(h.y))), fmaxf(fabsf(h.z), fabsf(h.w)));
                    if (MODE != 2) { v2u hw; hw.x = pk2(h.x, h.y); hw.y = pk2(h.z, h.w);
                        const f32x4 hr = {bflo(hw.x), bfhi(hw.x), bflo(hw.y), bfhi(hw.y)}; const f32x4 l4 = h - hr;
                        v2u lw; lw.x = pk2(l4.x, l4.y); lw.y = pk2(l4.z, l4.w);
                        *(LAS v2u*)(HI + lr * 1032 + col) = hw; *(LAS v2u*)(LO + lr * 1032 + col) = lw; } }
#pragma unroll
                for (int o = 1; o < 64; o <<= 1) am = fmaxf(am, __shfl_xor(am, o));
                const float inv = am > 0.f ? 127.0f / am : 0.f;
#pragma unroll
                for (int j = 0; j < 4; ++j) { const int col = 4 * lane + 256 * j;
                    const int q0 = (int)__builtin_rintf(v[j].x * inv), q1 = (int)__builtin_rintf(v[j].y * inv), q2 = (int)__builtin_rintf(v[j].z * inv), q3 = (int)__builtin_rintf(v[j].w * inv);
                    *(unsigned*)(H8 + (size_t)m * 1024 + col) = (unsigned)(q0 & 255) | ((unsigned)(q1 & 255) << 8) | ((unsigned)(q2 & 255) << 16) | ((unsigned)q3 << 24); }
                if (lane == 0) hscale[m] = am * (1.0f / 127.0f);
            }
        }
        if (MODE != 2) {
            __syncthreads();
            f32x4 acc[2] = {{0.f, 0.f, 0.f, 0.f}, {0.f, 0.f, 0.f, 0.f}};
#pragma unroll
            for (int s = 0; s < 4; ++s) { const int k0 = 128 * wave + 32 * s + 8 * fq;
                const bf16x8 ah = *(const LAS bf16x8*)(HI + fi * 1032 + k0), al = *(const LAS bf16x8*)(LO + fi * 1032 + k0);
#pragma unroll
                for (int nt = 0; nt < 2; ++nt) { acc[nt] = MFMA16(ah, Bh[nt][s], acc[nt]); acc[nt] = MFMA16(al, Bh[nt][s], acc[nt]); acc[nt] = MFMA16(ah, Bl[nt][s], acc[nt]); } }
#pragma unroll
            for (int nt = 0; nt < 2; ++nt)
#pragma unroll
                for (int r = 0; r < 4; ++r) PART[(wave * 16 + 4 * fq + r) * 32 + 16 * nt + fi] = acc[nt][r];
            __syncthreads();
            { const int lr = tid >> 5, n = tid & 31; float s = bsk[n];
#pragma unroll
                for (int w = 0; w < 8; ++w) s += PART[(w * 16 + lr) * 32 + n];
                if (MODE == 0) { const float sp = fmaxf(s, 0.f) + log1pf(__expf(-fabsf(s))); ((float*)(ws + WS_DT))[(size_t)(64 * rb + 16 * tl + lr) * 32 + n] = sp; }
                else LOG[lr * 32 + n] = s; }
            if (MODE == 1) {
                __syncthreads();
                { const int lr = tid >> 5, n = tid & 31; const float sv = LOG[lr * 32 + n]; int rank = 0;
#pragma unroll
                    for (int n2 = 0; n2 < 32; ++n2) { const float o = LOG[lr * 32 + n2]; rank += (o > sv || (o == sv && n2 < n)) ? 1 : 0; }
                    if (rank < 4) { TOPV[lr * 4 + rank] = sv; AE[(16 * tl + lr) * 4 + rank] = n; } }
                __syncthreads();
                if (tid < 64) { const int row = tid >> 2, k = tid & 3; const float v0 = TOPV[row * 4], v1 = TOPV[row * 4 + 1], v2 = TOPV[row * 4 + 2], v3 = TOPV[row * 4 + 3];
                    const float e0 = 1.0f, e1 = __expf(v1 - v0), e2 = __expf(v2 - v0), e3 = __expf(v3 - v0); const float sum = (e0 + e1) + (e2 + e3);
                    const float ek = k == 0 ? e0 : (k == 1 ? e1 : (k == 2 ? e2 : e3));
                    AG[(16 * tl + row) * 4 + k] = ek / sum; }
            }
        }
    }
    if (MODE == 1) {
        __syncthreads();
        int* asg_e = (int*)(ws + WS_ASG); float* asg_g = (float*)(ws + WS_ASG + 262144); int* asg_r = (int*)(ws + WS_ASG + 524288);
        int* cntblk = (int*)(ws + WS_MISC + MISC_CNT);
        LAS int* WC = (LAS int*)(lds + NP_PART);
        int e_mine = 0, rank_w = 0;
        if (wave < 4) { e_mine = AE[tid];
#pragma unroll 4
            for (int e = 0; e < 32; ++e) { const unsigned long long mb = __ballot(e_mine == e); if (e_mine == e) rank_w = __popcll(mb & ((1ull << lane) - 1ull)); if (lane == 0) WC[wave * 32 + e] = __popcll(mb); } }
        __syncthreads();
        if (wave < 4) { int base = 0;
#pragma unroll
            for (int w = 0; w < 3; ++w) base += (w < wave) ? WC[w * 32 + e_mine] : 0;
            asg_e[rb * 256 + tid] = e_mine; asg_g[rb * 256 + tid] = AG[tid]; asg_r[rb * 256 + tid] = base + rank_w; }
        else if (tid < 288) { const int e = tid - 256; cntblk[rb * 32 + e] = (WC[e] + WC[32 + e]) + (WC[64 + e] + WC[96 + e]); }
    }
    __syncthreads();
}

__device__ __forceinline__ void moe_scatter(const Args& a, LAS unsigned char* lds, int tid, int wave, int lane) {
    unsigned char* ws = a.ws; const int rb = blockIdx.x, G = gridDim.x;
    LAS int* PARTS = (LAS int*)(lds + 0); LAS int* TOT = (LAS int*)(lds + 4096); LAS int* BASE = (LAS int*)(lds + 4224); LAS int* PS = (LAS int*)(lds + 4352); LAS int* POS = (LAS int*)(lds + 4608);
    const int* cntblk = (const int*)(ws + WS_MISC + MISC_CNT);
    const int* asg_e = (const int*)(ws + WS_ASG); const float* asg_g = (const float*)(ws + WS_ASG + 262144); const int* asg_r = (const int*)(ws + WS_ASG + 524288);
    int* srt_tok = (int*)(ws + WS_SRT); float* srt_gate = (float*)(ws + WS_SRT + 524288);
    int* rowoff = (int*)(ws + WS_XG); float* xgs = (float*)(ws + WS_XG + XGS_OFF); const float* hscale = (const float*)(ws + WS_H + HS_OFF);
    { const int e = tid & 31, part = tid >> 5; int tot = 0, base = 0;
        for (int bb = part * 16; bb < part * 16 + 16; ++bb) { if (bb < G) { const int c = cntblk[bb * 32 + e]; tot += c; if (bb < rb) base += c; } }
        PARTS[(part * 32 + e) * 2] = tot; PARTS[(part * 32 + e) * 2 + 1] = base; }
    __syncthreads();
    if (tid < 32) { int tot = 0, base = 0; for (int p = 0; p < 16; ++p) { tot += PARTS[(p * 32 + tid) * 2]; base += PARTS[(p * 32 + tid) * 2 + 1]; } TOT[tid] = tot; BASE[tid] = base; }
    __syncthreads();
    if (tid == 0) { int ps = 0; for (int e = 0; e < 32; ++e) { PS[e] = ps; ps += ((TOT[e] + MTILE - 1) / MTILE) * MTILE; } PS[32] = ps; }
    __syncthreads();
    if (tid < 256) { const int aidx = rb * 256 + tid; const int e = asg_e[aidx]; const int pos = PS[e] + BASE[e] + asg_r[aidx];
        srt_tok[pos] = aidx; srt_gate[pos] = asg_g[aidx]; rowoff[pos] = (aidx >> 2) * 1024; xgs[pos] = hscale[aidx >> 2]; }
    if (rb < 32) { const int e = rb; const int p0 = PS[e] + TOT[e], p1 = PS[e + 1];
        for (int pos = p0 + tid; pos < p1; pos += NTHR) { srt_tok[pos] = -1; srt_gate[pos] = 0.f; xgs[pos] = 0.f; rowoff[pos] = 0; } }
    if (rb == 0) { int* te = (int*)(ws + WS_MISC + MISC_TE);
        if (tid < MAXTILES) { const int r0 = tid * MTILE; int e = 0; for (int j = 0; j < 32; ++j) e += (PS[j + 1] <= r0) ? 1 : 0; te[tid] = (r0 < PS[32]) ? e : 31; }
        if (tid == 0) *(int*)(ws + WS_MISC + MISC_NT) = PS[32] / MTILE; }
    __syncthreads();
    __syncthreads();
}
__device__ __forceinline__ void load_tile_table(const Args& a, LAS unsigned char* lds, int tid) {
    const int* te = (const int*)(a.ws + WS_MISC + MISC_TE);
    LAS int* TE = (LAS int*)(lds + TE_OFF);
    if (tid < MAXTILES) TE[tid] = te[tid];
    if (tid == MAXTILES) TE[MAXTILES] = *(const int*)(a.ws + WS_MISC + MISC_NT);
    __syncthreads();
}

#define OPAQUE(x) asm volatile("" : "+v"(x))
__device__ __forceinline__ void conv_load(const bf16* __restrict__ ZX, int tok0, int l0, int zc0, int lane, v4u (&raw)[11]) {
    const int chunk = lane & 7, run = lane >> 3; const int zc = zc0 + 8 * chunk;
    const bf16* __restrict__ base = ZX - 3 * XW; unsigned off = (unsigned)((tok0 + l0 + 8 * run) * XW + zc);
#pragma unroll
    for (int e = 0; e < 11; ++e) { raw[e] = *(const v4u*)(base + off); off += XW; OPAQUE(off); }
}
__device__ __forceinline__ void conv_finish(const Args& a, bool first, int l0, int zc0, bf16* outT, bf16* outN, int lane, v4u (&raw)[11], LAS bf16* ldsT = nullptr, int ldsS = 0, int ldsL = 0) {
    const int chunk = lane & 7, run = lane >> 3; const int zc = zc0 + 8 * chunk, ch = zc - XOFF;
    const float* __restrict__ cw = a.in[I_MCONVW]; const float* __restrict__ cbp = a.in[I_MCONVB];
    if (first && l0 == 0 && run == 0) { raw[0] = (v4u){0u, 0u, 0u, 0u}; raw[1] = (v4u){0u, 0u, 0u, 0u}; raw[2] = (v4u){0u, 0u, 0u, 0u}; }
    float w[4][8], cb[8];
#pragma unroll
    for (int j = 0; j < 4; ++j) { const f32x4 t0 = *(const f32x4*)(cw + j * CONVD + ch), t1 = *(const f32x4*)(cw + j * CONVD + ch + 4);
        w[j][0] = t0.x; w[j][1] = t0.y; w[j][2] = t0.z; w[j][3] = t0.w; w[j][4] = t1.x; w[j][5] = t1.y; w[j][6] = t1.z; w[j][7] = t1.w; }
    { const f32x4 t0 = *(const f32x4*)(cbp + ch), t1 = *(const f32x4*)(cbp + ch + 4); cb[0] = t0.x; cb[1] = t0.y; cb[2] = t0.z; cb[3] = t0.w; cb[4] = t1.x; cb[5] = t1.y; cb[6] = t1.z; cb[7] = t1.w; }
    unsigned P[4][8];
#pragma unroll
    for (int rp = 0; rp < 4; ++rp) { float o[2][8];
#pragma unroll
        for (int rr = 0; rr < 2; ++rr) { const int r = 2 * rp + rr;
#pragma unroll
            for (int cx = 0; cx < 8; ++cx) o[rr][cx] = cb[cx];
#pragma unroll
            for (int j = 0; j < 4; ++j) { const v4u x = raw[r + j];
                const float xv[8] = {bflo(x.x), bfhi(x.x), bflo(x.y), bfhi(x.y), bflo(x.z), bfhi(x.z), bflo(x.w), bfhi(x.w)};
#pragma unroll
                for (int cx = 0; cx < 8; ++cx) o[rr][cx] += w[j][cx] * xv[cx]; }
#pragma unroll
            for (int cx = 0; cx < 8; ++cx) o[rr][cx] = silu_f(o[rr][cx]); }
#pragma unroll
        for (int cx = 0; cx < 8; ++cx) P[rp][cx] = pk2(o[0][cx], o[1][cx]); }
    if (outT) {
#pragma unroll
        for (int cx = 0; cx < 8; ++cx) { v4u t = {P[0][cx], P[1][cx], P[2][cx], P[3][cx]}; *(v4u*)(outT + (8 * chunk + cx) * 128 + l0 + 8 * run) = t; } }
    if (ldsS != 0) {
#pragma unroll
        for (int cx = 0; cx < 8; ++cx) { v4u t = {P[0][cx], P[1][cx], P[2][cx], P[3][cx]}; *(LAS v4u*)(ldsT + (8 * chunk + cx) * ldsS + ldsL + 8 * run) = t; } }
    if (outN) {
#pragma unroll
        for (int rp = 0; rp < 4; ++rp) { v4u e0, e1;
            e0.x = (P[rp][0] & 0xffffu) | (P[rp][1] << 16); e0.y = (P[rp][2] & 0xffffu) | (P[rp][3] << 16); e0.z = (P[rp][4] & 0xffffu) | (P[rp][5] << 16); e0.w = (P[rp][6] & 0xffffu) | (P[rp][7] << 16);
            e1.x = (P[rp][0] >> 16) | (P[rp][1] & 0xffff0000u); e1.y = (P[rp][2] >> 16) | (P[rp][3] & 0xffff0000u); e1.z = (P[rp][4] >> 16) | (P[rp][5] & 0xffff0000u); e1.w = (P[rp][6] >> 16) | (P[rp][7] & 0xffff0000u);
            *(v4u*)(outN + (l0 + 8 * run + 2 * rp) * 128 + 8 * chunk) = e0; *(v4u*)(outN + (l0 + 8 * run + 2 * rp + 1) * 128 + 8 * chunk) = e1; } }
}
__device__ __forceinline__ void head_scan(const float* __restrict__ DT, int tok0, int hh, float Ah, int lane, float& d0, float& d1, float& acs0, float& acs1, float& total) {
    d0 = DT[(size_t)(tok0 + 2 * lane) * 32 + hh]; d1 = DT[(size_t)(tok0 + 2 * lane + 1) * 32 + hh];
    const float a0 = d0 * Ah, a1 = a0 + d1 * Ah;
    float v = a1;
#pragma unroll
    for (int o = 1; o < 64; o <<= 1) { const float t = __shfl_up(v, o); if (lane >= o) v += t; }
    acs0 = v - a1 + a0; acs1 = v; total = __shfl(v, 63);
}
__device__ __forceinline__ void ssd_states(const Args& a, LAS unsigned char* lds, int tid, int wave, int lane) {
    unsigned char* ws = a.ws;
    const bf16* __restrict__ ZX = (const bf16*)(ws + WS_ZX); const float* __restrict__ DT = (const float*)(ws + WS_DT);
    bf16* ST = (bf16*)(ws + WS_ST); float* CDEC = (float*)(ws + WS_MISC + MISC_CDEC);
    bf16* XT = (bf16*)(ws + WS_XT); bf16* BT = (bf16*)(ws + WS_BT); bf16* BN = (bf16*)(ws + WS_BN); bf16* CN = (bf16*)(ws + WS_CN);
    LAS bf16* BTs = (LAS bf16*)(lds + 0);
    LAS bf16* XTs = (LAS bf16*)(lds + 34816 + wave * 9216);
    LAS float* WL = (LAS float*)(lds + 34816 + 8 * 9216 + wave * 512);
    const int fi = lane & 15, fq = lane >> 4;
    for (int u = (int)((blockIdx.x & 7) * (gridDim.x >> 3) + (blockIdx.x >> 3)); u < BATCH * NCH * NGRP; u += gridDim.x) {
        const int b = u >> 8, c = (u >> 2) & 63, g = u & 3; const int tok0 = b * SEQ + c * CHK; const bool first = (c == 0);
        const size_t cg = (size_t)((b * NCH + c) * NGRP + g);
        const int hh = 8 * g + wave; const float Ah = -__expf(a.in[I_MALOG][hh]);
        { float d0, d1, acs0, acs1, total; head_scan(DT, tok0, hh, Ah, lane, d0, d1, acs0, acs1, total);
            WL[2 * lane] = d0 * __expf(total - acs0); WL[2 * lane + 1] = d1 * __expf(total - acs1);
            if (lane == 0) CDEC[(b * NCH + c) * SH + hh] = __expf(total); }
        { const int rh = wave & 1, cb2 = (wave & 3) >> 1; const bool isC = wave >= 4;
            const int zc0 = (isC ? COFF : BOFF) + g * 128 + 64 * cb2;
            v4u raw[11]; conv_load(ZX, tok0, 64 * rh, zc0, lane, raw);
            conv_finish(a, first, 64 * rh, zc0, nullptr, (isC ? CN : BN) + cg * 16384 + 64 * cb2, lane, raw, BTs + (64 * cb2) * 136, isC ? 0 : 136, 64 * rh); }
        bf16x8 Xf[4][4];
        bf16* xtg = XT + ((size_t)((b * NCH + c) * SH + hh)) * 8192;
#pragma unroll
        for (int rh = 0; rh < 2; ++rh) {
            { v4u raw[11]; conv_load(ZX, tok0, 64 * rh, XOFF + hh * 64, lane, raw);
                conv_finish(a, first, 64 * rh, XOFF + hh * 64, xtg, nullptr, lane, raw, XTs, 72, 0); }
            LDS_WAIT(); asm volatile("" ::: "memory");
#pragma unroll
            for (int pt = 0; pt < 4; ++pt)
#pragma unroll
                for (int k2 = 0; k2 < 2; ++k2) { const int ll = 32 * k2 + 8 * fq, l0 = 64 * rh + ll; const v4u x = *(const LAS v4u*)(XTs + (16 * pt + fi) * 72 + ll);
                    const f32x4 s0 = *(const LAS f32x4*)(WL + l0), s1 = *(const LAS f32x4*)(WL + l0 + 4);
                    const float o[8] = {bflo(x.x) * s0.x, bfhi(x.x) * s0.y, bflo(x.y) * s0.z, bfhi(x.y) * s0.w, bflo(x.z) * s1.x, bfhi(x.z) * s1.y, bflo(x.w) * s1.z, bfhi(x.w) * s1.w};
                    Xf[pt][2 * rh + k2] = pack8(o); }
            LDS_WAIT(); asm volatile("" ::: "memory");
        }
        __syncthreads();
        bf16* stp = ST + ((size_t)((b * NCH + c) * SH + hh)) * 8192;
#pragma unroll 1
        for (int nh = 0; nh < 2; ++nh) {
            f32x4 acc[4][4];
#pragma unroll
            for (int n4 = 0; n4 < 4; ++n4)
#pragma unroll
                for (int pt = 0; pt < 4; ++pt) acc[n4][pt] = (f32x4){0.f, 0.f, 0.f, 0.f};
#pragma unroll
            for (int ks = 0; ks < 4; ++ks)
#pragma unroll
                for (int n4 = 0; n4 < 4; ++n4) { const bf16x8 af = *(const LAS bf16x8*)(BTs + (16 * (4 * nh + n4) + fi) * 136 + 32 * ks + 8 * fq);
#pragma unroll
                    for (int pt = 0; pt < 4; ++pt) acc[n4][pt] = MFMA16(af, Xf[pt][ks], acc[n4][pt]); }
#pragma unroll
            for (int n4 = 0; n4 < 4; ++n4)
#pragma unroll
                for (int pt = 0; pt < 4; ++pt) { v2u w; w.x = pk2(acc[n4][pt][0], acc[n4][pt][1]); w.y = pk2(acc[n4][pt][2], acc[n4][pt][3]);
                    *(v2u*)(stp + (16 * pt + fi) * 128 + 16 * (4 * nh + n4) + 4 * fq) = w; }
            asm volatile("" ::: "memory");
        }
        __syncthreads();
    }
}

__device__ __forceinline__ void ssd_scan(const Args& a, int tid) {
    unsigned char* ws = a.ws; bf16* ST = (bf16*)(ws + WS_ST); const float* CDEC = (const float*)(ws + WS_MISC + MISC_CDEC);
    for (int e4 = blockIdx.x * NTHR + tid; e4 < BATCH * SH * 2048; e4 += gridDim.x * NTHR) {
        const int b = e4 >> 16, rem = e4 & 65535, hh = rem >> 11, off = (rem & 2047) * 4;
        f32x4 h = {0.f, 0.f, 0.f, 0.f};
        bf16* p = ST + ((size_t)(b * NCH) * SH + hh) * 8192 + off;
        for (int c0 = 0; c0 < NCH; c0 += 8) { v2u s[8]; float dc[8];
#pragma unroll
            for (int j = 0; j < 8; ++j) { s[j] = *(const v2u*)(p + (size_t)(c0 + j) * SH * 8192); dc[j] = CDEC[(b * NCH + c0 + j) * SH + hh]; }
#pragma unroll
            for (int j = 0; j < 8; ++j) { v2u o; o.x = pk2(h.x, h.y); o.y = pk2(h.z, h.w); *(v2u*)(p + (size_t)(c0 + j) * SH * 8192) = o;
                const f32x4 sv = {bflo(s[j].x), bfhi(s[j].x), bflo(s[j].y), bfhi(s[j].y)}; h = h * dc[j] + sv; } }
    }
}

constexpr int S3_CC = 0, S3_BC = 34816, S3_CB = 69632, S3_TAB = 104448, S3_WV = 109568, S3_RMS = 117760, S3_END = 121856;
static_assert(S3_END <= RING_BYTES, "S3 LDS");
__device__ __forceinline__ void ssd_out(const Args& a, LAS unsigned char* lds, int tid, int wave, int lane) {
    unsigned char* ws = a.ws;
    const bf16* __restrict__ ZX = (const bf16*)(ws + WS_ZX); const float* __restrict__ DT = (const float*)(ws + WS_DT);
    const bf16* ST = (const bf16*)(ws + WS_ST); bf16* Y = (bf16*)(ws + WS_Y);
    LAS bf16* Cc = (LAS bf16*)(lds + S3_CC); LAS bf16* Bc = (LAS bf16*)(lds + S3_BC); LAS bf16* CB = (LAS bf16*)(lds + S3_CB);
    LAS float* ACS = (LAS float*)(lds + S3_WV + wave * 1024); LAS float* DTW = ACS + 128;
    LAS float* RMS = (LAS float*)(lds + S3_RMS);
    const int fi = lane & 15, fq = lane >> 4;
    const int u0 = (int)((blockIdx.x & 7) * (gridDim.x >> 3) + (blockIdx.x >> 3));
    v4u bcn[4], ccn[4];
#define S3_LOAD_BC(uu) do { const int b_ = (uu) >> 8, c_ = ((uu) >> 2) & 63, g_ = (uu) & 3; const size_t cg_ = (size_t)((b_ * NCH + c_) * NGRP + g_); \
        const bf16* bn_ = (const bf16*)(ws + WS_BN) + cg_ * 16384; const bf16* cn_ = (const bf16*)(ws + WS_CN) + cg_ * 16384; \
        _Pragma("unroll") for (int i = 0; i < 4; ++i) { const int idx = tid + NTHR * i, row = idx >> 4, c8 = (idx & 15) * 8; bcn[i] = *(const v4u*)(bn_ + row * 128 + c8); ccn[i] = *(const v4u*)(cn_ + row * 128 + c8); } } while (0)
    if (u0 < BATCH * NCH * NGRP) S3_LOAD_BC(u0);
    for (int u = u0; u < BATCH * NCH * NGRP; u += gridDim.x) {
        const int b = u >> 8, c = (u >> 2) & 63, g = u & 3; const int tok0 = b * SEQ + c * CHK;
        {
#pragma unroll
            for (int i = 0; i < 4; ++i) { const int idx = tid + NTHR * i, row = idx >> 4, c8 = (idx & 15) * 8;
                *(LAS v4u*)(Bc + row * 136 + c8) = bcn[i]; *(LAS v4u*)(Cc + row * 136 + c8) = ccn[i]; } }
        const int hh = 8 * g + wave; const float Ah = -__expf(a.in[I_MALOG][hh]); const float Dh = a.in[I_MD][hh];
        { float d0, d1, acs0, acs1, total; head_scan(DT, tok0, hh, Ah, lane, d0, d1, acs0, acs1, total);
            ACS[2 * lane] = acs0; ACS[2 * lane + 1] = acs1; DTW[2 * lane] = d0; DTW[2 * lane + 1] = d1; }
        bf16x8 Xf[4][4];
        { const bf16* xth = (const bf16*)(ws + WS_XT) + ((size_t)((b * NCH + c) * SH + hh)) * 8192;
#pragma unroll
            for (int pt = 0; pt < 4; ++pt)
#pragma unroll
                for (int ks = 0; ks < 4; ++ks) Xf[pt][ks] = *(const bf16x8*)(xth + (16 * pt + fi) * 128 + 32 * ks + 8 * fq); }
        __syncthreads();
        if (u + (int)gridDim.x < BATCH * NCH * NGRP) S3_LOAD_BC(u + (int)gridDim.x);
        { const int lt = wave;
#pragma unroll 1
            for (int st = 0; st < 8; ++st) { if (st <= lt) { f32x4 cacc = {0.f, 0.f, 0.f, 0.f};
#pragma unroll
                for (int kn = 0; kn < 4; ++kn) { const bf16x8 af = *(const LAS bf16x8*)(Bc + (16 * st + fi) * 136 + 32 * kn + 8 * fq), bfr = *(const LAS bf16x8*)(Cc + (16 * lt + fi) * 136 + 32 * kn + 8 * fq);
                    cacc = MFMA16(af, bfr, cacc); }
                v2u w; w.x = pk2(cacc[0], cacc[1]); w.y = pk2(cacc[2], cacc[3]);
                *(LAS v2u*)(CB + (16 * lt + fi) * 136 + 16 * st + 4 * fq) = w; } } }
        __syncthreads();
        const bf16* sth = ST + ((size_t)((b * NCH + c) * SH + hh)) * 8192;
        const float* __restrict__ ng = a.in[I_MNG];
#pragma unroll 1
        for (int lhi = 0; lhi < 4; ++lhi) {
            int lh = lhi; asm volatile("" : "+s"(lh));
            int fio = fi, fqo = fq; asm volatile("" : "+v"(fio), "+v"(fqo));
            f32x4 acc[4][2];
#pragma unroll
            for (int pt = 0; pt < 4; ++pt)
#pragma unroll
                for (int l4 = 0; l4 < 2; ++l4) acc[pt][l4] = (f32x4){0.f, 0.f, 0.f, 0.f};
            bf16x8 ah0[4], ah1[4];
#pragma unroll
            for (int pt = 0; pt < 4; ++pt) { ah0[pt] = *(const bf16x8*)(sth + (16 * pt + fio) * 128 + 8 * fqo); ah1[pt] = *(const bf16x8*)(sth + (16 * pt + fio) * 128 + 32 + 8 * fqo); }
#pragma unroll
            for (int kn = 0; kn < 4; ++kn) { bf16x8 bfr[2];
#pragma unroll
                for (int l4 = 0; l4 < 2; ++l4) bfr[l4] = *(const LAS bf16x8*)(Cc + (16 * (2 * lh + l4) + fio) * 136 + 32 * kn + 8 * fqo);
#pragma unroll
                for (int pt = 0; pt < 4; ++pt) { const bf16x8 ah = (kn & 1) ? ah1[pt] : ah0[pt];
#pragma unroll
                    for (int l4 = 0; l4 < 2; ++l4) acc[pt][l4] = MFMA16(ah, bfr[l4], acc[pt][l4]); }
                if (kn < 2) {
#pragma unroll
                    for (int pt = 0; pt < 4; ++pt) { const bf16x8 t = *(const bf16x8*)(sth + (16 * pt + fio) * 128 + 32 * (kn + 2) + 8 * fqo); if (kn & 1) ah1[pt] = t; else ah0[pt] = t; } }
                asm volatile("" ::: "memory"); }
#pragma unroll
            for (int l4 = 0; l4 < 2; ++l4) { const float ea = __expf(ACS[16 * (2 * lh + l4) + fio]);
#pragma unroll
                for (int pt = 0; pt < 4; ++pt) acc[pt][l4] *= ea; }
            v2u zq[2][4];
#pragma unroll
            for (int l4 = 0; l4 < 2; ++l4)
#pragma unroll
                for (int pt = 0; pt < 4; ++pt) zq[l4][pt] = *(const v2u*)(ZX + (size_t)(tok0 + 16 * (2 * lh + l4) + fio) * XW + hh * 64 + 16 * pt + 4 * fqo);
#pragma unroll
            for (int l4 = 0; l4 < 2; ++l4) { const int lt = 2 * lh + l4, l = 16 * lt + fio; const float al = ACS[l];
#pragma unroll
                for (int ks = 0; ks < 4; ++ks) { if (32 * ks <= 16 * lt + 15) { const int s0 = 32 * ks + 8 * fqo;
                    const v4u cb8 = *(const LAS v4u*)(CB + l * 136 + s0);
                    const f32x4 as0 = *(const LAS f32x4*)(ACS + s0), as1 = *(const LAS f32x4*)(ACS + s0 + 4), dt0 = *(const LAS f32x4*)(DTW + s0), dt1 = *(const LAS f32x4*)(DTW + s0 + 4);
                    const float cbv[8] = {bflo(cb8.x), bfhi(cb8.x), bflo(cb8.y), bfhi(cb8.y), bflo(cb8.z), bfhi(cb8.z), bflo(cb8.w), bfhi(cb8.w)};
                    const float asv[8] = {as0.x, as0.y, as0.z, as0.w, as1.x, as1.y, as1.z, as1.w}, dtv[8] = {dt0.x, dt0.y, dt0.z, dt0.w, dt1.x, dt1.y, dt1.z, dt1.w};
                    float mv[8];
#pragma unroll
                    for (int e = 0; e < 8; ++e) { const int s = s0 + e; float v = (s <= l) ? cbv[e] * __expf(al - asv[e]) * dtv[e] : 0.f; if (s == l) v += Dh; mv[e] = v; }
                    const bf16x8 mf = pack8(mv);
#pragma unroll
                    for (int pt = 0; pt < 4; ++pt) acc[pt][l4] = MFMA16(Xf[pt][ks], mf, acc[pt][l4]); asm volatile("" ::: "memory"); } } }
#pragma unroll
            for (int l4 = 0; l4 < 2; ++l4) { const int l = 16 * (2 * lh + l4) + fio; float ssq = 0.f;
#pragma unroll
                for (int pt = 0; pt < 4; ++pt) { const v2u z = zq[l4][pt];
                    const float zv[4] = {bflo(z.x), bfhi(z.x), bflo(z.y), bfhi(z.y)};
#pragma unroll
                    for (int r = 0; r < 4; ++r) { const float yv = acc[pt][l4][r] * silu_f(zv[r]); acc[pt][l4][r] = yv; ssq += yv * yv; } }
                ssq += __shfl_xor(ssq, 16); ssq += __shfl_xor(ssq, 32);
                if (fqo == 0) RMS[wave * 128 + l] = ssq; asm volatile("" ::: "memory"); }
            __syncthreads();
#pragma unroll
            for (int l4 = 0; l4 < 2; ++l4) { const int l = 16 * (2 * lh + l4) + fio; float tot = 0.f;
#pragma unroll
                for (int w = 0; w < 8; ++w) tot += RMS[w * 128 + l];
                const float rstd = rsq_f(tot * (1.0f / 512.0f) + EPS);
#pragma unroll
                for (int pt = 0; pt < 4; ++pt) { const int col = hh * 64 + 16 * pt + 4 * fqo; const f32x4 gv = *(const f32x4*)(ng + col);
                    v2u w; w.x = pk2(acc[pt][l4][0] * rstd * gv.x, acc[pt][l4][1] * rstd * gv.y); w.y = pk2(acc[pt][l4][2] * rstd * gv.z, acc[pt][l4][3] * rstd * gv.w);
                    *(v2u*)(Y + (size_t)(tok0 + l) * DI + col) = w; } }
        }
        __syncthreads();
    }
}

constexpr int AT_K = 0, AT_V = 36864, AT_TAB = 73728, AT_END = 75776;
__device__ __forceinline__ void attn_phase(const Args& a, LAS unsigned char* lds, int tid, int wave, int lane) {
    unsigned char* ws = a.ws;
    const bf16* __restrict__ QKV = (const bf16*)(ws + WS_QKV); bf16* AO = (bf16*)(ws + WS_AO);
    LAS bf16* Ks = (LAS bf16*)(lds + AT_K); LAS bf16* Vs = (LAS bf16*)(lds + AT_V); LAS float* TAB = (LAS float*)(lds + AT_TAB);
    const float* __restrict__ qg = a.in[I_AQNG]; const float* __restrict__ kg = a.in[I_AKNG];
    const int fi = lane & 15, fq = lane >> 4;
    const int u0 = (int)((blockIdx.x & 7) * (gridDim.x >> 3) + (blockIdx.x >> 3));
    v4u kxn[4], vxn[4];
#define AT_LOAD_KV(uu) do { const int b_ = (uu) >> 8, nb_ = ((uu) >> 2) & 63, g_ = (uu) & 3; const int key_ = tid >> 1, half_ = tid & 1; \
        const bf16* kp_ = QKV + (ptrdiff_t)(b_ * SEQ + nb_ * 128 - 128 + key_) * QKVW + 1024 + g_ * 64 + 32 * half_; \
        _Pragma("unroll") for (int j = 0; j < 4; ++j) { kxn[j] = *(const v4u*)(kp_ + 8 * j); vxn[j] = *(const v4u*)(kp_ + 256 + 8 * j); } } while (0)
    if (u0 < BATCH * 64 * KVH) AT_LOAD_KV(u0);
    for (int u = u0; u < BATCH * 64 * KVH; u += gridDim.x) {
        const int b = u >> 8, nb = (u >> 2) & 63, g = u & 3; const int tokq0 = b * SEQ + nb * 128;
        { const int key = tid >> 1, half = tid & 1; const bool valid = (nb > 0) || (key >= 128);
            v4u kx[4], vx[4];
            {
#pragma unroll
                for (int j = 0; j < 4; ++j) { kx[j] = kxn[j]; vx[j] = vxn[j]; }
                if (!valid) {
#pragma unroll
                    for (int j = 0; j < 4; ++j) { kx[j] = (v4u){0u, 0u, 0u, 0u}; vx[j] = (v4u){0u, 0u, 0u, 0u}; } } }
            float kf[32]; float ss = 0.f;
#pragma unroll
            for (int j = 0; j < 4; ++j) { kf[8 * j + 0] = bflo(kx[j].x); kf[8 * j + 1] = bfhi(kx[j].x); kf[8 * j + 2] = bflo(kx[j].y); kf[8 * j + 3] = bfhi(kx[j].y);
                kf[8 * j + 4] = bflo(kx[j].z); kf[8 * j + 5] = bfhi(kx[j].z); kf[8 * j + 6] = bflo(kx[j].w); kf[8 * j + 7] = bfhi(kx[j].w); }
#pragma unroll
            for (int e = 0; e < 32; ++e) ss += kf[e] * kf[e];
            ss += __shfl_xor(ss, 1);
            const float r = rsq_f(ss * (1.0f / 64.0f) + EPS);
#pragma unroll
            for (int j = 0; j < 4; ++j) { float o[8];
#pragma unroll
                for (int e = 0; e < 8; ++e) o[e] = kf[8 * j + e] * r * kg[32 * half + 8 * j + e];
                *(LAS bf16x8*)(Ks + key * 72 + 32 * half + 8 * j) = pack8(o);
                *(LAS v4u*)(Vs + key * 72 + 32 * half + 8 * j) = vx[j]; } }
        { const int r = tid >> 7, dist = tid & 127; int bucket;
            if (dist < 16) bucket = dist; else { bucket = 16 + (int)(logf((float)dist / 16.0f) / logf(8.0f) * 16.0f); bucket = bucket < 31 ? bucket : 31; }
            TAB[r * 128 + dist] = a.in[I_RELB][bucket * 16 + 4 * g + r]; }
        __syncthreads();
        if (u + (int)gridDim.x < BATCH * 64 * KVH) AT_LOAD_KV(u + (int)gridDim.x);
        const int r = wave >> 1, hf = wave & 1, h = 4 * g + r; const float sink = a.in[I_ASINK][h];
        for (int qt = 0; qt < 4; ++qt) {
            const int qi0 = 64 * hf + 16 * qt;
            bf16x8 Qf[2];
            { const bf16* qp = QKV + (size_t)(tokq0 + qi0 + fi) * QKVW + h * 64 + 8 * fq;
                const v4u q0 = *(const v4u*)qp, q1 = *(const v4u*)(qp + 32);
                float f0[8] = {bflo(q0.x), bfhi(q0.x), bflo(q0.y), bfhi(q0.y), bflo(q0.z), bfhi(q0.z), bflo(q0.w), bfhi(q0.w)};
                float f1[8] = {bflo(q1.x), bfhi(q1.x), bflo(q1.y), bfhi(q1.y), bflo(q1.z), bfhi(q1.z), bflo(q1.w), bfhi(q1.w)};
                float ss = 0.f;
#pragma unroll
                for (int e = 0; e < 8; ++e) ss += f0[e] * f0[e] + f1[e] * f1[e];
                ss += __shfl_xor(ss, 16); ss += __shfl_xor(ss, 32);
                const float rs = 0.125f * rsq_f(ss * (1.0f / 64.0f) + EPS);
#pragma unroll
                for (int e = 0; e < 8; ++e) { f0[e] *= rs * qg[8 * fq + e]; f1[e] *= rs * qg[32 + 8 * fq + e]; }
                Qf[0] = pack8(f0); Qf[1] = pack8(f1); }
            const int kt0 = (qi0 >> 4) < 6 ? (qi0 >> 4) : 6;
            f32x4 s[10];
#pragma unroll
            for (int kt = 0; kt < 10; ++kt) { const LAS bf16* kp = Ks + (16 * (kt0 + kt) + fi) * 72 + 8 * fq;
                f32x4 z = {0.f, 0.f, 0.f, 0.f};
                z = MFMA16(*(const LAS bf16x8*)kp, Qf[0], z); z = MFMA16(*(const LAS bf16x8*)(kp + 32), Qf[1], z); s[kt] = z; }
            const int qi = qi0 + fi; float mx = -__builtin_inff();
#pragma unroll
            for (int kt = 0; kt < 10; ++kt)
#pragma unroll
                for (int rr = 0; rr < 4; ++rr) { const int kj = 16 * (kt0 + kt) + 4 * fq + rr; const int dist = qi + 128 - kj;
                    const bool valid = (dist >= 0) && (dist < 128) && ((nb > 0) || (kj >= 128));
                    const float sc = valid ? s[kt][rr] + TAB[r * 128 + (dist & 127)] : -__builtin_inff();
                    s[kt][rr] = sc; mx = fmaxf(mx, sc); }
            mx = fmaxf(mx, __shfl_xor(mx, 16)); mx = fmaxf(mx, __shfl_xor(mx, 32)); mx = fmaxf(mx, sink);
            float sum = 0.f;
#pragma unroll
            for (int kt = 0; kt < 10; ++kt)
#pragma unroll
                for (int rr = 0; rr < 4; ++rr) { const float p = __expf(s[kt][rr] - mx); s[kt][rr] = p; sum += p; }
            sum += __shfl_xor(sum, 16); sum += __shfl_xor(sum, 32);
            const float inv = rcp_f(sum + __expf(sink - mx));
            f32x4 o[4];
#pragma unroll
            for (int dt = 0; dt < 4; ++dt) o[dt] = (f32x4){0.f, 0.f, 0.f, 0.f};
#pragma unroll
            for (int kk = 0; kk < 5; ++kk) {
                const float pv[8] = {s[2 * kk][0], s[2 * kk][1], s[2 * kk][2], s[2 * kk][3], s[2 * kk + 1][0], s[2 * kk + 1][1], s[2 * kk + 1][2], s[2 * kk + 1][3]};
                const bf16x8 pf = pack8(pv);
#pragma unroll
                for (int dt = 0; dt < 4; ++dt) {
                    const LAS bf16* vp0 = Vs + (16 * (kt0 + 2 * kk) + 4 * fq + (fi >> 2)) * 72 + 16 * dt + 4 * (fi & 3);
                    const v4i16_t t0 = __builtin_amdgcn_ds_read_tr16_b64_v4i16((LAS v4i16_t*)vp0);
                    const v4i16_t t1 = __builtin_amdgcn_ds_read_tr16_b64_v4i16((LAS v4i16_t*)(vp0 + 16 * 72));
                    const bf16x8 vf = {t0[0], t0[1], t0[2], t0[3], t1[0], t1[1], t1[2], t1[3]};
                    o[dt] = MFMA16(vf, pf, o[dt]); } }
            bf16* op = AO + (size_t)(tokq0 + qi) * 1024 + h * 64 + 4 * fq;
#pragma unroll
            for (int dt = 0; dt < 4; ++dt) { v2u w; w.x = pk2(o[dt][0] * inv, o[dt][1] * inv); w.y = pk2(o[dt][2] * inv, o[dt][3] * inv); *(v2u*)(op + 16 * dt) = w; }
        }
        __syncthreads();
    }
}

constexpr int NPHASE = 20;
constexpr int BG6_PER = 8, BG6 = 256 * BG6_PER;
constexpr int BGQ9 = 4, BGQ10 = 3, BGQ12 = 3;
__device__ __forceinline__ int bg_done9(int nt) { const int r = (nt * 8) & 255; return BG6 + (r ? (256 - r) * BGQ9 : 0); }
__device__ __forceinline__ int bg_done10(int nt) { const int r = (nt * 4) & 255; return bg_done9(nt) + (r ? (256 - r) * BGQ10 : 0); }
__global__ void __launch_bounds__(NTHR, 2) fwd_kernel(Args args) {
    extern __shared__ __attribute__((aligned(16))) unsigned char lds_raw[];
    LAS unsigned char* lds = (LAS unsigned char*)lds_raw;
    volatile LAS unsigned* MISC = (volatile LAS unsigned*)(lds + MISC_OFF);
    const int tid = threadIdx.x, lane = tid & 63, wave = __builtin_amdgcn_readfirstlane(tid >> 6);
    const int G = gridDim.x;
    unsigned char* ws = args.ws;
    gu32* ctl = (gu32*)(ws + WS_CTL);
    for (int u = tid; u < (LDS_BYTES - LDSCTL_OFF) / 4; u += NTHR) ((LAS unsigned*)(lds + LDSCTL_OFF))[u] = 0u;
    __syncthreads();
    XcdBarrier bar = xcd_barrier_post((unsigned*)(ctl + CW_BAR), MISC + 8);
    const int lo = args.ph_lo, hi = args.ph_hi;
    int nt_l0 = 256;
#ifndef PROBE_MASK
#define PROBE_MASK 0
#endif
#define PROBE_REP(k) ((int)(((unsigned)PROBE_MASK >> (k)) & 1u))
#define PHASE(k, ...) do { if (IN(k)) { __VA_ARGS__ } if (IN(k) && PROBE_REP(k)) { __VA_ARGS__ } } while (0)
#ifdef ONLYMASK
#define IN(k) (((ONLYMASK >> (k)) & 1) && lo <= (k) && (k) < hi)
#else
#define IN(k) (lo <= (k) && (k) < hi)
#endif
#define SEAM(k) do { if (IN(k) && IN((k) + 1)) xcd_barrier(bar); } while (0)
    bf16* H = (bf16*)(ws + WS_H);
    float* X1 = (float*)(ws + WS_X1); float* X2 = (float*)(ws + WS_X2); float* X3 = (float*)(ws + WS_X3);
    float* GATE = (float*)(ws + WS_MISC + MISC_GATE);
    const unsigned char* YK = (const unsigned char*)(ws + WS_YK);

    PHASE(0,  p0_prologue(args, lds, wave, lane); p0_quant(args, lds, wave, lane); ); SEAM(0);
    PHASE(1,
        { const int gid = blockIdx.x * NTHR + tid; if (gid < 8192) { const int l = gid >> 12, w = (gid >> 11) & 1, b = (gid >> 10) & 1, col = gid & 1023; GATE[gid] = modval(args, l, b, (w ? 5120 : 2048) + col); } }
        norm_phase<0, false, true>(args, lds, 0, 0, args.in[I_X], nullptr, nullptr, nullptr, args.in[I_MINW] + XW, IN_DIM, args.in[I_MDTB], tid, wave, lane);
    ); SEAM(1);
    PHASE(2,  const bool grpA_ = (((int)blockIdx.x >> 3) & 1) == 0;
        if (grpA_) bg_run(args, lds, (int)blockIdx.x, 12, 256, wave, lane, 0);
        pg8::Gemm g{H, (const bf16*)(ws + WS_WIN), T, XW, D}; pg8::StaticOrder S; S.init(T, XW, G, (int)blockIdx.x);
        pg8::EpiBf16Q E{(bf16*)(ws + WS_ZX), XW, (const float*)(ws + WS_H + HS_OFF), (const float*)(ws + WS_WSC + WSC_IN)};
        pg8::gemm_phase<pg8::EpiBf16Q, pg8::StaticOrder, true, true>(lds + RING_OFF, g, S, E, lds + EPIX_OFF);
        if (!grpA_) bg_run(args, lds, (int)blockIdx.x, 12, 256, wave, lane, 0); ); SEAM(2);
    PHASE(3,  ssd_states(args, lds, tid, wave, lane); ); SEAM(3);
    PHASE(4,  ssd_scan(args, tid); ); SEAM(4);
    PHASE(5,  ssd_out(args, lds, tid, wave, lane); ); SEAM(5);
    PHASE(6,  const bool grpA6_ = (((int)blockIdx.x >> 3) & 1) == 0;
        if (!grpA6_) bg_run(args, lds, (int)blockIdx.x, BG6_PER, 256, wave, lane, 32);
        pg8::Gemm g{(const bf16*)(ws + WS_Y), (const bf16*)(ws + WS_WOUT), T, D, DI}; pg8::StaticOrder S; S.init(T, D, G, (int)blockIdx.x);
        pg8::EpiResid E{args.in[I_X], X1, GATE + (0 * 2 + 0) * 2048};
        pg8::gemm_phase<pg8::EpiResid, pg8::StaticOrder, true, true>(lds + RING_OFF, g, S, E);
        if (grpA6_) bg_run(args, lds, (int)blockIdx.x, BG6_PER, 256, wave, lane, 32); ); SEAM(6);
#define MOE_PHASES(layer, pb, xres) \
    PHASE(pb,  norm_phase<1, false, true>(args, lds, layer, 1, xres, nullptr, nullptr, nullptr, args.in[I_RW] + (size_t)(layer) * 1024 * 32, 32, args.in[I_RB] + (layer) * 32, tid, wave, lane); ); SEAM(pb); \
    PHASE((pb) + 1,  moe_scatter(args, lds, tid, wave, lane); \
        if ((layer) == 1) { const int d_ = bg_done10(nt_l0) + 128 * BGQ12; bg_run(args, lds, d_ + (int)blockIdx.x, 16, 256, wave, lane); } ); SEAM((pb) + 1); \
    PHASE((pb) + 2,  load_tile_table(args, lds, tid); \
        const volatile LAS int* TE = (const volatile LAS int*)(lds + TE_OFF); \
        pg8::Gemm g{(const bf16*)(ws + WS_H), (const bf16*)(ws + WS_W1 + (size_t)(layer) * 32 * 2048 * 1024), CAP, 32 * 2048, D}; \
        pg8::MoeGatherOrder S{(int)TE[MAXTILES], 8, G, (int)((blockIdx.x & 7) * 32 + (blockIdx.x >> 3)), TE, (const int*)(ws + WS_XG), (LAS int*)(lds + ROWT_OFF)}; \
        pg8::EpiSwigluQ E{(unsigned char*)(ws + WS_ACT), args.in[I_EB1] + (size_t)(layer) * 32 * 2048, (const float*)(ws + WS_XG + XGS_OFF), (const float*)(ws + WS_WSC + WSC_W1) + (size_t)(layer) * 32 * 2048}; \
        pg8::gemm_phase<pg8::EpiSwigluQ, pg8::MoeGatherOrder, true, true>(lds + RING_OFF, g, S, E, lds + EPIX_OFF); \
        if ((layer) == 0) { const int nt_ = (int)TE[MAXTILES]; nt_l0 = nt_; const int r_ = (nt_ * 8) & 255, vc_ = (int)((blockIdx.x & 7) * 32 + (blockIdx.x >> 3)); if (r_ && vc_ >= r_) bg_run(args, lds, BG6 + (vc_ - r_) * BGQ9, BGQ9, 1, wave, lane); } ); SEAM((pb) + 2); \
    PHASE((pb) + 3,  load_tile_table(args, lds, tid); \
        const volatile LAS int* TE = (const volatile LAS int*)(lds + TE_OFF); \
        pg8::Gemm g{(const bf16*)(ws + WS_ACT), (const bf16*)(ws + WS_W2 + (size_t)(layer) * 32 * 1024 * 1024), CAP, 32 * 1024, FF}; \
        pg8::MoeOrder S{(int)TE[MAXTILES], 4, G, (int)((blockIdx.x & 7) * 32 + (blockIdx.x >> 3)), TE, nullptr, nullptr}; \
        pg8::EpiMoeOutF8 E{(unsigned char*)(ws + WS_YK), args.in[I_EB2] + (size_t)(layer) * 32 * 1024, (const float*)(ws + WS_WSC + WSC_W2) + (size_t)(layer) * 32 * 1024, (const int*)(ws + WS_SRT), (const float*)(ws + WS_SRT + 524288)}; \
        pg8::gemm_phase<pg8::EpiMoeOutF8, pg8::MoeOrder, true, true>(lds + RING_OFF, g, S, E, lds + EPIX_OFF); \
        if ((layer) == 0) { const int nt_ = (int)TE[MAXTILES]; const int r_ = (nt_ * 4) & 255, vc_ = (int)((blockIdx.x & 7) * 32 + (blockIdx.x >> 3)); if (r_ && vc_ >= r_) bg_run(args, lds, bg_done9(nt_) + (vc_ - r_) * BGQ10, BGQ10, 1, wave, lane); } ); SEAM((pb) + 3);

    MOE_PHASES(0, 7, X1)
    PHASE(11,  norm_phase<2, true, true>(args, lds, 1, 0, X1, GATE + (0 * 2 + 1) * 2048, YK, X2, nullptr, 0, nullptr, tid, wave, lane); ); SEAM(11);
    PHASE(12,  pg8::Gemm g{H, (const bf16*)(ws + WS_WQKV), T, QKVW, D}; pg8::StaticOrder S; S.init(T, QKVW, G, (int)blockIdx.x);
        pg8::EpiBf16Q E{(bf16*)(ws + WS_QKV), QKVW, (const float*)(ws + WS_H + HS_OFF), (const float*)(ws + WS_WSC + WSC_QKV)};
        pg8::gemm_phase<pg8::EpiBf16Q, pg8::StaticOrder, true, true>(lds + RING_OFF, g, S, E, lds + EPIX_OFF);
        if ((int)blockIdx.x >= 128) bg_run(args, lds, bg_done10(nt_l0) + ((int)blockIdx.x - 128) * BGQ12, BGQ12, 1, wave, lane); ); SEAM(12);
    PHASE(13,  attn_phase(args, lds, tid, wave, lane); ); SEAM(13);
    PHASE(14,  pg8::Gemm g{(const bf16*)(ws + WS_AO), (const bf16*)(ws + WS_WAO), T, D, D}; pg8::StaticOrder S; S.init(T, D, G, (int)blockIdx.x);
        pg8::EpiResid E{X2, X3, GATE + (1 * 2 + 0) * 2048};
        pg8::gemm_phase<pg8::EpiResid, pg8::StaticOrder, true, true>(lds + RING_OFF, g, S, E); ); SEAM(14);
    MOE_PHASES(1, 15, X3)
    PHASE(19,  norm_phase<2, true, false>(args, lds, 1, 0, X3, GATE + (1 * 2 + 1) * 2048, YK, args.out, nullptr, 0, nullptr, tid, wave, lane); );
#undef MOE_PHASES
#undef IN
#undef SEAM
}

extern "C" void kernel_launch(void* const* d_in, const int* in_sizes, int n_in, void* d_out, int out_size, void* d_ws, size_t ws_size, hipStream_t stream) {
    static int grid = 0;
    if (grid == 0) {
        if (n_in != 26 || in_sizes[0] != T * D || out_size != T * D || ws_size < WS_END) { fprintf(stderr, "kernel_launch: unexpected shapes (n_in %d, in0 %d, out %d, ws %zu)\n", n_in, n_in > 0 ? in_sizes[0] : -1, out_size, ws_size); grid = -1; return; }
        if (hipFuncSetAttribute((const void*)fwd_kernel, hipFuncAttributeMaxDynamicSharedMemorySize, LDS_BYTES) != hipSuccess) { fprintf(stderr, "kernel_launch: hipFuncSetAttribute failed\n"); grid = -1; return; }
        int per_cu = 0;
        if (hipOccupancyMaxActiveBlocksPerMultiprocessor(&per_cu, (const void*)fwd_kernel, NTHR, LDS_BYTES) != hipSuccess || per_cu < 1) fprintf(stderr, "kernel_launch: occupancy query reports %d\n", per_cu);
        (void)hipGetLastError();
        grid = 256;
    }
    if (grid < 0) return;
    if (hipMemsetAsync((char*)d_ws + WS_CTL, 0, CTL_ZERO_BYTES, stream) != hipSuccess) { fprintf(stderr, "kernel_launch: memset failed\n"); return; }
    Args a{};
    for (int i = 0; i < 26; ++i) a.in[i] = (const float*)d_in[i];
    a.out = (float*)d_out; a.ws = (unsigned char*)d_ws;
#ifndef MK_SPLIT
    a.ph_lo = 0; a.ph_hi = NPHASE;
    hipLaunchKernelGGL(fwd_kernel, dim3(grid), dim3(NTHR), LDS_BYTES, stream, a);
#else
    for (int p = 0; p < NPHASE; ++p) { a.ph_lo = p; a.ph_hi = p + 1; hipLaunchKernelGGL(fwd_kernel, dim3(grid), dim3(NTHR), LDS_BYTES, stream, a); }
#endif
}
```

```cpp
#include <hip/hip_runtime.h>
#include <cstdio>
#include <cstdint>

#define GAS __attribute__((address_space(1)))
#define LAS __attribute__((address_space(3)))
typedef unsigned short bf16;
typedef unsigned v4u __attribute__((ext_vector_type(4)));
typedef unsigned v2u __attribute__((ext_vector_type(2)));
typedef float f32x4 __attribute__((ext_vector_type(4)));
typedef short bf16x8 __attribute__((ext_vector_type(8)));
typedef short v4i16_t __attribute__((ext_vector_type(4)));
typedef GAS unsigned gu32;

namespace pg8 {
#define PG8_LAS __attribute__((address_space(3)))
typedef unsigned short bf16_t;
typedef unsigned u32x4 __attribute__((ext_vector_type(4)));
typedef int i32x4 __attribute__((ext_vector_type(4)));
constexpr int BM = 256, BK = 64, HALF = 128, HTB = HALF * BK * 2, STAGE_BYTES = 8 * HTB, NXCD = 8, WGM = 8;
__host__ __device__ __forceinline__ int lds_byte(int r, int c) { const int st = (r >> 4) * 2 + (c >> 5), rr = r & 15, cc = c & 31, ob = rr * 64 + cc * 2; return st * 1024 + (ob ^ (((ob >> 9) & 1) << 5)); }
__host__ __device__ __forceinline__ void stage_rc(int b, int& R, int& C) { const int st = b / 1024, sb = b % 1024, swz = sb ^ (((sb >> 9) & 1) << 5); R = (st >> 1) * 16 + swz / 64; C = (st & 1) * 32 + (swz % 64) / 2; }
__host__ __device__ __forceinline__ int perm32(int rho) { const int n = rho >> 4, i = rho & 15; return 8 * (i >> 2) + 4 * n + (i & 3); }
struct Unit { int pm, pn; };
struct Gemm { const bf16_t* A; const bf16_t* Bt; int M, N, K; };
struct StaticOrder {
    int nM, nN, nwg, G, c;
    __host__ __device__ void init(int M, int N, int G_, int c_) { nM = M / BM; nN = N / BM; nwg = nM * nN; G = G_; c = c_; }
    __host__ __device__ bool next(int i, Unit& u) const {
        const long L = (long)i * G + c; if (L >= nwg) return false;
        int wgid = (int)L; { const int q = nwg / NXCD, r = nwg % NXCD, xcd = wgid % NXCD, off = wgid / NXCD; wgid = (xcd < r ? xcd * (q + 1) : r * (q + 1) + (xcd - r) * q) + off; }
        const int nig = WGM * nN, gid = wgid / nig, fm = gid * WGM, gsz = (nM - fm) < WGM ? (nM - fm) : WGM;
        u.pm = fm + ((wgid % nig) % gsz); u.pn = (wgid % nig) / gsz; return true;
    }
    static constexpr bool GATHER = false; const int* rowoff = nullptr; PG8_LAS int* rowt = nullptr;
    __device__ __forceinline__ void a_ready(const Unit&) const {}
    __device__ __forceinline__ void done(const Unit&) const {}
};
template <bool GATHER_> struct MoeOrderT {
    static constexpr bool GATHER = GATHER_;
    int ntiles, NT, G, c; const volatile PG8_LAS int* te; const int* rowoff; PG8_LAS int* rowt;
    __device__ bool next(int i, Unit& u) const {
        const int L = i * G + c; if (L >= ntiles * NT) return false;
        const int tile = L / NT, n = L % NT; const int e = __builtin_amdgcn_readfirstlane(te[tile]);
        u.pm = tile; u.pn = e * NT + n; return true;
    }
    __device__ __forceinline__ void a_ready(const Unit&) const {}
    __device__ __forceinline__ void done(const Unit&) const {}
};
typedef MoeOrderT<false> MoeOrder; typedef MoeOrderT<true> MoeGatherOrder;
__device__ __forceinline__ unsigned cvt_pk_bf16(float lo, float hi) { unsigned r; asm volatile("v_cvt_pk_bf16_f32 %0, %1, %2" : "=v"(r) : "v"(lo), "v"(hi)); return r; }

struct EpiBf16 {
    static constexpr int NSTAGE = 0; __device__ __forceinline__ const void* stage_src(int, const Unit&) const { return nullptr; }
    static constexpr bool PERM = true, AFTER_DRAIN = false; static constexpr int MODE = 0; typedef f32x4 acc_t;
    bf16_t* O; int ldc;
    __device__ __forceinline__ void operator()(const f32x4 (&acc)[2][2][4][2], const Unit& u, int wr, int wc, int fr, int fq, const PG8_LAS unsigned char* xl) const {
        const int row0 = u.pm * BM + wr * 64 + fr, col0 = u.pn * BM + wc * 32 + 8 * fq;
#pragma unroll
        for (int ai = 0; ai < 2; ++ai)
#pragma unroll
            for (int m = 0; m < 4; ++m) { bf16_t* rowp = O + (size_t)(row0 + ai * HALF + m * 16) * ldc + col0;
#pragma unroll
                for (int bj = 0; bj < 2; ++bj) { const f32x4 v0 = acc[ai][bj][m][0], v1 = acc[ai][bj][m][1];
                    u32x4 w; w.x = cvt_pk_bf16(v0[0], v0[1]); w.y = cvt_pk_bf16(v0[2], v0[3]); w.z = cvt_pk_bf16(v1[0], v1[1]); w.w = cvt_pk_bf16(v1[2], v1[3]);
                    *(u32x4*)(rowp + bj * HALF) = w; } }
    }
};
struct EpiResid {
    static constexpr int NSTAGE = 0; __device__ __forceinline__ const void* stage_src(int, const Unit&) const { return nullptr; }
    static constexpr bool PERM = true, AFTER_DRAIN = false; static constexpr int MODE = 0; typedef f32x4 acc_t;
    const float* res; float* out; const float* gate;
    __device__ __forceinline__ void operator()(const f32x4 (&acc)[2][2][4][2], const Unit& u, int wr, int wc, int fr, int fq, const PG8_LAS unsigned char* xl) const {
        const int row0 = u.pm * BM + wr * 64 + fr, col0 = u.pn * BM + wc * 32 + 8 * fq; const int b = (u.pm * BM) >> 13;
        f32x4 gv[2][2];
#pragma unroll
        for (int bj = 0; bj < 2; ++bj)
#pragma unroll
            for (int n = 0; n < 2; ++n) gv[bj][n] = *(const f32x4*)(gate + b * 1024 + col0 + bj * HALF + 4 * n);
#pragma unroll
        for (int ai = 0; ai < 2; ++ai)
#pragma unroll
            for (int m = 0; m < 4; ++m) { const size_t off = (size_t)(row0 + ai * HALF + m * 16) * 1024 + col0;
#pragma unroll
                for (int bj = 0; bj < 2; ++bj)
#pragma unroll
                    for (int n = 0; n < 2; ++n) { const f32x4 r4 = *(const f32x4*)(res + off + bj * HALF + 4 * n);
                        *(f32x4*)(out + off + bj * HALF + 4 * n) = r4 + gv[bj][n] * acc[ai][bj][m][n]; } }
    }
};
struct EpiSwiglu {
    static constexpr int NSTAGE = 0; __device__ __forceinline__ const void* stage_src(int, const Unit&) const { return nullptr; }
    static constexpr bool PERM = true, AFTER_DRAIN = false; static constexpr int MODE = 0; typedef f32x4 acc_t;
    bf16_t* act; const float* b1;
    __device__ __forceinline__ void operator()(const f32x4 (&acc)[2][2][4][2], const Unit& u, int wr, int wc, int fr, int fq, const PG8_LAS unsigned char* xl) const {
        const int row0 = u.pm * BM + wr * 64 + fr; const int e = u.pn >> 3, ntile = u.pn & 7;
        const int c0 = ntile * BM + wc * 32 + 8 * fq;
        f32x4 bv[2][2];
#pragma unroll
        for (int bj = 0; bj < 2; ++bj)
#pragma unroll
            for (int n = 0; n < 2; ++n) bv[bj][n] = *(const f32x4*)(b1 + e * 2048 + c0 + bj * HALF + 4 * n);
#pragma unroll
        for (int ai = 0; ai < 2; ++ai)
#pragma unroll
            for (int m = 0; m < 4; ++m) { bf16_t* rowp = act + (size_t)(row0 + ai * HALF + m * 16) * 1024 + (c0 >> 1);
#pragma unroll
                for (int bj = 0; bj < 2; ++bj) { const f32x4 v0 = acc[ai][bj][m][0] + bv[bj][0], v1 = acc[ai][bj][m][1] + bv[bj][1];
                    float o[4];
                    const float g[4] = {v0[0], v0[2], v1[0], v1[2]}, l[4] = {v0[1], v0[3], v1[1], v1[3]};
#pragma unroll
                    for (int t = 0; t < 4; ++t) { const float xg = fminf(g[t], 7.0f), xl = fminf(fmaxf(l[t], -7.0f), 7.0f);
                        o[t] = xg * __builtin_amdgcn_rcpf(1.0f + __expf(-1.702f * xg)) * (xl + 1.0f); }
                    v2u w; w.x = cvt_pk_bf16(o[0], o[1]); w.y = cvt_pk_bf16(o[2], o[3]);
                    *(v2u*)(rowp + bj * (HALF / 2)) = w; } }
    }
};
struct EpiMoeOut {
    static constexpr int NSTAGE = 0; __device__ __forceinline__ const void* stage_src(int, const Unit&) const { return nullptr; }
    static constexpr bool PERM = true, AFTER_DRAIN = false; static constexpr int MODE = 0; typedef f32x4 acc_t;
    bf16_t* yk; const float* b2; const int* srt_tok; const float* srt_gate;
    __device__ __forceinline__ void operator()(const f32x4 (&acc)[2][2][4][2], const Unit& u, int wr, int wc, int fr, int fq, const PG8_LAS unsigned char* xl) const {
        const int row0 = u.pm * BM + wr * 64 + fr; const int e = u.pn >> 2, ntile = u.pn & 3;
        const int c0 = ntile * BM + wc * 32 + 8 * fq;
        f32x4 bv[2][2];
#pragma unroll
        for (int bj = 0; bj < 2; ++bj)
#pragma unroll
            for (int n = 0; n < 2; ++n) bv[bj][n] = *(const f32x4*)(b2 + e * 1024 + c0 + bj * HALF + 4 * n);
#pragma unroll
        for (int ai = 0; ai < 2; ++ai)
#pragma unroll
            for (int m = 0; m < 4; ++m) { const int pos = row0 + ai * HALF + m * 16; const int id = srt_tok[pos]; const float gt = srt_gate[pos];
                if (id >= 0) { bf16_t* rowp = yk + (size_t)id * 1024 + c0;
#pragma unroll
                    for (int bj = 0; bj < 2; ++bj) { const f32x4 v0 = (acc[ai][bj][m][0] + bv[bj][0]) * gt, v1 = (acc[ai][bj][m][1] + bv[bj][1]) * gt;
                        u32x4 w; w.x = cvt_pk_bf16(v0[0], v0[1]); w.y = cvt_pk_bf16(v0[2], v0[3]); w.z = cvt_pk_bf16(v1[0], v1[1]); w.w = cvt_pk_bf16(v1[2], v1[3]);
                        *(u32x4*)(rowp + bj * HALF) = w; } } }
    }
};

struct EpiBf16Q {
    static constexpr bool PERM = true, AFTER_DRAIN = false; static constexpr int MODE = 1; typedef i32x4 acc_t;
    bf16_t* O; int ldc; const float* sa; const float* sb;
    static constexpr int NSTAGE = 2; __device__ __forceinline__ const void* stage_src(int k, const Unit& u) const { return k == 0 ? (const void*)(sa + u.pm * BM) : (const void*)(sb + u.pn * BM); }
    __device__ __forceinline__ void operator()(const i32x4 (&acc)[2][2][4][2], const Unit& u, int wr, int wc, int fr, int fq, const PG8_LAS unsigned char* xl) const {
        const int row0 = u.pm * BM + wr * 64 + fr, col0 = u.pn * BM + wc * 32 + 8 * fq;
        f32x4 sv[2][2];
#pragma unroll
        for (int bj = 0; bj < 2; ++bj)
#pragma unroll
            for (int n = 0; n < 2; ++n) sv[bj][n] = *(const PG8_LAS f32x4*)(xl + 1024 + (wc * 32 + 8 * fq + bj * HALF + 4 * n) * 4);
#pragma unroll
        for (int ai = 0; ai < 2; ++ai)
#pragma unroll
            for (int m = 0; m < 4; ++m) { const int row = row0 + ai * HALF + m * 16; const float s = *(const PG8_LAS float*)(xl + (wr * 64 + fr + ai * HALF + m * 16) * 4); bf16_t* rowp = O + (size_t)row * ldc + col0;
#pragma unroll
                for (int bj = 0; bj < 2; ++bj) { const f32x4 v0 = __builtin_convertvector(acc[ai][bj][m][0], f32x4) * (sv[bj][0] * s), v1 = __builtin_convertvector(acc[ai][bj][m][1], f32x4) * (sv[bj][1] * s);
                    u32x4 w; w.x = cvt_pk_bf16(v0[0], v0[1]); w.y = cvt_pk_bf16(v0[2], v0[3]); w.z = cvt_pk_bf16(v1[0], v1[1]); w.w = cvt_pk_bf16(v1[2], v1[3]);
                    *(u32x4*)(rowp + bj * HALF) = w; } }
    }
};
typedef _Float16 h2_t __attribute__((ext_vector_type(2)));
__device__ __forceinline__ h2_t swiglu_h2(h2_t g, h2_t l) {
    const h2_t seven = {(_Float16)7.0f, (_Float16)7.0f}, mseven = {(_Float16)-7.0f, (_Float16)-7.0f}, one = {(_Float16)1.0f, (_Float16)1.0f}, kk = {(_Float16)-2.4554669f, (_Float16)-2.4554669f};
    const h2_t xg = __builtin_elementwise_min(g, seven), xl = __builtin_elementwise_min(__builtin_elementwise_max(l, mseven), seven);
    const h2_t a = xg * kk; h2_t e; e.x = __builtin_exp2f16(a.x); e.y = __builtin_exp2f16(a.y);
    const h2_t den = one + e; h2_t r; r.x = __builtin_amdgcn_rcph(den.x); r.y = __builtin_amdgcn_rcph(den.y);
    const h2_t t = xg * r; return t * xl + t;
}
__device__ __forceinline__ void xpose4(unsigned& r0, unsigned& r1, unsigned& r2, unsigned& r3) {
    { const auto t = __builtin_amdgcn_permlane32_swap(r0, r2, false, false); r0 = t[0]; r2 = t[1]; }
    { const auto t = __builtin_amdgcn_permlane32_swap(r1, r3, false, false); r1 = t[0]; r3 = t[1]; }
    { const auto t = __builtin_amdgcn_permlane16_swap(r0, r1, false, false); r0 = t[0]; r1 = t[1]; }
    { const auto t = __builtin_amdgcn_permlane16_swap(r2, r3, false, false); r2 = t[0]; r3 = t[1]; }
}
struct EpiSwigluQ {
    static constexpr bool PERM = true, AFTER_DRAIN = false; static constexpr int MODE = 1; typedef i32x4 acc_t;
    unsigned char* act; const float* b1; const float* sa; const float* sb;
    static constexpr int NSTAGE = 3;
    __device__ __forceinline__ const void* stage_src(int k, const Unit& u) const { const int e = u.pn >> 3, ntile = u.pn & 7;
        return k == 0 ? (const void*)(sa + u.pm * BM) : (k == 1 ? (const void*)(b1 + e * 2048 + ntile * BM) : (const void*)(sb + e * 2048 + ntile * BM)); }
    __device__ __forceinline__ void operator()(const i32x4 (&acc)[2][2][4][2], const Unit& u, int wr, int wc, int fr, int fq, const PG8_LAS unsigned char* xl) const {
        const int row0 = u.pm * BM + wr * 64 + fr; const int e = u.pn >> 3, ntile = u.pn & 7;
        const int c0 = ntile * BM + wc * 32 + 8 * fq;
        f32x4 bv[2][2], sv[2][2];
#pragma unroll
        for (int bj = 0; bj < 2; ++bj)
#pragma unroll
            for (int n = 0; n < 2; ++n) { const int cl = (wc * 32 + 8 * fq + bj * HALF + 4 * n) * 4; bv[bj][n] = *(const PG8_LAS f32x4*)(xl + 1024 + cl); sv[bj][n] = *(const PG8_LAS f32x4*)(xl + 2048 + cl); }
#pragma unroll
        for (int ai = 0; ai < 2; ++ai) { unsigned w4[2][4];
#pragma unroll
            for (int m = 0; m < 4; ++m) { const float s = *(const PG8_LAS float*)(xl + (wr * 64 + fr + ai * HALF + m * 16) * 4);
#pragma unroll
                for (int bj = 0; bj < 2; ++bj) { const f32x4 v0 = __builtin_convertvector(acc[ai][bj][m][0], f32x4) * (sv[bj][0] * s) + bv[bj][0], v1 = __builtin_convertvector(acc[ai][bj][m][1], f32x4) * (sv[bj][1] * s) + bv[bj][1];
                    const h2_t g01 = {(_Float16)v0[0], (_Float16)v0[2]}, l01 = {(_Float16)v0[1], (_Float16)v0[3]}, g23 = {(_Float16)v1[0], (_Float16)v1[2]}, l23 = {(_Float16)v1[1], (_Float16)v1[3]};
                    const h2_t o01 = swiglu_h2(g01, l01), o23 = swiglu_h2(g23, l23);
                    int w = __builtin_amdgcn_cvt_pk_fp8_f32((float)o01.x, (float)o01.y, 0, false); w = __builtin_amdgcn_cvt_pk_fp8_f32((float)o23.x, (float)o23.y, w, true);
                    w4[bj][m] = (unsigned)w; } }
            unsigned char* rowp = act + (size_t)(row0 + ai * HALF + 16 * fq) * 1024 + ((ntile * BM + wc * 32) >> 1);
#pragma unroll
            for (int bj = 0; bj < 2; ++bj) { xpose4(w4[bj][0], w4[bj][1], w4[bj][2], w4[bj][3]);
                u32x4 o4; o4.x = w4[bj][0]; o4.y = w4[bj][1]; o4.z = w4[bj][2]; o4.w = w4[bj][3];
                *(u32x4*)(rowp + bj * (HALF / 2)) = o4; } }
    }
};
struct EpiMoeOutF8 {
    static constexpr bool PERM = true, AFTER_DRAIN = false; static constexpr int MODE = 2; typedef f32x4 acc_t;
    unsigned char* yk; const float* b2; const float* sb; const int* srt_tok; const float* srt_gate;
    static constexpr int NSTAGE = 4;
    __device__ __forceinline__ const void* stage_src(int k, const Unit& u) const { const int e = u.pn >> 2, ntile = u.pn & 3;
        return k == 0 ? (const void*)(b2 + e * 1024 + ntile * BM) : (k == 1 ? (const void*)(sb + e * 1024 + ntile * BM) : (k == 2 ? (const void*)(srt_tok + u.pm * BM) : (const void*)(srt_gate + u.pm * BM))); }
    __device__ __forceinline__ void operator()(const f32x4 (&acc)[2][2][4][2], const Unit& u, int wr, int wc, int fr, int fq, const PG8_LAS unsigned char* xl) const {
        const int row0 = u.pm * BM + wr * 64 + fr; const int e = u.pn >> 2, ntile = u.pn & 3;
        const int c0 = ntile * BM + wc * 32 + 8 * fq;
#pragma unroll
        for (int bj = 0; bj < 2; ++bj) { f32x4 bv[2], sv[2];
#pragma unroll
            for (int n = 0; n < 2; ++n) { const int cl = (wc * 32 + 8 * fq + bj * HALF + 4 * n) * 4; bv[n] = *(const PG8_LAS f32x4*)(xl + cl); sv[n] = *(const PG8_LAS f32x4*)(xl + 1024 + cl); }
#pragma unroll
            for (int ai = 0; ai < 2; ++ai)
#pragma unroll
                for (int m = 0; m < 4; ++m) { const int rl = (wr * 64 + fr + ai * HALF + m * 16) * 4; const int id = *(const PG8_LAS int*)(xl + 2048 + rl); const float gt = *(const PG8_LAS float*)(xl + 3072 + rl);
                    if (id >= 0) { const f32x4 v0 = (acc[ai][bj][m][0] * sv[0] + bv[0]) * gt, v1 = (acc[ai][bj][m][1] * sv[1] + bv[1]) * gt;
                        int w0 = __builtin_amdgcn_cvt_pk_fp8_f32(v0[0], v0[1], 0, false); w0 = __builtin_amdgcn_cvt_pk_fp8_f32(v0[2], v0[3], w0, true);
                        int w1 = __builtin_amdgcn_cvt_pk_fp8_f32(v1[0], v1[1], 0, false); w1 = __builtin_amdgcn_cvt_pk_fp8_f32(v1[2], v1[3], w1, true);
                        v2u w; w.x = (unsigned)w0; w.y = (unsigned)w1;
                        *(v2u*)(yk + (size_t)id * 1024 + c0 + bj * HALF) = w; } }
            asm volatile("" ::: "memory"); }
    }
};


typedef int i32x8 __attribute__((ext_vector_type(8)));
struct Frag2 { bf16x8 h[2]; };
template <int MODE> struct FragOps { typedef Frag2 frag_t;
    static __device__ __forceinline__ Frag2 load(const PG8_LAS unsigned char* p) { Frag2 f; f.h[0] = *(const PG8_LAS bf16x8*)p; f.h[1] = *(const PG8_LAS bf16x8*)(p + 1024); return f; } };
template <> struct FragOps<2> { typedef i32x8 frag_t;
    static __device__ __forceinline__ i32x8 load(const PG8_LAS unsigned char* p) { const i32x4 lo = *(const PG8_LAS i32x4*)p, hi = *(const PG8_LAS i32x4*)(p + 1024); return __builtin_shufflevector(lo, hi, 0, 1, 2, 3, 4, 5, 6, 7); } };
template <int MODE> struct Mma;
template <> struct Mma<0> { static __device__ __forceinline__ f32x4 run(const Frag2& a, const Frag2& b, f32x4 c) { c = __builtin_amdgcn_mfma_f32_16x16x32_bf16(a.h[0], b.h[0], c, 0, 0, 0); return __builtin_amdgcn_mfma_f32_16x16x32_bf16(a.h[1], b.h[1], c, 0, 0, 0); } };
template <> struct Mma<1> { static __device__ __forceinline__ i32x4 run(const Frag2& a, const Frag2& b, i32x4 c) { c = __builtin_amdgcn_mfma_i32_16x16x64_i8(__builtin_bit_cast(i32x4, a.h[0]), __builtin_bit_cast(i32x4, b.h[0]), c, 0, 0, 0);
        return __builtin_amdgcn_mfma_i32_16x16x64_i8(__builtin_bit_cast(i32x4, a.h[1]), __builtin_bit_cast(i32x4, b.h[1]), c, 0, 0, 0); } };
template <> struct Mma<2> { static __device__ __forceinline__ f32x4 run(const i32x8& a, const i32x8& b, f32x4 c) {
        asm volatile("v_mfma_scale_f32_16x16x128_f8f6f4 %0, %1, %2, %0, %3, %3 op_sel_hi:[0,0,0]" : "+v"(c) : "v"(a), "v"(b), "v"(0x7F7F7F7F)); return c; } };

template <class Epi, class Sched, bool ALIGN_EPI = false, bool SP2 = false>
__device__ __forceinline__ void gemm_phase(PG8_LAS unsigned char* lds, const Gemm g, const Sched& S, const Epi& E, PG8_LAS unsigned char* xlds = nullptr) {
    const int tid = threadIdx.x, wid = __builtin_amdgcn_readfirstlane(tid >> 6), lane = tid & 63, wr = wid >> 2, wc = wid & 3, fr = lane & 15, fq = lane >> 4;
    constexpr int MODE = Epi::MODE; typedef typename Epi::acc_t acc_t;
    const int rowb = MODE ? g.K : g.K * 2, nt = rowb / (BK * 2);
    unsigned voffA[2], voffB[2];
#pragma unroll
    for (int i = 0; i < 2; ++i) { int R, C; stage_rc(tid * 16 + i * 8192, R, C); const int Rb = Epi::PERM ? ((R & ~31) + perm32(R & 31)) : R;
        voffA[i] = (unsigned)(R * rowb + C * 2); voffB[i] = (unsigned)(Rb * rowb + C * 2); }
    const size_t kstep = (size_t)(BK * 2);
    const size_t hstep = (size_t)HALF * rowb;
    const size_t tstep = 2 * hstep;
    const unsigned ldsw = (unsigned)wid * 1024u;
    const int aoff = lds_byte(wr * 64 + fr, fq * 8), boff = lds_byte(wc * 32 + fr, fq * 8);
    constexpr bool GATHER = Sched::GATHER;
    int gR[2]; unsigned gC[2]; unsigned gA[2][2], gN[2][2];
#pragma unroll
    for (int i = 0; i < 2; ++i) { int R, C; stage_rc(tid * 16 + i * 8192, R, C); gR[i] = R; gC[i] = (unsigned)(C * 2);
#pragma unroll
        for (int h = 0; h < 2; ++h) { gA[h][i] = 0u; gN[h][i] = 0u; } }
#define PG8_SA(b, h) (((b) * 2 + (h)) * HTB)
#define PG8_SB(b, h) ((4 + (b) * 2 + (h)) * HTB)
#define PG8_STAGE(bufoff, gbase, voff) do { _Pragma("unroll") for (int _i = 0; _i < 2; ++_i) \
        __builtin_amdgcn_global_load_lds((const unsigned*)((const char*)(gbase) + (voff)[_i]), (PG8_LAS unsigned*)(lds + (bufoff) + ldsw + _i * 8192), 16, 0, 0); } while (0)
#define PG8_STA(bufoff, h, nxsel, kb) do { if constexpr (GATHER) { unsigned o_[2] = {(nxsel) ? gN[h][0] : gA[h][0], (nxsel) ? gN[h][1] : gA[h][1]}; PG8_STAGE(bufoff, (const char*)g.A + (kb), o_); } \
        else { PG8_STAGE(bufoff, ((nxsel) ? nA : cA) + (size_t)(h) * hstep + (kb), voffA); } } while (0)
#define PG8_ROWT_ISSUE(slot, pm) do { if constexpr (GATHER) { if (wid < 4) __builtin_amdgcn_global_load_lds((const unsigned*)(S.rowoff + (size_t)(pm) * BM + wid * 64 + lane), (PG8_LAS unsigned*)(S.rowt + (slot) * 256 + wid * 64), 4, 0, 0); } } while (0)
#define PG8_ROWT_READ(dst, slot) do { if constexpr (GATHER) { _Pragma("unroll") for (int h_ = 0; h_ < 2; ++h_) _Pragma("unroll") for (int i_ = 0; i_ < 2; ++i_) dst[h_][i_] = (unsigned)S.rowt[(slot) * 256 + h_ * HALF + gR[i_]] + gC[i_]; } } while (0)
#define PG8_EPI_ISSUE(slot, U) do { if constexpr (Epi::NSTAGE > 0) { if (wid < Epi::NSTAGE) __builtin_amdgcn_global_load_lds((const unsigned*)((const char*)E.stage_src(wid, U) + lane * 16), (PG8_LAS unsigned*)(xlds + (slot) * 4096 + wid * 1024), 16, 0, 0); } } while (0)
#define PG8_LDA(dst, b, h) do { _Pragma("unroll") for (int m = 0; m < 4; ++m) dst[m] = FragOps<MODE>::load(lds + PG8_SA(b, h) + aoff + m * 2048); } while (0)
#define PG8_LDB(dst, b, h) do { _Pragma("unroll") for (int n = 0; n < 2; ++n) dst[n] = FragOps<MODE>::load(lds + PG8_SB(b, h) + boff + n * 2048); } while (0)
#define PG8_MMA(ai, bj, At, Bt) do { __builtin_amdgcn_s_setprio(1); _Pragma("unroll") for (int m = 0; m < 4; ++m) _Pragma("unroll") for (int n = 0; n < 2; ++n) \
        acc[ai][bj][m][n] = Mma<MODE>::run(Bt[n], At[m], acc[ai][bj][m][n]); __builtin_amdgcn_s_setprio(0); } while (0)
#define PG8_WAIT_V(n) asm volatile("s_waitcnt vmcnt(" #n ")" ::: "memory")
#define PG8_WAIT_L(n) asm volatile("s_waitcnt lgkmcnt(" #n ")" ::: "memory")
#define PG8_BAR __builtin_amdgcn_s_barrier()
#define PG8_SCHED __builtin_amdgcn_sched_barrier(0)
    Unit cur, nxt; int ui = 0;
    if (!S.next(0, cur)) return;
    acc_t acc[2][2][4][2];
#pragma unroll
    for (int a = 0; a < 2; ++a)
#pragma unroll
        for (int b = 0; b < 2; ++b)
#pragma unroll
            for (int m = 0; m < 4; ++m)
#pragma unroll
                for (int n = 0; n < 2; ++n) acc[a][b][m][n] = (acc_t)0;
    typename FragOps<MODE>::frag_t At[4], B0[2], B1[2];
    const char* cA = (const char*)g.A + (size_t)cur.pm * tstep; const char* cB = (const char*)g.Bt + (size_t)cur.pn * tstep; const char* nA = cA;
    S.a_ready(cur);
    PG8_EPI_ISSUE(0, cur);
    if constexpr (GATHER) { PG8_ROWT_ISSUE(0, cur.pm); PG8_WAIT_V(0); __syncthreads(); PG8_ROWT_READ(gA, 0); PG8_WAIT_L(0); }
    if constexpr (SP2) {
        PG8_STAGE(PG8_SB(0, 0), cB, voffB); PG8_STAGE(PG8_SB(0, 1), cB + hstep, voffB); PG8_STA(PG8_SA(0, 0), 0, false, 0); PG8_STA(PG8_SA(0, 1), 1, false, 0);
        if (wr == 1) PG8_BAR;
        PG8_WAIT_V(2); PG8_BAR;
        PG8_STAGE(PG8_SB(1, 0), cB + kstep, voffB); PG8_STA(PG8_SA(1, 0), 0, false, kstep); PG8_STAGE(PG8_SB(1, 1), cB + hstep + kstep, voffB);
        PG8_WAIT_V(6); PG8_BAR;
    } else {
        PG8_STAGE(PG8_SB(0, 0), cB, voffB); PG8_STAGE(PG8_SA(0, 0), cA, voffA); PG8_STAGE(PG8_SB(0, 1), cB + hstep, voffB); PG8_STAGE(PG8_SA(0, 1), cA + hstep, voffA);
        if (wr == 1) PG8_BAR;
        PG8_WAIT_V(4); PG8_BAR;
        PG8_STAGE(PG8_SB(1, 0), cB + kstep, voffB); PG8_STAGE(PG8_SA(1, 0), cA + kstep, voffA); PG8_STAGE(PG8_SB(1, 1), cB + hstep + kstep, voffB);
        PG8_WAIT_V(6); PG8_BAR;
    }
    for (;;) {
        const bool has_next = S.next(ui + 1, nxt);
        nA = has_next ? (const char*)g.A + (size_t)nxt.pm * tstep : cA; const char* nB = has_next ? (const char*)g.Bt + (size_t)nxt.pn * tstep : cB;
        if (has_next) { PG8_EPI_ISSUE((ui + 1) % 3, nxt); }
        if (has_next) PG8_ROWT_ISSUE((ui + 1) & 1, nxt.pm);
#pragma unroll 1
        for (int t = 0; t < nt; t += 2) {
            const bool last = (t == nt - 2);
            const char* a1 = cA + (size_t)(t + 1) * kstep;
            const char* a2 = last ? nA : cA + (size_t)(t + 2) * kstep; const char* b2 = last ? nB : cB + (size_t)(t + 2) * kstep;
            const char* a3 = a2 + kstep; const char* b3 = b2 + kstep;
            const size_t kb1 = (size_t)(t + 1) * kstep, kb2 = last ? 0 : (size_t)(t + 2) * kstep, kb3 = kb2 + kstep;
            if (last && has_next) S.a_ready(nxt);
            if constexpr (GATHER) { if (last) { if (has_next) { PG8_ROWT_READ(gN, (ui + 1) & 1); } else {
#pragma unroll
                        for (int h_ = 0; h_ < 2; ++h_) { gN[h_][0] = gA[h_][0]; gN[h_][1] = gA[h_][1]; } } } }
            if constexpr (SP2) {
            PG8_LDB(B0, 0, 0); PG8_LDB(B1, 0, 1); PG8_SCHED; PG8_LDA(At, 0, 0); PG8_STA(PG8_SA(1, 1), 1, false, kb1);
            PG8_WAIT_V(8); PG8_WAIT_L(0); PG8_BAR; PG8_MMA(0, 0, At, B0); PG8_MMA(0, 1, At, B1); PG8_BAR; PG8_SCHED;
            PG8_LDA(At, 0, 1); PG8_STAGE(PG8_SB(0, 0), b2, voffB); PG8_STAGE(PG8_SB(0, 1), b2 + hstep, voffB); PG8_STA(PG8_SA(0, 0), 0, last, kb2);
            PG8_WAIT_V(8); PG8_WAIT_L(0); PG8_BAR; PG8_MMA(1, 0, At, B0); PG8_MMA(1, 1, At, B1); PG8_BAR; PG8_SCHED;
            PG8_LDB(B0, 1, 0); PG8_LDB(B1, 1, 1); PG8_SCHED; PG8_LDA(At, 1, 0); PG8_STA(PG8_SA(0, 1), 1, last, kb2);
            PG8_WAIT_V(8); PG8_WAIT_L(0); PG8_BAR; PG8_MMA(0, 0, At, B0); PG8_MMA(0, 1, At, B1); PG8_BAR; PG8_SCHED;
            PG8_LDA(At, 1, 1); PG8_STAGE(PG8_SB(1, 0), b3, voffB); PG8_STAGE(PG8_SB(1, 1), b3 + hstep, voffB); PG8_STA(PG8_SA(1, 0), 0, last, kb3);
            PG8_WAIT_V(8); PG8_WAIT_L(0); PG8_BAR; PG8_MMA(1, 0, At, B0); PG8_MMA(1, 1, At, B1); PG8_BAR; PG8_SCHED;
            } else {
            PG8_LDB(B0, 0, 0); PG8_SCHED; PG8_LDA(At, 0, 0); PG8_STAGE(PG8_SA(1, 1), a1 + hstep, voffA);
            PG8_WAIT_L(8); PG8_BAR; PG8_WAIT_L(0); PG8_MMA(0, 0, At, B0); PG8_BAR; PG8_SCHED;
            PG8_LDB(B1, 0, 1); PG8_STAGE(PG8_SB(0, 0), b2, voffB);
            PG8_BAR; PG8_WAIT_L(0); PG8_MMA(0, 1, At, B1); PG8_BAR;
            PG8_LDA(At, 0, 1); PG8_STAGE(PG8_SA(0, 0), a2, voffA);
            PG8_BAR; PG8_WAIT_L(0); PG8_MMA(1, 0, At, B0); PG8_BAR; PG8_SCHED;
            PG8_STAGE(PG8_SB(0, 1), b2 + hstep, voffB);
            PG8_WAIT_V(6); PG8_BAR; PG8_MMA(1, 1, At, B1); PG8_BAR;
            PG8_LDB(B0, 1, 0); PG8_SCHED; PG8_LDA(At, 1, 0); PG8_STAGE(PG8_SA(0, 1), a2 + hstep, voffA);
            PG8_WAIT_L(8); PG8_BAR; PG8_WAIT_L(0); PG8_MMA(0, 0, At, B0); PG8_BAR; PG8_SCHED;
            PG8_LDB(B1, 1, 1); PG8_STAGE(PG8_SB(1, 0), b3, voffB);
            PG8_BAR; PG8_WAIT_L(0); PG8_MMA(0, 1, At, B1); PG8_BAR;
            PG8_LDA(At, 1, 1); PG8_STAGE(PG8_SA(1, 0), a3, voffA);
            PG8_BAR; PG8_WAIT_L(0); PG8_MMA(1, 0, At, B0); PG8_BAR; PG8_SCHED;
            PG8_STAGE(PG8_SB(1, 1), b3 + hstep, voffB);
            PG8_WAIT_V(6); PG8_BAR; PG8_MMA(1, 1, At, B1); PG8_BAR;
            }
        }
        if constexpr (ALIGN_EPI) { if (wr == 0) PG8_BAR; }
        if constexpr (!Epi::AFTER_DRAIN) { E(acc, cur, wr, wc, fr, fq, xlds + (ui % 3) * 4096); S.done(cur); }
        if (!has_next) break;
#pragma unroll
        for (int a = 0; a < 2; ++a)
#pragma unroll
            for (int b = 0; b < 2; ++b)
#pragma unroll
                for (int m = 0; m < 4; ++m)
#pragma unroll
                    for (int n = 0; n < 2; ++n) acc[a][b][m][n] = (acc_t)0;
        cur = nxt; cA = nA; cB = nB; ++ui;
        if constexpr (GATHER) {
#pragma unroll
            for (int h_ = 0; h_ < 2; ++h_) { gA[h_][0] = gN[h_][0]; gA[h_][1] = gN[h_][1]; } }
        if constexpr (ALIGN_EPI) { if (wr == 1) PG8_BAR; }
    }
    PG8_WAIT_V(0);
    if constexpr (!ALIGN_EPI) { if (wr == 0) PG8_BAR; }
    PG8_BAR;
#undef PG8_SA
#undef PG8_SB
#undef PG8_STAGE
#undef PG8_STA
#undef PG8_EPI_ISSUE
#undef PG8_ROWT_ISSUE
#undef PG8_ROWT_READ
#undef PG8_LDA
#undef PG8_LDB
#undef PG8_MMA
#undef PG8_WAIT_V
#undef PG8_WAIT_L
#undef PG8_BAR
#undef PG8_SCHED
}
}

constexpr int NWAVES = 8, NTHR = 512;
constexpr int BATCH = 2, SEQ = 8192, T = BATCH * SEQ, D = 1024;
constexpr int DI = 2048, SH = 32, HP = 64, NGRP = 4, NS = 128, CHK = 128, NCH = SEQ / CHK;
constexpr int IN_DIM = 5152, XW = 5120, XOFF = 2048, BOFF = 4096, COFF = 4608, CONVD = 3072;
constexpr int QH = 16, KVH = 4, HD = 64, QKVW = 1536;
constexpr int NE = 32, TOPK = 4, FF = 1024, NA = T * TOPK, MTILE = 256, CAP = NA + NE * MTILE, MAXTILES = CAP / MTILE;
constexpr float EPS = 1e-6f;

constexpr size_t MiB = 1u << 20;
constexpr size_t WS_CTL = 0, CTL_ZERO_BYTES = 32768;
constexpr size_t WS_MODP = 1 * MiB;
constexpr size_t WS_MISC = 2 * MiB;
constexpr size_t MISC_CNT = 0, MISC_TE = 65536, MISC_NT = 65536 + 2048, MISC_CDEC = 131072, MISC_GATE = 262144;
constexpr size_t WS_WSC = 3 * MiB;
constexpr size_t WSC_W1 = 0, WSC_IN = 524288, WSC_QKV = 524288 + 32768, WSC_W2 = 524288 + 65536;
constexpr size_t HS_OFF = 16 * MiB, XGS_OFF = 80 * MiB;
constexpr size_t WS_WIN = 4 * MiB, WS_WOUT = 14 * MiB, WS_WQKV = 18 * MiB, WS_WAO = 21 * MiB;
constexpr size_t WS_W1 = 32 * MiB, WS_W2 = 288 * MiB;
constexpr size_t WS_H = 416 * MiB, WS_ZX = 448 * MiB, WS_DT = 608 * MiB, WS_ST = 610 * MiB, WS_Y = 674 * MiB;
constexpr size_t WS_X1 = 738 * MiB, WS_X2 = 802 * MiB, WS_X3 = 866 * MiB;
constexpr size_t WS_ASG = 930 * MiB;
constexpr size_t WS_SRT = 931 * MiB;
constexpr size_t WS_XG = 932 * MiB, WS_ACT = 1076 * MiB, WS_YK = 1220 * MiB, WS_QKV = 1348 * MiB, WS_AO = 1396 * MiB;
constexpr size_t WS_XT = 1428 * MiB, WS_BT = 1492 * MiB, WS_BN = 1508 * MiB, WS_CN = 1524 * MiB, WS_END = 1540 * MiB;
constexpr int CW_TMO = 0, CW_CODE = 1, CW_BAR = 4096;

constexpr int RING_OFF = 0, RING_BYTES = 131072;
constexpr int LDSCTL_OFF = RING_BYTES, MISC_OFF = LDSCTL_OFF + 320, TE_OFF = MISC_OFF + 128;
constexpr int ROWT_OFF = TE_OFF + 1280;
constexpr int EPIX_OFF = ROWT_OFF + 2048;
constexpr int LDS_BYTES = 147456;
static_assert(EPIX_OFF + 3 * 4096 <= LDS_BYTES && (EPIX_OFF & 15) == 0, "LDS map");
static_assert(TE_OFF + 4 * (MAXTILES + 4) <= LDS_BYTES, "LDS map");

#define LDS_WAIT() asm volatile("s_waitcnt lgkmcnt(0)" ::: "memory")
#define VM_WAIT() asm volatile("s_waitcnt vmcnt(0)" ::: "memory")
__device__ __forceinline__ unsigned f2bf(float f) { unsigned u = __builtin_bit_cast(unsigned, f); return (u + 0x7fffu + ((u >> 16) & 1u)) >> 16; }
typedef float f32x2_t __attribute__((ext_vector_type(2)));
typedef __bf16 bf16x2_t __attribute__((ext_vector_type(2)));
__device__ __forceinline__ unsigned pk2(float lo, float hi) { const f32x2_t v = {lo, hi}; const bf16x2_t b = __builtin_convertvector(v, bf16x2_t); return __builtin_bit_cast(unsigned, b); }
__device__ __forceinline__ float bf2f(unsigned h) { return __builtin_bit_cast(float, h << 16); }
__device__ __forceinline__ float bflo(unsigned w) { return __builtin_bit_cast(float, w << 16); }
__device__ __forceinline__ float bfhi(unsigned w) { return __builtin_bit_cast(float, w & 0xffff0000u); }
__device__ __forceinline__ bf16x8 pack8(const float (&o)[8]) { v4u w; w.x = pk2(o[0], o[1]); w.y = pk2(o[2], o[3]); w.z = pk2(o[4], o[5]); w.w = pk2(o[6], o[7]); return __builtin_bit_cast(bf16x8, w); }
__device__ __forceinline__ float rcp_f(float x) { return __builtin_amdgcn_rcpf(x); }
__device__ __forceinline__ float rsq_f(float x) { return __builtin_amdgcn_rsqf(x); }
__device__ __forceinline__ float silu_f(float x) { return x * rcp_f(1.0f + __expf(-x)); }
__device__ __forceinline__ float wave_sum(float v) {
#pragma unroll
    for (int o = 1; o < 64; o <<= 1) v += __shfl_xor(v, o);
    return v;
}
#define MFMA16(a, b, c) __builtin_amdgcn_mfma_f32_16x16x32_bf16((a), (b), (c), 0, 0, 0)

#define XB_TMO      128
#define XB_XCNT(j)  (256  + 64 * (j))
#define XB_XSUB(j)  (1280 + 64 * (j))
#define XB_XGEN(j)  (2304 + 64 * (j))
#define XB_TOP      3328
#define XB_TOPGEN   3392
#define XCD_BAR_WORDS 3456
#define XB_SPIN_CAP (1u << 18)
__device__ __forceinline__ unsigned xb_ld(unsigned* p)              { return __hip_atomic_load(p, __ATOMIC_RELAXED, __HIP_MEMORY_SCOPE_AGENT); }
__device__ __forceinline__ unsigned xb_add(unsigned* p, unsigned v) { return __hip_atomic_fetch_add(p, v, __ATOMIC_RELAXED, __HIP_MEMORY_SCOPE_AGENT); }
__device__ __forceinline__ unsigned xb_xcc_id() { return (unsigned)__builtin_amdgcn_s_getreg((3 << 11) | 20) & 0xFu; }
#define XB_SPIN(cond, bar) do { unsigned _sp = 0; while (cond) { __builtin_amdgcn_s_sleep(1); \
    if ((++_sp & 255u) == 0u) { if (xb_ld(&(bar)[XB_TMO])) break; if (_sp > XB_SPIN_CAP) { atomicAdd(&(bar)[XB_TMO], 1u); break; } } } } while (0)
struct XcdBarrier { unsigned* bar; unsigned x; volatile LAS unsigned* st; };
__device__ __forceinline__ XcdBarrier xcd_barrier_post(unsigned* bar, volatile LAS unsigned* st) {
    XcdBarrier b; b.bar = bar; b.x = xb_xcc_id(); b.st = st;
    if (threadIdx.x == 0) (void)xb_add(&bar[XB_XCNT(b.x)], 1u);
    return b;
}
__device__ __forceinline__ void xcd_barrier_complete(unsigned* bar, unsigned x, unsigned& nloc, unsigned& nx) {
    const unsigned G = gridDim.x * gridDim.y * gridDim.z;
    unsigned sum, cnt, mine, sp = 0u;
    for (;;) {
        sum = 0u; cnt = 0u; mine = 0u;
#pragma unroll
        for (unsigned j = 0; j < 16; ++j) { const unsigned c = xb_ld(&bar[XB_XCNT(j)]); sum += c; cnt += (c > 0u) ? 1u : 0u; mine = (j == x) ? c : mine; }
        if (sum == G) break;
        __builtin_amdgcn_s_sleep(1);
        if ((++sp & 255u) == 0u) { if (xb_ld(&bar[XB_TMO])) break; if (sp > XB_SPIN_CAP) { atomicAdd(&bar[XB_TMO], 1u); break; } }
    }
    nloc = mine > 0u ? mine : 1u; nx = cnt > 0u ? cnt : 1u;
}
__device__ __forceinline__ void xcd_barrier(const XcdBarrier& b) {
    asm volatile("s_waitcnt vmcnt(0)" ::: "memory");
    __syncthreads();
    if (threadIdx.x == 0) {
        unsigned* bar = b.bar;
        __builtin_amdgcn_s_waitcnt(0);
        unsigned nloc = b.st[0], nx = b.st[1];
        if (nloc == 0u) { xcd_barrier_complete(bar, b.x, nloc, nx); b.st[0] = nloc; b.st[1] = nx; }
        const unsigned old = xb_add(&bar[XB_XSUB(b.x)], 1u);
        const unsigned gen = old / nloc;
        if (old + 1u == (gen + 1u) * nloc) {
            __builtin_amdgcn_fence(__ATOMIC_RELEASE, "agent");
            asm volatile("s_waitcnt vmcnt(0)" ::: "memory");
            const unsigned og = xb_add(&bar[XB_TOP], 1u);
            const unsigned tg = og / nx;
            if (og + 1u == (tg + 1u) * nx) xb_add(&bar[XB_TOPGEN], 1u);
            else XB_SPIN(xb_ld(&bar[XB_TOPGEN]) == tg, bar);
            __builtin_amdgcn_fence(__ATOMIC_ACQUIRE, "agent");
            xb_add(&bar[XB_XGEN(b.x)], 1u);
            asm volatile("s_waitcnt vmcnt(0)" ::: "memory");
        } else {
            XB_SPIN(xb_ld(&bar[XB_XGEN(b.x)]) == gen, bar);
            __builtin_amdgcn_fence(__ATOMIC_ACQUIRE, "agent");
            asm volatile("s_waitcnt vmcnt(0)" ::: "memory");
        }
    }
    __syncthreads();
}

struct Args { const float* in[26]; float* out; unsigned char* ws; int ph_lo, ph_hi; };
enum { I_X = 0, I_C, I_ADAW, I_ADAB, I_N1G, I_N2G, I_MINW, I_MCONVW, I_MCONVB, I_MDTB, I_MALOG, I_MD, I_MNG, I_MOUTW, I_AQKVW, I_AQNG, I_AKNG, I_ASINK, I_AOUTW, I_RELB, I_RW, I_RB, I_EW1, I_EB1, I_EW2, I_EB2 };

__device__ __forceinline__ void p0_transpose_item(const float* __restrict__ W, int ldw, int K, int nblk, bf16* WT, LAS float* scr, int item, int lane) {
    const int kb = item / nblk, nb = item % nblk, k0 = 64 * kb, n0 = 32 * nb;
    float tv[32];
#pragma unroll
    for (int i = 0; i < 32; ++i) { const int kk = 2 * i + (lane >> 5); tv[i] = W[(size_t)(k0 + kk) * ldw + n0 + (lane & 31)]; }
#pragma unroll
    for (int i = 0; i < 32; ++i) { const int kk = 2 * i + (lane >> 5); scr[kk * 33 + (lane & 31)] = tv[i]; }
    LDS_WAIT(); asm volatile("" ::: "memory");
    const int c = lane & 7;
#pragma unroll
    for (int j = 0; j < 4; ++j) { const int n = (lane >> 3) + 8 * j; const LAS float* s = scr + (8 * c) * 33 + n;
        v4u o; o.x = pk2(s[0 * 33], s[1 * 33]); o.y = pk2(s[2 * 33], s[3 * 33]); o.z = pk2(s[4 * 33], s[5 * 33]); o.w = pk2(s[6 * 33], s[7 * 33]);
        *(GAS v4u*)(WT + (size_t)(n0 + n) * K + k0 + 8 * c) = o; }
    LDS_WAIT(); asm volatile("" ::: "memory");
}
__device__ __forceinline__ void p0_prologue(const Args& a, LAS unsigned char* lds, int wave, int lane) {
    unsigned char* ws = a.ws; const int blk = blockIdx.x, G = gridDim.x;
    float* modp = (float*)(ws + WS_MODP);
    const float* __restrict__ cin = a.in[I_C]; const float* __restrict__ adaw = a.in[I_ADAW];
    if (wave < 2) {
        for (int it = wave * G + blk; it < 384; it += 2 * G) {
            const int kc = it & 7, rest = it >> 3, l = rest / 24, nb = rest % 24;
            f32x4 a0 = {0.f, 0.f, 0.f, 0.f}, a1 = {0.f, 0.f, 0.f, 0.f};
            const float* wp = adaw + ((size_t)l * 1024 + kc * 128) * 6144 + nb * 256 + lane * 4;
#pragma unroll 32
            for (int k = 0; k < 128; ++k) { const f32x4 w = *(const f32x4*)(wp + (size_t)k * 6144);
                const float c0 = silu_f(cin[kc * 128 + k]), c1 = silu_f(cin[1024 + kc * 128 + k]); a0 += w * c0; a1 += w * c1; }
            *(f32x4*)(modp + ((size_t)(kc * 2 + l) * 2 + 0) * 6144 + nb * 256 + lane * 4) = a0;
            *(f32x4*)(modp + ((size_t)(kc * 2 + l) * 2 + 1) * 6144 + nb * 256 + lane * 4) = a1;
        }
    } else {
        LAS float* scr = (LAS float*)(lds + RING_OFF + wave * 16384);
        constexpr int I1 = 32 * 32, I3 = 16 * 32;
        constexpr int NITEMS = I1 + I3;
        for (int it = (wave - 2) * G + blk; it < NITEMS; it += 6 * G) {
            int r = it;
            if (r < I1) { p0_transpose_item(a.in[I_MOUTW], 1024, 2048, 32, (bf16*)(ws + WS_WOUT), scr, r, lane); continue; } r -= I1;
            { p0_transpose_item(a.in[I_AOUTW], 1024, 1024, 32, (bf16*)(ws + WS_WAO), scr, r, lane); }
        }
    }
}
struct QItem { const float* W; int ldw, n0; signed char* outq; float* sc; int f8; };
__device__ __forceinline__ QItem quant_decode(const Args& a, int it) {
    unsigned char* ws = a.ws; float* wsc = (float*)(ws + WS_WSC); QItem q; q.f8 = 0;
    constexpr int Q2 = 160;
    if (it < Q2) { q.W = a.in[I_MINW]; q.ldw = IN_DIM; q.n0 = 32 * it; q.outq = (signed char*)(ws + WS_WIN); q.sc = wsc + WSC_IN / 4; }
    else { q.W = a.in[I_AQKVW]; q.ldw = 1536; q.n0 = 32 * (it - Q2); q.outq = (signed char*)(ws + WS_WQKV); q.sc = wsc + WSC_QKV / 4; }
    return q;
}
__device__ __forceinline__ void quant_load(const QItem& q, int wave, int lane, float (&vals)[64]) {
    const int n = lane & 31, kh = lane >> 5; const float* __restrict__ wp = q.W + (size_t)(128 * wave + kh) * q.ldw + q.n0 + n;
#pragma unroll
    for (int i = 0; i < 64; ++i) vals[i] = wp[(size_t)(2 * i) * q.ldw];
}
__device__ __forceinline__ void quant_finish(const QItem& q, const float (&vals)[64], LAS unsigned char* lds, int wave, int lane) {
    LAS float* AMX = (LAS float*)(lds + 36864);
    LAS unsigned char* Tt = lds + wave * 4224;
    const int n = lane & 31, kh = lane >> 5; float am = 0.f;
#pragma unroll
    for (int i = 0; i < 64; ++i) am = fmaxf(am, fabsf(vals[i]));
    am = fmaxf(am, __shfl_xor(am, 32));
    if (lane < 32) AMX[wave * 32 + n] = am;
    __syncthreads();
    float amt = 0.f;
#pragma unroll
    for (int w = 0; w < 8; ++w) amt = fmaxf(amt, AMX[w * 32 + n]);
    const float qmax = q.f8 ? 448.0f : 127.0f;
    const float inv = amt > 0.f ? qmax / amt : 0.f;
    if (wave == 0 && lane < 32) q.sc[q.n0 + n] = amt > 0.f ? amt / qmax : 1.0f;
    if (q.f8) {
#pragma unroll
        for (int i = 0; i < 64; ++i) { const float x = vals[i] * inv; Tt[n * 132 + 2 * i + kh] = (unsigned char)(__builtin_amdgcn_cvt_pk_fp8_f32(x, x, 0, false) & 255); }
    } else {
#pragma unroll
        for (int i = 0; i < 64; ++i) Tt[n * 132 + 2 * i + kh] = (unsigned char)((int)__builtin_rintf(vals[i] * inv) & 255);
    }
    LDS_WAIT(); asm volatile("" ::: "memory");
    { const int rn = lane >> 1, half = lane & 1; const LAS unsigned* src = (const LAS unsigned*)(Tt + rn * 132 + 64 * half);
        v4u o[4];
#pragma unroll
        for (int qd = 0; qd < 4; ++qd) { o[qd].x = src[4 * qd]; o[qd].y = src[4 * qd + 1]; o[qd].z = src[4 * qd + 2]; o[qd].w = src[4 * qd + 3]; }
#pragma unroll
        for (int qd = 0; qd < 4; ++qd) *(v4u*)(q.outq + (size_t)(q.n0 + rn) * 1024 + 128 * wave + 64 * half + 16 * qd) = o[qd]; }
    __syncthreads();
}
__device__ __forceinline__ void p0_quant(const Args& a, LAS unsigned char* lds, int wave, int lane) {
    constexpr int NQ = 160 + 48;
    __syncthreads();
    float va[64], vb[64];
    int it = blockIdx.x;
    if (it < NQ) { const QItem q0 = quant_decode(a, it); quant_load(q0, wave, lane, va); }
#pragma unroll 1
    for (; it < NQ; it += gridDim.x) {
        const int nx = it + gridDim.x;
        if (nx < NQ) { const QItem qn = quant_decode(a, nx); quant_load(qn, wave, lane, vb); }
        const QItem q = quant_decode(a, it);
        quant_finish(q, va, lds, wave, lane);
#pragma unroll
        for (int i = 0; i < 64; ++i) va[i] = vb[i];
    }
}
constexpr int BG_N = 2048 + 1024;
__device__ __forceinline__ QItem bg_decode(const Args& a, int j, int matbase) {
    unsigned char* ws = a.ws; float* wsc = (float*)(ws + WS_WSC); QItem q;
    if (j < 2048) { const int mat = matbase + (j >> 6), nb = j & 63;
        q.W = a.in[I_EW1] + (size_t)mat * 1024 * 2048; q.ldw = 2048; q.n0 = 32 * nb; q.outq = (signed char*)(ws + WS_W1) + (size_t)mat * 2048 * 1024; q.sc = wsc + WSC_W1 / 4 + mat * 2048; q.f8 = 0; }
    else { const int g = j - 2048, mat = matbase + (g >> 5), nb = g & 31;
        q.W = a.in[I_EW2] + (size_t)mat * 1024 * 1024; q.ldw = 1024; q.n0 = 32 * nb; q.outq = (signed char*)(ws + WS_W2) + (size_t)mat * 1024 * 1024; q.sc = wsc + WSC_W2 / 4 + mat * 1024; q.f8 = 1; }
    return q;
}
__device__ __forceinline__ void bg_run(const Args& a, LAS unsigned char* lds, int first, int count, int step, int wave, int lane, int matbase = 32) {
    if (first > BG_N) first = BG_N;
    __syncthreads();
    float va[64], vb[64];
    int j = first, left = count;
    if (j >= BG_N) left = 0;
    if (left > 0) { const QItem q0 = bg_decode(a, j, matbase); quant_load(q0, wave, lane, va); }
#pragma unroll 1
    for (; left > 0; --left, j += step) {
        const int nx = j + step; const bool more = (left > 1) && (nx < BG_N);
        if (more) { const QItem qn = bg_decode(a, nx, matbase); quant_load(qn, wave, lane, vb); }
        const QItem q = bg_decode(a, j, matbase);
        quant_finish(q, va, lds, wave, lane);
        if (!more) break;
#pragma unroll
        for (int i = 0; i < 64; ++i) va[i] = vb[i];
    }
    __syncthreads();
}
__device__ __forceinline__ float modval(const Args& a, int l, int b, int idx) {
    const float* modp = (const float*)(a.ws + WS_MODP);
    float s = a.in[I_ADAB][l * 6144 + idx];
#pragma unroll
    for (int kc = 0; kc < 8; ++kc) s += modp[((size_t)(kc * 2 + l) * 2 + b) * 6144 + idx];
    return s;
}

constexpr int NP_MOD = 0, NP_HI = 16384, NP_LO = NP_HI + 16 * 1032 * 2, NP_PART = NP_LO + 16 * 1032 * 2, NP_LOG = NP_PART + 16384, NP_AE = NP_LOG + 2048, NP_AG = NP_AE + 1024, NP_TOPV = NP_AG + 1024, NP_END = NP_TOPV + 256;
static_assert(NP_END <= RING_BYTES, "norm phase LDS");
template <int MODE, bool COMBINE, bool NORM>
__device__ __forceinline__ void norm_phase(const Args& a, LAS unsigned char* lds, int layer, int which, const float* xin, const float* cgate, const unsigned char* yk, float* xout,
                                           const float* __restrict__ Wsk, int ldw, const float* __restrict__ bsk, int tid, int wave, int lane) {
    unsigned char* ws = a.ws;
    LAS float* MOD = (LAS float*)(lds + NP_MOD);
    LAS bf16* HI = (LAS bf16*)(lds + NP_HI); LAS bf16* LO = (LAS bf16*)(lds + NP_LO);
    LAS float* PART = (LAS float*)(lds + NP_PART); LAS float* LOG = (LAS float*)(lds + NP_LOG);
    LAS int* AE = (LAS int*)(lds + NP_AE); LAS float* AG = (LAS float*)(lds + NP_AG); LAS float* TOPV = (LAS float*)(lds + NP_TOPV);
    signed char* H8 = (signed char*)(ws + WS_H); float* hscale = (float*)(ws + WS_H + HS_OFF);
    const int rb = blockIdx.x;
    if (NORM) {
        const float* ng = a.in[which ? I_N2G : I_N1G] + layer * 1024;
        for (int idx = tid; idx < 2048; idx += NTHR) { const int b = idx >> 10, col = idx & 1023;
            const float sh = modval(a, layer, b, which * 3072 + col), sc = modval(a, layer, b, which * 3072 + 1024 + col);
            MOD[(b * 2 + 0) * 1024 + col] = ng[col] * (1.0f + sc); MOD[(b * 2 + 1) * 1024 + col] = sh; }
    }
    const int fi = lane & 15, fq = lane >> 4;
    bf16x8 Bh[2][4], Bl[2][4];
    if (MODE != 2) {
#pragma unroll
        for (int s = 0; s < 4; ++s)
#pragma unroll
            for (int nt = 0; nt < 2; ++nt) { float hi[8], lo[8];
#pragma unroll
                for (int e = 0; e < 8; ++e) { const float w = Wsk[(size_t)(128 * wave + 32 * s + 8 * fq + e) * ldw + 16 * nt + fi]; const float h = bf2f(f2bf(w)); hi[e] = h; lo[e] = w - h; }
                Bh[nt][s] = pack8(hi); Bl[nt][s] = pack8(lo); }
    }
    __syncthreads();
    f32x4 vn[2][4]; unsigned yn[2][4][4];
#define NP_LOAD_TILE(tlx) do { _Pragma("unroll") for (int rr_ = 0; rr_ < 2; ++rr_) { const int m_ = 64 * rb + 16 * (tlx) + 8 * rr_ + wave; \
        _Pragma("unroll") for (int j = 0; j < 4; ++j) { vn[rr_][j] = *(const f32x4*)(xin + (size_t)m_ * 1024 + 4 * lane + 256 * j); \
            if (COMBINE) { _Pragma("unroll") for (int k = 0; k < 4; ++k) yn[rr_][j][k] = *(const unsigned*)(yk + ((size_t)m_ * 4 + k) * 1024 + 4 * lane + 256 * j); } } } } while (0)
    NP_LOAD_TILE(0);
#pragma unroll 1
    for (int tl = 0; tl < 4; ++tl) {
        f32x4 vc[2][4]; unsigned yc[2][4][4];
#pragma unroll
        for (int rr = 0; rr < 2; ++rr)
#pragma unroll
            for (int j = 0; j < 4; ++j) { vc[rr][j] = vn[rr][j];
                if (COMBINE) {
#pragma unroll
                    for (int k = 0; k < 4; ++k) yc[rr][j][k] = yn[rr][j][k]; } }
        if (tl < 3) NP_LOAD_TILE(tl + 1);
#pragma unroll
        for (int rr = 0; rr < 2; ++rr) {
            const int lr = 8 * rr + wave, m = 64 * rb + 16 * tl + lr, b = m >> 13;
            f32x4 v[4];
#pragma unroll
            for (int j = 0; j < 4; ++j) v[j] = vc[rr][j];
            if (COMBINE) {
#pragma unroll
                for (int j = 0; j < 4; ++j) { const int col = 4 * lane + 256 * j; const f32x4 g = *(const f32x4*)(cgate + b * 1024 + col);
                    f32x4 s = {0.f, 0.f, 0.f, 0.f};
#pragma unroll
                    for (int k = 0; k < 4; ++k) { const unsigned y = yc[rr][j][k]; const f32x2_t lo = __builtin_amdgcn_cvt_pk_f32_fp8((int)y, false), hi = __builtin_amdgcn_cvt_pk_f32_fp8((int)y, true); s += (f32x4){lo[0], lo[1], hi[0], hi[1]}; }
                    v[j] += g * s; *(f32x4*)(xout + (size_t)m * 1024 + col) = v[j]; }
            }
            if (NORM) {
                float ss = 0.f;
#pragma unroll
                for (int j = 0; j < 4; ++j) ss += (v[j].x * v[j].x + v[j].y * v[j].y) + (v[j].z * v[j].z + v[j].w * v[j].w);
                const float r = rsq_f(wave_sum(ss) * (1.0f / 1024.0f) + EPS);
                float am = 0.f;
#pragma unroll
                for (int j = 0; j < 4; ++j) { const int col = 4 * lane + 256 * j;
                    const f32x4 A = *(const LAS f32x4*)(MOD + (b * 2 + 0) * 1024 + col), S = *(const LAS f32x4*)(MOD + (b * 2 + 1) * 1024 + col);
                    const f32x4 h = v[j] * r * A + S; v[j] = h;
                    am = fmaxf(fmaxf(am, fmaxf(fabsf(h.x), fabsf(h.y))), fmaxf(fabsf(h.z), fabsf(h.w)));
                    if (MODE != 2) { v2u hw; hw.x = pk2(h.x, h.y); hw.y = pk2(h.z, h.w);
                        const f32x4 hr = {bflo(hw.x), bfhi(hw.x), bflo(hw.y), bfhi(hw.y)}; const f32x4 l4 = h - hr;
                        v2u lw; lw.x = pk2(l4.x, l4.y); lw.y = pk2(l4.z, l4.w);
                        *(LAS v2u*)(HI + lr * 1032 + col) = hw; *(LAS v2u*)(LO + lr * 1032 + col) = lw; } }
#pragma unroll
                for (int o = 1; o < 64; o <<= 1) am = fmaxf(am, __shfl_xor(am, o));
                const float inv = am > 0.f ? 127.0f / am : 0.f;
#pragma unroll
                for (int j = 0; j < 4; ++j) { const int col = 4 * lane + 256 * j;
                    const int q0 = (int)__builtin_rintf(v[j].x * inv), q1 = (int)__builtin_rintf(v[j].y * inv), q2 = (int)__builtin_rintf(v[j].z * inv), q3 = (int)__builtin_rintf(v[j].w * inv);
                    *(unsigned*)(H8 + (size_t)m * 1024 + col) = (unsigned)(q0 & 255) | ((unsigned)(q1 & 255) << 8) | ((unsigned)(q2 & 255) << 16) | ((unsigned)q3 << 24); }
                if (lane == 0) hscale[m] = am * (1.0f / 127.0f);
            }
        }
        if (MODE != 2) {
            __syncthreads();
            f32x4 acc[2] = {{0.f, 0.f, 0.f, 0.f}, {0.f, 0.f, 0.f, 0.f}};
#pragma unroll
            for (int s = 0; s < 4; ++s) { const int k0 = 128 * wave + 32 * s + 8 * fq;
                const bf16x8 ah = *(const LAS bf16x8*)(HI + fi * 1032 + k0), al = *(const LAS bf16x8*)(LO + fi * 1032 + k0);
#pragma unroll
                for (int nt = 0; nt < 2; ++nt) { acc[nt] = MFMA16(ah, Bh[nt][s], acc[nt]); acc[nt] = MFMA16(al, Bh[nt][s], acc[nt]); acc[nt] = MFMA16(ah, Bl[nt][s], acc[nt]); } }
#pragma unroll
            for (int nt = 0; nt < 2; ++nt)
#pragma unroll
                for (int r = 0; r < 4; ++r) PART[(wave * 16 + 4 * fq + r) * 32 + 16 * nt + fi] = acc[nt][r];
            __syncthreads();
            { const int lr = tid >> 5, n = tid & 31; float s = bsk[n];
#pragma unroll
                for (int w = 0; w < 8; ++w) s += PART[(w * 16 + lr) * 32 + n];
                if (MODE == 0) { const float sp = fmaxf(s, 0.f) + log1pf(__expf(-fabsf(s))); ((float*)(ws + WS_DT))[(size_t)(64 * rb + 16 * tl + lr) * 32 + n] = sp; }
                else LOG[lr * 32 + n] = s; }
            if (MODE == 1) {
                __syncthreads();
                { const int lr = tid >> 5, n = tid & 31; const float sv = LOG[lr * 32 + n]; int rank = 0;
#pragma unroll
                    for (int n2 = 0; n2 < 32; ++n2) { const float o = LOG[lr * 32 + n2]; rank += (o > sv || (o == sv && n2 < n)) ? 1 : 0; }
                    if (rank < 4) { TOPV[lr * 4 + rank] = sv; AE[(16 * tl + lr) * 4 + rank] = n; } }
                __syncthreads();
                if (tid < 64) { const int row = tid >> 2, k = tid & 3; const float v0 = TOPV[row * 4], v1 = TOPV[row * 4 + 1], v2 = TOPV[row * 4 + 2], v3 = TOPV[row * 4 + 3];
                    const float e0 = 1.0f, e1 = __expf(v1 - v0), e2 = __expf(v2 - v0), e3 = __expf(v3 - v0); const float sum = (e0 + e1) + (e2 + e3);
                    const float ek = k == 0 ? e0 : (k == 1 ? e1 : (k == 2 ? e2 : e3));
                    AG[(16 * tl + row) * 4 + k] = ek / sum; }
            }
        }
    }
    if (MODE == 1) {
        __syncthreads();
        int* asg_e = (int*)(ws + WS_ASG); float* asg_g = (float*)(ws + WS_ASG + 262144); int* asg_r = (int*)(ws + WS_ASG + 524288);
        int* cntblk = (int*)(ws + WS_MISC + MISC_CNT);
        LAS int* WC = (LAS int*)(lds + NP_PART);
        int e_mine = 0, rank_w = 0;
        if (wave < 4) { e_mine = AE[tid];
#pragma unroll 4
            for (int e = 0; e < 32; ++e) { const unsigned long long mb = __ballot(e_mine == e); if (e_mine == e) rank_w = __popcll(mb & ((1ull << lane) - 1ull)); if (lane == 0) WC[wave * 32 + e] = __popcll(mb); } }
        __syncthreads();
        if (wave < 4) { int base = 0;
#pragma unroll
            for (int w = 0; w < 3; ++w) base += (w < wave) ? WC[w * 32 + e_mine] : 0;
            asg_e[rb * 256 + tid] = e_mine; asg_g[rb * 256 + tid] = AG[tid]; asg_r[rb * 256 + tid] = base + rank_w; }
        else if (tid < 288) { const int e = tid - 256; cntblk[rb * 32 + e] = (WC[e] + WC[32 + e]) + (WC[64 + e] + WC[96 + e]); }
    }
    __syncthreads();
}

__device__ __forceinline__ void moe_scatter(const Args& a, LAS unsigned char* lds, int tid, int wave, int lane) {
    unsigned char* ws = a.ws; const int rb = blockIdx.x, G = gridDim.x;
    LAS int* PARTS = (LAS int*)(lds + 0); LAS int* TOT = (LAS int*)(lds + 4096); LAS int* BASE = (LAS int*)(lds + 4224); LAS int* PS = (LAS int*)(lds + 4352); LAS int* POS = (LAS int*)(lds + 4608);
    const int* cntblk = (const int*)(ws + WS_MISC + MISC_CNT);
    const int* asg_e = (const int*)(ws + WS_ASG); const float* asg_g = (const float*)(ws + WS_ASG + 262144); const int* asg_r = (const int*)(ws + WS_ASG + 524288);
    int* srt_tok = (int*)(ws + WS_SRT); float* srt_gate = (float*)(ws + WS_SRT + 524288);
    int* rowoff = (int*)(ws + WS_XG); float* xgs = (float*)(ws + WS_XG + XGS_OFF); const float* hscale = (const float*)(ws + WS_H + HS_OFF);
    { const int e = tid & 31, part = tid >> 5; int tot = 0, base = 0;
        for (int bb = part * 16; bb < part * 16 + 16; ++bb) { if (bb < G) { const int c = cntblk[bb * 32 + e]; tot += c; if (bb < rb) base += c; } }
        PARTS[(part * 32 + e) * 2] = tot; PARTS[(part * 32 + e) * 2 + 1] = base; }
    __syncthreads();
    if (tid < 32) { int tot = 0, base = 0; for (int p = 0; p < 16; ++p) { tot += PARTS[(p * 32 + tid) * 2]; base += PARTS[(p * 32 + tid) * 2 + 1]; } TOT[tid] = tot; BASE[tid] = base; }
    __syncthreads();
    if (tid == 0) { int ps = 0; for (int e = 0; e < 32; ++e) { PS[e] = ps; ps += ((TOT[e] + MTILE - 1) / MTILE) * MTILE; } PS[32] = ps; }
    __syncthreads();
    if (tid < 256) { const int aidx = rb * 256 + tid; const int e = asg_e[aidx]; const int pos = PS[e] + BASE[e] + asg_r[aidx];
        srt_tok[pos] = aidx; srt_gate[pos] = asg_g[aidx]; rowoff[pos] = (aidx >> 2) * 1024; xgs[pos] = hscale[aidx >> 2]; }
    if (rb < 32) { const int e = rb; const int p0 = PS[e] + TOT[e], p1 = PS[e + 1];
        for (int pos = p0 + tid; pos < p1; pos += NTHR) { srt_tok[pos] = -1; srt_gate[pos] = 0.f; xgs[pos] = 0.f; rowoff[pos] = 0; } }
    if (rb == 0) { int* te = (int*)(ws + WS_MISC + MISC_TE);
        if (tid < MAXTILES) { const int r0 = tid * MTILE; int e = 0; for (int j = 0; j < 32; ++j) e += (PS[j + 1] <= r0) ? 1 : 0; te[tid] = (r0 < PS[32]) ? e : 31; }
        if (tid == 0) *(int*)(ws + WS_MISC + MISC_NT) = PS[32] / MTILE; }
    __syncthreads();
    __syncthreads();
}
__device__ __forceinline__ void load_tile_table(const Args& a, LAS unsigned char* lds, int tid) {
    const int* te = (const int*)(a.ws + WS_MISC + MISC_TE);
    LAS int* TE = (LAS int*)(lds + TE_OFF);
    if (tid < MAXTILES) TE[tid] = te[tid];
    if (tid == MAXTILES) TE[MAXTILES] = *(const int*)(a.ws + WS_MISC + MISC_NT);
    __syncthreads();
}

#define OPAQUE(x) asm volatile("" : "+v"(x))
__device__ __forceinline__ void conv_load(const bf16* __restrict__ ZX, int tok0, int l0, int zc0, int lane, v4u (&raw)[11]) {
    const int chunk = lane & 7, run = lane >> 3; const int zc = zc0 + 8 * chunk;
    const bf16* __restrict__ base = ZX - 3 * XW; unsigned off = (unsigned)((tok0 + l0 + 8 * run) * XW + zc);
#pragma unroll
    for (int e = 0; e < 11; ++e) { raw[e] = *(const v4u*)(base + off); off += XW; OPAQUE(off); }
}
__device__ __forceinline__ void conv_finish(const Args& a, bool first, int l0, int zc0, bf16* outT, bf16* outN, int lane, v4u (&raw)[11], LAS bf16* ldsT = nullptr, int ldsS = 0, int ldsL = 0) {
    const int chunk = lane & 7, run = lane >> 3; const int zc = zc0 + 8 * chunk, ch = zc - XOFF;
    const float* __restrict__ cw = a.in[I_MCONVW]; const float* __restrict__ cbp = a.in[I_MCONVB];
    if (first && l0 == 0 && run == 0) { raw[0] = (v4u){0u, 0u, 0u, 0u}; raw[1] = (v4u){0u, 0u, 0u, 0u}; raw[2] = (v4u){0u, 0u, 0u, 0u}; }
    float w[4][8], cb[8];
#pragma unroll
    for (int j = 0; j < 4; ++j) { const f32x4 t0 = *(const f32x4*)(cw + j * CONVD + ch), t1 = *(const f32x4*)(cw + j * CONVD + ch + 4);
        w[j][0] = t0.x; w[j][1] = t0.y; w[j][2] = t0.z; w[j][3] = t0.w; w[j][4] = t1.x; w[j][5] = t1.y; w[j][6] = t1.z; w[j][7] = t1.w; }
    { const f32x4 t0 = *(const f32x4*)(cbp + ch), t1 = *(const f32x4*)(cbp + ch + 4); cb[0] = t0.x; cb[1] = t0.y; cb[2] = t0.z; cb[3] = t0.w; cb[4] = t1.x; cb[5] = t1.y; cb[6] = t1.z; cb[7] = t1.w; }
    unsigned P[4][8];
#pragma unroll
    for (int rp = 0; rp < 4; ++rp) { float o[2][8];
#pragma unroll
        for (int rr = 0; rr < 2; ++rr) { const int r = 2 * rp + rr;
#pragma unroll
            for (int cx = 0; cx < 8; ++cx) o[rr][cx] = cb[cx];
#pragma unroll
            for (int j = 0; j < 4; ++j) { const v4u x = raw[r + j];
                const float xv[8] = {bflo(x.x), bfhi(x.x), bflo(x.y), bfhi(x.y), bflo(x.z), bfhi(x.z), bflo(x.w), bfhi(x.w)};
#pragma unroll
                for (int cx = 0; cx < 8; ++cx) o[rr][cx] += w[j][cx] * xv[cx]; }
#pragma unroll
            for (int cx = 0; cx < 8; ++cx) o[rr][cx] = silu_f(o[rr][cx]); }
#pragma unroll
        for (int cx = 0; cx < 8; ++cx) P[rp][cx] = pk2(o[0][cx], o[1][cx]); }
    if (outT) {
#pragma unroll
        for (int cx = 0; cx < 8; ++cx) { v4u t = {P[0][cx], P[1][cx], P[2][cx], P[3][cx]}; *(v4u*)(outT + (8 * chunk + cx) * 128 + l0 + 8 * run) = t; } }
    if (ldsS != 0) {
#pragma unroll
        for (int cx = 0; cx < 8; ++cx) { v4u t = {P[0][cx], P[1][cx], P[2][cx], P[3][cx]}; *(LAS v4u*)(ldsT + (8 * chunk + cx) * ldsS + ldsL + 8 * run) = t; } }
    if (outN) {
#pragma unroll
        for (int rp = 0; rp < 4; ++rp) { v4u e0, e1;
            e0.x = (P[rp][0] & 0xffffu) | (P[rp][1] << 16); e0.y = (P[rp][2] & 0xffffu) | (P[rp][3] << 16); e0.z = (P[rp][4] & 0xffffu) | (P[rp][5] << 16); e0.w = (P[rp][6] & 0xffffu) | (P[rp][7] << 16);
            e1.x = (P[rp][0] >> 16) | (P[rp][1] & 0xffff0000u); e1.y = (P[rp][2] >> 16) | (P[rp][3] & 0xffff0000u); e1.z = (P[rp][4] >> 16) | (P[rp][5] & 0xffff0000u); e1.w = (P[rp][6] >> 16) | (P[rp][7] & 0xffff0000u);
            *(v4u*)(outN + (l0 + 8 * run + 2 * rp) * 128 + 8 * chunk) = e0; *(v4u*)(outN + (l0 + 8 * run + 2 * rp + 1) * 128 + 8 * chunk) = e1; } }
}
__device__ __forceinline__ void head_scan(const float* __restrict__ DT, int tok0, int hh, float Ah, int lane, float& d0, float& d1, float& acs0, float& acs1, float& total) {
    d0 = DT[(size_t)(tok0 + 2 * lane) * 32 + hh]; d1 = DT[(size_t)(tok0 + 2 * lane + 1) * 32 + hh];
    const float a0 = d0 * Ah, a1 = a0 + d1 * Ah;
    float v = a1;
#pragma unroll
    for (int o = 1; o < 64; o <<= 1) { const float t = __shfl_up(v, o); if (lane >= o) v += t; }
    acs0 = v - a1 + a0; acs1 = v; total = __shfl(v, 63);
}
__device__ __forceinline__ void ssd_states(const Args& a, LAS unsigned char* lds, int tid, int wave, int lane) {
    unsigned char* ws = a.ws;
    const bf16* __restrict__ ZX = (const bf16*)(ws + WS_ZX); const float* __restrict__ DT = (const float*)(ws + WS_DT);
    bf16* ST = (bf16*)(ws + WS_ST); float* CDEC = (float*)(ws + WS_MISC + MISC_CDEC);
    bf16* XT = (bf16*)(ws + WS_XT); bf16* BT = (bf16*)(ws + WS_BT); bf16* BN = (bf16*)(ws + WS_BN); bf16* CN = (bf16*)(ws + WS_CN);
    LAS bf16* BTs = (LAS bf16*)(lds + 0);
    LAS bf16* XTs = (LAS bf16*)(lds + 34816 + wave * 9216);
    LAS float* WL = (LAS float*)(lds + 34816 + 8 * 9216 + wave * 512);
    const int fi = lane & 15, fq = lane >> 4;
    for (int u = (int)((blockIdx.x & 7) * (gridDim.x >> 3) + (blockIdx.x >> 3)); u < BATCH * NCH * NGRP; u += gridDim.x) {
        const int b = u >> 8, c = (u >> 2) & 63, g = u & 3; const int tok0 = b * SEQ + c * CHK; const bool first = (c == 0);
        const size_t cg = (size_t)((b * NCH + c) * NGRP + g);
        const int hh = 8 * g + wave; const float Ah = -__expf(a.in[I_MALOG][hh]);
        { float d0, d1, acs0, acs1, total; head_scan(DT, tok0, hh, Ah, lane, d0, d1, acs0, acs1, total);
            WL[2 * lane] = d0 * __expf(total - acs0); WL[2 * lane + 1] = d1 * __expf(total - acs1);
            if (lane == 0) CDEC[(b * NCH + c) * SH + hh] = __expf(total); }
        { const int rh = wave & 1, cb2 = (wave & 3) >> 1; const bool isC = wave >= 4;
            const int zc0 = (isC ? COFF : BOFF) + g * 128 + 64 * cb2;
            v4u raw[11]; conv_load(ZX, tok0, 64 * rh, zc0, lane, raw);
            conv_finish(a, first, 64 * rh, zc0, nullptr, (isC ? CN : BN) + cg * 16384 + 64 * cb2, lane, raw, BTs + (64 * cb2) * 136, isC ? 0 : 136, 64 * rh); }
        bf16x8 Xf[4][4];
        bf16* xtg = XT + ((size_t)((b * NCH + c) * SH + hh)) * 8192;
#pragma unroll
        for (int rh = 0; rh < 2; ++rh) {
            { v4u raw[11]; conv_load(ZX, tok0, 64 * rh, XOFF + hh * 64, lane, raw);
                conv_finish(a, first, 64 * rh, XOFF + hh * 64, xtg, nullptr, lane, raw, XTs, 72, 0); }
            LDS_WAIT(); asm volatile("" ::: "memory");
#pragma unroll
            for (int pt = 0; pt < 4; ++pt)
#pragma unroll
                for (int k2 = 0; k2 < 2; ++k2) { const int ll = 32 * k2 + 8 * fq, l0 = 64 * rh + ll; const v4u x = *(const LAS v4u*)(XTs + (16 * pt + fi) * 72 + ll);
                    const f32x4 s0 = *(const LAS f32x4*)(WL + l0), s1 = *(const LAS f32x4*)(WL + l0 + 4);
                    const float o[8] = {bflo(x.x) * s0.x, bfhi(x.x) * s0.y, bflo(x.y) * s0.z, bfhi(x.y) * s0.w, bflo(x.z) * s1.x, bfhi(x.z) * s1.y, bflo(x.w) * s1.z, bfhi(x.w) * s1.w};
                    Xf[pt][2 * rh + k2] = pack8(o); }
            LDS_WAIT(); asm volatile("" ::: "memory");
        }
        __syncthreads();
        bf16* stp = ST + ((size_t)((b * NCH + c) * SH + hh)) * 8192;
#pragma unroll 1
        for (int nh = 0; nh < 2; ++nh) {
            f32x4 acc[4][4];
#pragma unroll
            for (int n4 = 0; n4 < 4; ++n4)
#pragma unroll
                for (int pt = 0; pt < 4; ++pt) acc[n4][pt] = (f32x4){0.f, 0.f, 0.f, 0.f};
#pragma unroll
            for (int ks = 0; ks < 4; ++ks)
#pragma unroll
                for (int n4 = 0; n4 < 4; ++n4) { const bf16x8 af = *(const LAS bf16x8*)(BTs + (16 * (4 * nh + n4) + fi) * 136 + 32 * ks + 8 * fq);
#pragma unroll
                    for (int pt = 0; pt < 4; ++pt) acc[n4][pt] = MFMA16(af, Xf[pt][ks], acc[n4][pt]); }
#pragma unroll
            for (int n4 = 0; n4 < 4; ++n4)
#pragma unroll
                for (int pt = 0; pt < 4; ++pt) { v2u w; w.x = pk2(acc[n4][pt][0], acc[n4][pt][1]); w.y = pk2(acc[n4][pt][2], acc[n4][pt][3]);
                    *(v2u*)(stp + (16 * pt + fi) * 128 + 16 * (4 * nh + n4) + 4 * fq) = w; }
            asm volatile("" ::: "memory");
        }
        __syncthreads();
    }
}

__device__ __forceinline__ void ssd_scan(const Args& a, int tid) {
    unsigned char* ws = a.ws; bf16* ST = (bf16*)(ws + WS_ST); const float* CDEC = (const float*)(ws + WS_MISC + MISC_CDEC);
    for (int e4 = blockIdx.x * NTHR + tid; e4 < BATCH * SH * 2048; e4 += gridDim.x * NTHR) {
        const int b = e4 >> 16, rem = e4 & 65535, hh = rem >> 11, off = (rem & 2047) * 4;
        f32x4 h = {0.f, 0.f, 0.f, 0.f};
        bf16* p = ST + ((size_t)(b * NCH) * SH + hh) * 8192 + off;
        for (int c0 = 0; c0 < NCH; c0 += 8) { v2u s[8]; float dc[8];
#pragma unroll
            for (int j = 0; j < 8; ++j) { s[j] = *(const v2u*)(p + (size_t)(c0 + j) * SH * 8192); dc[j] = CDEC[(b * NCH + c0 + j) * SH + hh]; }
#pragma unroll
            for (int j = 0; j < 8; ++j) { v2u o; o.x = pk2(h.x, h.y); o.y = pk2(h.z, h.w); *(v2u*)(p + (size_t)(c0 + j) * SH * 8192) = o;
                const f32x4 sv = {bflo(s[j].x), bfhi(s[j].x), bflo(s[j].y), bfhi(s[j].y)}; h = h * dc[j] + sv; } }
    }
}

constexpr int S3_CC = 0, S3_BC = 34816, S3_CB = 69632, S3_TAB = 104448, S3_WV = 109568, S3_RMS = 117760, S3_END = 121856;
static_assert(S3_END <= RING_BYTES, "S3 LDS");
__device__ __forceinline__ void ssd_out(const Args& a, LAS unsigned char* lds, int tid, int wave, int lane) {
    unsigned char* ws = a.ws;
    const bf16* __restrict__ ZX = (const bf16*)(ws + WS_ZX); const float* __restrict__ DT = (const float*)(ws + WS_DT);
    const bf16* ST = (const bf16*)(ws + WS_ST); bf16* Y = (bf16*)(ws + WS_Y);
    LAS bf16* Cc = (LAS bf16*)(lds + S3_CC); LAS bf16* Bc = (LAS bf16*)(lds + S3_BC); LAS bf16* CB = (LAS bf16*)(lds + S3_CB);
    LAS float* ACS = (LAS float*)(lds + S3_WV + wave * 1024); LAS float* DTW = ACS + 128;
    LAS float* RMS = (LAS float*)(lds + S3_RMS);
    const int fi = lane & 15, fq = lane >> 4;
    const int u0 = (int)((blockIdx.x & 7) * (gridDim.x >> 3) + (blockIdx.x >> 3));
    v4u bcn[4], ccn[4];
#define S3_LOAD_BC(uu) do { const int b_ = (uu) >> 8, c_ = ((uu) >> 2) & 63, g_ = (uu) & 3; const size_t cg_ = (size_t)((b_ * NCH + c_) * NGRP + g_); \
        const bf16* bn_ = (const bf16*)(ws + WS_BN) + cg_ * 16384; const bf16* cn_ = (const bf16*)(ws + WS_CN) + cg_ * 16384; \
        _Pragma("unroll") for (int i = 0; i < 4; ++i) { const int idx = tid + NTHR * i, row = idx >> 4, c8 = (idx & 15) * 8; bcn[i] = *(const v4u*)(bn_ + row * 128 + c8); ccn[i] = *(const v4u*)(cn_ + row * 128 + c8); } } while (0)
    if (u0 < BATCH * NCH * NGRP) S3_LOAD_BC(u0);
    for (int u = u0; u < BATCH * NCH * NGRP; u += gridDim.x) {
        const int b = u >> 8, c = (u >> 2) & 63, g = u & 3; const int tok0 = b * SEQ + c * CHK;
        {
#pragma unroll
            for (int i = 0; i < 4; ++i) { const int idx = tid + NTHR * i, row = idx >> 4, c8 = (idx & 15) * 8;
                *(LAS v4u*)(Bc + row * 136 + c8) = bcn[i]; *(LAS v4u*)(Cc + row * 136 + c8) = ccn[i]; } }
        const int hh = 8 * g + wave; const float Ah = -__expf(a.in[I_MALOG][hh]); const float Dh = a.in[I_MD][hh];
        { float d0, d1, acs0, acs1, total; head_scan(DT, tok0, hh, Ah, lane, d0, d1, acs0, acs1, total);
            ACS[2 * lane] = acs0; ACS[2 * lane + 1] = acs1; DTW[2 * lane] = d0; DTW[2 * lane + 1] = d1; }
        bf16x8 Xf[4][4];
        { const bf16* xth = (const bf16*)(ws + WS_XT) + ((size_t)((b * NCH + c) * SH + hh)) * 8192;
#pragma unroll
            for (int pt = 0; pt < 4; ++pt)
#pragma unroll
                for (int ks = 0; ks < 4; ++ks) Xf[pt][ks] = *(const bf16x8*)(xth + (16 * pt + fi) * 128 + 32 * ks + 8 * fq); }
        __syncthreads();
        if (u + (int)gridDim.x < BATCH * NCH * NGRP) S3_LOAD_BC(u + (int)gridDim.x);
        { const int lt = wave;
#pragma unroll 1
            for (int st = 0; st < 8; ++st) { if (st <= lt) { f32x4 cacc = {0.f, 0.f, 0.f, 0.f};
#pragma unroll
                for (int kn = 0; kn < 4; ++kn) { const bf16x8 af = *(const LAS bf16x8*)(Bc + (16 * st + fi) * 136 + 32 * kn + 8 * fq), bfr = *(const LAS bf16x8*)(Cc + (16 * lt + fi) * 136 + 32 * kn + 8 * fq);
                    cacc = MFMA16(af, bfr, cacc); }
                v2u w; w.x = pk2(cacc[0], cacc[1]); w.y = pk2(cacc[2], cacc[3]);
                *(LAS v2u*)(CB + (16 * lt + fi) * 136 + 16 * st + 4 * fq) = w; } } }
        __syncthreads();
        const bf16* sth = ST + ((size_t)((b * NCH + c) * SH + hh)) * 8192;
        const float* __restrict__ ng = a.in[I_MNG];
#pragma unroll 1
        for (int lhi = 0; lhi < 4; ++lhi) {
            int lh = lhi; asm volatile("" : "+s"(lh));
            int fio = fi, fqo = fq; asm volatile("" : "+v"(fio), "+v"(fqo));
            f32x4 acc[4][2];
#pragma unroll
            for (int pt = 0; pt < 4; ++pt)
#pragma unroll
                for (int l4 = 0; l4 < 2; ++l4) acc[pt][l4] = (f32x4){0.f, 0.f, 0.f, 0.f};
            bf16x8 ah0[4], ah1[4];
#pragma unroll
            for (int pt = 0; pt < 4; ++pt) { ah0[pt] = *(const bf16x8*)(sth + (16 * pt + fio) * 128 + 8 * fqo); ah1[pt] = *(const bf16x8*)(sth + (16 * pt + fio) * 128 + 32 + 8 * fqo); }
#pragma unroll
            for (int kn = 0; kn < 4; ++kn) { bf16x8 bfr[2];
#pragma unroll
                for (int l4 = 0; l4 < 2; ++l4) bfr[l4] = *(const LAS bf16x8*)(Cc + (16 * (2 * lh + l4) + fio) * 136 + 32 * kn + 8 * fqo);
#pragma unroll
                for (int pt = 0; pt < 4; ++pt) { const bf16x8 ah = (kn & 1) ? ah1[pt] : ah0[pt];
#pragma unroll
                    for (int l4 = 0; l4 < 2; ++l4) acc[pt][l4] = MFMA16(ah, bfr[l4], acc[pt][l4]); }
                if (kn < 2) {
#pragma unroll
                    for (int pt = 0; pt < 4; ++pt) { const bf16x8 t = *(const bf16x8*)(sth + (16 * pt + fio) * 128 + 32 * (kn + 2) + 8 * fqo); if (kn & 1) ah1[pt] = t; else ah0[pt] = t; } }
                asm volatile("" ::: "memory"); }
#pragma unroll
            for (int l4 = 0; l4 < 2; ++l4) { const float ea = __expf(ACS[16 * (2 * lh + l4) + fio]);
#pragma unroll
                for (int pt = 0; pt < 4; ++pt) acc[pt][l4] *= ea; }
            v2u zq[2][4];
#pragma unroll
            for (int l4 = 0; l4 < 2; ++l4)
#pragma unroll
                for (int pt = 0; pt < 4; ++pt) zq[l4][pt] = *(const v2u*)(ZX + (size_t)(tok0 + 16 * (2 * lh + l4) + fio) * XW + hh * 64 + 16 * pt + 4 * fqo);
#pragma unroll
            for (int l4 = 0; l4 < 2; ++l4) { const int lt = 2 * lh + l4, l = 16 * lt + fio; const float al = ACS[l];
#pragma unroll
                for (int ks = 0; ks < 4; ++ks) { if (32 * ks <= 16 * lt + 15) { const int s0 = 32 * ks + 8 * fqo;
                    const v4u cb8 = *(const LAS v4u*)(CB + l * 136 + s0);
                    const f32x4 as0 = *(const LAS f32x4*)(ACS + s0), as1 = *(const LAS f32x4*)(ACS + s0 + 4), dt0 = *(const LAS f32x4*)(DTW + s0), dt1 = *(const LAS f32x4*)(DTW + s0 + 4);
                    const float cbv[8] = {bflo(cb8.x), bfhi(cb8.x), bflo(cb8.y), bfhi(cb8.y), bflo(cb8.z), bfhi(cb8.z), bflo(cb8.w), bfhi(cb8.w)};
                    const float asv[8] = {as0.x, as0.y, as0.z, as0.w, as1.x, as1.y, as1.z, as1.w}, dtv[8] = {dt0.x, dt0.y, dt0.z, dt0.w, dt1.x, dt1.y, dt1.z, dt1.w};
                    float mv[8];
#pragma unroll
                    for (int e = 0; e < 8; ++e) { const int s = s0 + e; float v = (s <= l) ? cbv[e] * __expf(al - asv[e]) * dtv[e] : 0.f; if (s == l) v += Dh; mv[e] = v; }
                    const bf16x8 mf = pack8(mv);
#pragma unroll
                    for (int pt = 0; pt < 4; ++pt) acc[pt][l4] = MFMA16(Xf[pt][ks], mf, acc[pt][l4]); asm volatile("" ::: "memory"); } } }
#pragma unroll
            for (int l4 = 0; l4 < 2; ++l4) { const int l = 16 * (2 * lh + l4) + fio; float ssq = 0.f;
#pragma unroll
                for (int pt = 0; pt < 4; ++pt) { const v2u z = zq[l4][pt];
                    const float zv[4] = {bflo(z.x), bfhi(z.x), bflo(z.y), bfhi(z.y)};
#pragma unroll
                    for (int r = 0; r < 4; ++r) { const float yv = acc[pt][l4][r] * silu_f(zv[r]); acc[pt][l4][r] = yv; ssq += yv * yv; } }
                ssq += __shfl_xor(ssq, 16); ssq += __shfl_xor(ssq, 32);
                if (fqo == 0) RMS[wave * 128 + l] = ssq; asm volatile("" ::: "memory"); }
            __syncthreads();
#pragma unroll
            for (int l4 = 0; l4 < 2; ++l4) { const int l = 16 * (2 * lh + l4) + fio; float tot = 0.f;
#pragma unroll
                for (int w = 0; w < 8; ++w) tot += RMS[w * 128 + l];
                const float rstd = rsq_f(tot * (1.0f / 512.0f) + EPS);
#pragma unroll
                for (int pt = 0; pt < 4; ++pt) { const int col = hh * 64 + 16 * pt + 4 * fqo; const f32x4 gv = *(const f32x4*)(ng + col);
                    v2u w; w.x = pk2(acc[pt][l4][0] * rstd * gv.x, acc[pt][l4][1] * rstd * gv.y); w.y = pk2(acc[pt][l4][2] * rstd * gv.z, acc[pt][l4][3] * rstd * gv.w);
                    *(v2u*)(Y + (size_t)(tok0 + l) * DI + col) = w; } }
        }
        __syncthreads();
    }
}

constexpr int AT_K = 0, AT_V = 36864, AT_TAB = 73728, AT_END = 75776;
__device__ __forceinline__ void attn_phase(const Args& a, LAS unsigned char* lds, int tid, int wave, int lane) {
    unsigned char* ws = a.ws;
    const bf16* __restrict__ QKV = (const bf16*)(ws + WS_QKV); bf16* AO = (bf16*)(ws + WS_AO);
    LAS bf16* Ks = (LAS bf16*)(lds + AT_K); LAS bf16* Vs = (LAS bf16*)(lds + AT_V); LAS float* TAB = (LAS float*)(lds + AT_TAB);
    const float* __restrict__ qg = a.in[I_AQNG]; const float* __restrict__ kg = a.in[I_AKNG];
    const int fi = lane & 15, fq = lane >> 4;
    const int u0 = (int)((blockIdx.x & 7) * (gridDim.x >> 3) + (blockIdx.x >> 3));
    v4u kxn[4], vxn[4];
#define AT_LOAD_KV(uu) do { const int b_ = (uu) >> 8, nb_ = ((uu) >> 2) & 63, g_ = (uu) & 3; const int key_ = tid >> 1, half_ = tid & 1; \
        const bf16* kp_ = QKV + (ptrdiff_t)(b_ * SEQ + nb_ * 128 - 128 + key_) * QKVW + 1024 + g_ * 64 + 32 * half_; \
        _Pragma("unroll") for (int j = 0; j < 4; ++j) { kxn[j] = *(const v4u*)(kp_ + 8 * j); vxn[j] = *(const v4u*)(kp_ + 256 + 8 * j); } } while (0)
    if (u0 < BATCH * 64 * KVH) AT_LOAD_KV(u0);
    for (int u = u0; u < BATCH * 64 * KVH; u += gridDim.x) {
        const int b = u >> 8, nb = (u >> 2) & 63, g = u & 3; const int tokq0 = b * SEQ + nb * 128;
        { const int key = tid >> 1, half = tid & 1; const bool valid = (nb > 0) || (key >= 128);
            v4u kx[4], vx[4];
            {
#pragma unroll
                for (int j = 0; j < 4; ++j) { kx[j] = kxn[j]; vx[j] = vxn[j]; }
                if (!valid) {
#pragma unroll
                    for (int j = 0; j < 4; ++j) { kx[j] = (v4u){0u, 0u, 0u, 0u}; vx[j] = (v4u){0u, 0u, 0u, 0u}; } } }
            float kf[32]; float ss = 0.f;
#pragma unroll
            for (int j = 0; j < 4; ++j) { kf[8 * j + 0] = bflo(kx[j].x); kf[8 * j + 1] = bfhi(kx[j].x); kf[8 * j + 2] = bflo(kx[j].y); kf[8 * j + 3] = bfhi(kx[j].y);
                kf[8 * j + 4] = bflo(kx[j].z); kf[8 * j + 5] = bfhi(kx[j].z); kf[8 * j + 6] = bflo(kx[j].w); kf[8 * j + 7] = bfhi(kx[j].w); }
#pragma unroll
            for (int e = 0; e < 32; ++e) ss += kf[e] * kf[e];
            ss += __shfl_xor(ss, 1);
            const float r = rsq_f(ss * (1.0f / 64.0f) + EPS);
#pragma unroll
            for (int j = 0; j < 4; ++j) { float o[8];
#pragma unroll
                for (int e = 0; e < 8; ++e) o[e] = kf[8 * j + e] * r * kg[32 * half + 8 * j + e];
                *(LAS bf16x8*)(Ks + key * 72 + 32 * half + 8 * j) = pack8(o);
                *(LAS v4u*)(Vs + key * 72 + 32 * half + 8 * j) = vx[j]; } }
        { const int r = tid >> 7, dist = tid & 127; int bucket;
            if (dist < 16) bucket = dist; else { bucket = 16 + (int)(logf((float)dist / 16.0f) / logf(8.0f) * 16.0f); bucket = bucket < 31 ? bucket : 31; }
            TAB[r * 128 + dist] = a.in[I_RELB][bucket * 16 + 4 * g + r]; }
        __syncthreads();
        if (u + (int)gridDim.x < BATCH * 64 * KVH) AT_LOAD_KV(u + (int)gridDim.x);
        const int r = wave >> 1, hf = wave & 1, h = 4 * g + r; const float sink = a.in[I_ASINK][h];
        for (int qt = 0; qt < 4; ++qt) {
            const int qi0 = 64 * hf + 16 * qt;
            bf16x8 Qf[2];
            { const bf16* qp = QKV + (size_t)(tokq0 + qi0 + fi) * QKVW + h * 64 + 8 * fq;
                const v4u q0 = *(const v4u*)qp, q1 = *(const v4u*)(qp + 32);
                float f0[8] = {bflo(q0.x), bfhi(q0.x), bflo(q0.y), bfhi(q0.y), bflo(q0.z), bfhi(q0.z), bflo(q0.w), bfhi(q0.w)};
                float f1[8] = {bflo(q1.x), bfhi(q1.x), bflo(q1.y), bfhi(q1.y), bflo(q1.z), bfhi(q1.z), bflo(q1.w), bfhi(q1.w)};
                float ss = 0.f;
#pragma unroll
                for (int e = 0; e < 8; ++e) ss += f0[e] * f0[e] + f1[e] * f1[e];
                ss += __shfl_xor(ss, 16); ss += __shfl_xor(ss, 32);
                const float rs = 0.125f * rsq_f(ss * (1.0f / 64.0f) + EPS);
#pragma unroll
                for (int e = 0; e < 8; ++e) { f0[e] *= rs * qg[8 * fq + e]; f1[e] *= rs * qg[32 + 8 * fq + e]; }
                Qf[0] = pack8(f0); Qf[1] = pack8(f1); }
            const int kt0 = (qi0 >> 4) < 6 ? (qi0 >> 4) : 6;
            f32x4 s[10];
#pragma unroll
            for (int kt = 0; kt < 10; ++kt) { const LAS bf16* kp = Ks + (16 * (kt0 + kt) + fi) * 72 + 8 * fq;
                f32x4 z = {0.f, 0.f, 0.f, 0.f};
                z = MFMA16(*(const LAS bf16x8*)kp, Qf[0], z); z = MFMA16(*(const LAS bf16x8*)(kp + 32), Qf[1], z); s[kt] = z; }
            const int qi = qi0 + fi; float mx = -__builtin_inff();
#pragma unroll
            for (int kt = 0; kt < 10; ++kt)
#pragma unroll
                for (int rr = 0; rr < 4; ++rr) { const int kj = 16 * (kt0 + kt) + 4 * fq + rr; const int dist = qi + 128 - kj;
                    const bool valid = (dist >= 0) && (dist < 128) && ((nb > 0) || (kj >= 128));
                    const float sc = valid ? s[kt][rr] + TAB[r * 128 + (dist & 127)] : -__builtin_inff();
                    s[kt][rr] = sc; mx = fmaxf(mx, sc); }
            mx = fmaxf(mx, __shfl_xor(mx, 16)); mx = fmaxf(mx, __shfl_xor(mx, 32)); mx = fmaxf(mx, sink);
            float sum = 0.f;
#pragma unroll
            for (int kt = 0; kt < 10; ++kt)
#pragma unroll
                for (int rr = 0; rr < 4; ++rr) { const float p = __expf(s[kt][rr] - mx); s[kt][rr] = p; sum += p; }
            sum += __shfl_xor(sum, 16); sum += __shfl_xor(sum, 32);
            const float inv = rcp_f(sum + __expf(sink - mx));
            f32x4 o[4];
#pragma unroll
            for (int dt = 0; dt < 4; ++dt) o[dt] = (f32x4){0.f, 0.f, 0.f, 0.f};
#pragma unroll
            for (int kk = 0; kk < 5; ++kk) {
                const float pv[8] = {s[2 * kk][0], s[2 * kk][1], s[2 * kk][2], s[2 * kk][3], s[2 * kk + 1][0], s[2 * kk + 1][1], s[2 * kk + 1][2], s[2 * kk + 1][3]};
                const bf16x8 pf = pack8(pv);
#pragma unroll
                for (int dt = 0; dt < 4; ++dt) {
                    const LAS bf16* vp0 = Vs + (16 * (kt0 + 2 * kk) + 4 * fq + (fi >> 2)) * 72 + 16 * dt + 4 * (fi & 3);
                    const v4i16_t t0 = __builtin_amdgcn_ds_read_tr16_b64_v4i16((LAS v4i16_t*)vp0);
                    const v4i16_t t1 = __builtin_amdgcn_ds_read_tr16_b64_v4i16((LAS v4i16_t*)(vp0 + 16 * 72));
                    const bf16x8 vf = {t0[0], t0[1], t0[2], t0[3], t1[0], t1[1], t1[2], t1[3]};
                    o[dt] = MFMA16(vf, pf, o[dt]); } }
            bf16* op = AO + (size_t)(tokq0 + qi) * 1024 + h * 64 + 4 * fq;
#pragma unroll
            for (int dt = 0; dt < 4; ++dt) { v2u w; w.x = pk2(o[dt][0] * inv, o[dt][1] * inv); w.y = pk2(o[dt][2] * inv, o[dt][3] * inv); *(v2u*)(op + 16 * dt) = w; }
        }
        __syncthreads();
    }
}

constexpr int NPHASE = 20;
constexpr int BG6_PER = 8, BG6 = 256 * BG6_PER;
constexpr int BGQ9 = 4, BGQ10 = 3, BGQ12 = 3;
__device__ __forceinline__ int bg_done9(int nt) { const int r = (nt * 8) & 255; return BG6 + (r ? (256 - r) * BGQ9 : 0); }
__device__ __forceinline__ int bg_done10(int nt) { const int r = (nt * 4) & 255; return bg_done9(nt) + (r ? (256 - r) * BGQ10 : 0); }
__global__ void __launch_bounds__(NTHR, 2) fwd_kernel(Args args) {
    extern __shared__ __attribute__((aligned(16))) unsigned char lds_raw[];
    LAS unsigned char* lds = (LAS unsigned char*)lds_raw;
    volatile LAS unsigned* MISC = (volatile LAS unsigned*)(lds + MISC_OFF);
    const int tid = threadIdx.x, lane = tid & 63, wave = __builtin_amdgcn_readfirstlane(tid >> 6);
    const int G = gridDim.x;
    unsigned char* ws = args.ws;
    gu32* ctl = (gu32*)(ws + WS_CTL);
    for (int u = tid; u < (LDS_BYTES - LDSCTL_OFF) / 4; u += NTHR) ((LAS unsigned*)(lds + LDSCTL_OFF))[u] = 0u;
    __syncthreads();
    XcdBarrier bar = xcd_barrier_post((unsigned*)(ctl + CW_BAR), MISC + 8);
    const int lo = args.ph_lo, hi = args.ph_hi;
    int nt_l0 = 256;
#ifndef PROBE_MASK
#define PROBE_MASK 0
#endif
#define PROBE_REP(k) ((int)(((unsigned)PROBE_MASK >> (k)) & 1u))
#define PHASE(k, ...) do { if (IN(k)) { __VA_ARGS__ } if (IN(k) && PROBE_REP(k)) { __VA_ARGS__ } } while (0)
#ifdef ONLYMASK
#define IN(k) (((ONLYMASK >> (k)) & 1) && lo <= (k) && (k) < hi)
#else
#define IN(k) (lo <= (k) && (k) < hi)
#endif
#define SEAM(k) do { if (IN(k) && IN((k) + 1)) xcd_barrier(bar); } while (0)
    bf16* H = (bf16*)(ws + WS_H);
    float* X1 = (float*)(ws + WS_X1); float* X2 = (float*)(ws + WS_X2); float* X3 = (float*)(ws + WS_X3);
    float* GATE = (float*)(ws + WS_MISC + MISC_GATE);
    const unsigned char* YK = (const unsigned char*)(ws + WS_YK);

    PHASE(0,  p0_prologue(args, lds, wave, lane); p0_quant(args, lds, wave, lane); ); SEAM(0);
    PHASE(1,
        { const int gid = blockIdx.x * NTHR + tid; if (gid < 8192) { const int l = gid >> 12, w = (gid >> 11) & 1, b = (gid >> 10) & 1, col = gid & 1023; GATE[gid] = modval(args, l, b, (w ? 5120 : 2048) + col); } }
        norm_phase<0, false, true>(args, lds, 0, 0, args.in[I_X], nullptr, nullptr, nullptr, args.in[I_MINW] + XW, IN_DIM, args.in[I_MDTB], tid, wave, lane);
    ); SEAM(1);
    PHASE(2,  const bool grpA_ = (((int)blockIdx.x >> 3) & 1) == 0;
        if (grpA_) bg_run(args, lds, (int)blockIdx.x, 12, 256, wave, lane, 0);
        pg8::Gemm g{H, (const bf16*)(ws + WS_WIN), T, XW, D}; pg8::StaticOrder S; S.init(T, XW, G, (int)blockIdx.x);
        pg8::EpiBf16Q E{(bf16*)(ws + WS_ZX), XW, (const float*)(ws + WS_H + HS_OFF), (const float*)(ws + WS_WSC + WSC_IN)};
        pg8::gemm_phase<pg8::EpiBf16Q, pg8::StaticOrder, true, true>(lds + RING_OFF, g, S, E, lds + EPIX_OFF);
        if (!grpA_) bg_run(args, lds, (int)blockIdx.x, 12, 256, wave, lane, 0); ); SEAM(2);
    PHASE(3,  ssd_states(args, lds, tid, wave, lane); ); SEAM(3);
    PHASE(4,  ssd_scan(args, tid); ); SEAM(4);
    PHASE(5,  ssd_out(args, lds, tid, wave, lane); ); SEAM(5);
    PHASE(6,  const bool grpA6_ = (((int)blockIdx.x >> 3) & 1) == 0;
        if (!grpA6_) bg_run(args, lds, (int)blockIdx.x, BG6_PER, 256, wave, lane, 32);
        pg8::Gemm g{(const bf16*)(ws + WS_Y), (const bf16*)(ws + WS_WOUT), T, D, DI}; pg8::StaticOrder S; S.init(T, D, G, (int)blockIdx.x);
        pg8::EpiResid E{args.in[I_X], X1, GATE + (0 * 2 + 0) * 2048};
        pg8::gemm_phase<pg8::EpiResid, pg8::StaticOrder, true, true>(lds + RING_OFF, g, S, E);
        if (grpA6_) bg_run(args, lds, (int)blockIdx.x, BG6_PER, 256, wave, lane, 32); ); SEAM(6);
#define MOE_PHASES(layer, pb, xres) \
    PHASE(pb,  norm_phase<1, false, true>(args, lds, layer, 1, xres, nullptr, nullptr, nullptr, args.in[I_RW] + (size_t)(layer) * 1024 * 32, 32, args.in[I_RB] + (layer) * 32, tid, wave, lane); ); SEAM(pb); \
    PHASE((pb) + 1,  moe_scatter(args, lds, tid, wave, lane); \
        if ((layer) == 1) { const int d_ = bg_done10(nt_l0) + 128 * BGQ12; bg_run(args, lds, d_ + (int)blockIdx.x, 16, 256, wave, lane); } ); SEAM((pb) + 1); \
    PHASE((pb) + 2,  load_tile_table(args, lds, tid); \
        const volatile LAS int* TE = (const volatile LAS int*)(lds + TE_OFF); \
        pg8::Gemm g{(const bf16*)(ws + WS_H), (const bf16*)(ws + WS_W1 + (size_t)(layer) * 32 * 2048 * 1024), CAP, 32 * 2048, D}; \
        pg8::MoeGatherOrder S{(int)TE[MAXTILES], 8, G, (int)((blockIdx.x & 7) * 32 + (blockIdx.x >> 3)), TE, (const int*)(ws + WS_XG), (LAS int*)(lds + ROWT_OFF)}; \
        pg8::EpiSwigluQ E{(unsigned char*)(ws + WS_ACT), args.in[I_EB1] + (size_t)(layer) * 32 * 2048, (const float*)(ws + WS_XG + XGS_OFF), (const float*)(ws + WS_WSC + WSC_W1) + (size_t)(layer) * 32 * 2048}; \
        pg8::gemm_phase<pg8::EpiSwigluQ, pg8::MoeGatherOrder, true, true>(lds + RING_OFF, g, S, E, lds + EPIX_OFF); \
        if ((layer) == 0) { const int nt_ = (int)TE[MAXTILES]; nt_l0 = nt_; const int r_ = (nt_ * 8) & 255, vc_ = (int)((blockIdx.x & 7) * 32 + (blockIdx.x >> 3)); if (r_ && vc_ >= r_) bg_run(args, lds, BG6 + (vc_ - r_) * BGQ9, BGQ9, 1, wave, lane); } ); SEAM((pb) + 2); \
    PHASE((pb) + 3,  load_tile_table(args, lds, tid); \
        const volatile LAS int* TE = (const volatile LAS int*)(lds + TE_OFF); \
        pg8::Gemm g{(const bf16*)(ws + WS_ACT), (const bf16*)(ws + WS_W2 + (size_t)(layer) * 32 * 1024 * 1024), CAP, 32 * 1024, FF}; \
        pg8::MoeOrder S{(int)TE[MAXTILES], 4, G, (int)((blockIdx.x & 7) * 32 + (blockIdx.x >> 3)), TE, nullptr, nullptr}; \
        pg8::EpiMoeOutF8 E{(unsigned char*)(ws + WS_YK), args.in[I_EB2] + (size_t)(layer) * 32 * 1024, (const float*)(ws + WS_WSC + WSC_W2) + (size_t)(layer) * 32 * 1024, (const int*)(ws + WS_SRT), (const float*)(ws + WS_SRT + 524288)}; \
        pg8::gemm_phase<pg8::EpiMoeOutF8, pg8::MoeOrder, true, true>(lds + RING_OFF, g, S, E, lds + EPIX_OFF); \
        if ((layer) == 0) { const int nt_ = (int)TE[MAXTILES]; const int r_ = (nt_ * 4) & 255, vc_ = (int)((blockIdx.x & 7) * 32 + (blockIdx.x >> 3)); if (r_ && vc_ >= r_) bg_run(args, lds, bg_done9(nt_) + (vc_ - r_) * BGQ10, BGQ10, 1, wave, lane); } ); SEAM((pb) + 3);

    MOE_PHASES(0, 7, X1)
    PHASE(11,  norm_phase<2, true, true>(args, lds, 1, 0, X1, GATE + (0 * 2 + 1) * 2048, YK, X2, nullptr, 0, nullptr, tid, wave, lane); ); SEAM(11);
    PHASE(12,  pg8::Gemm g{H, (const bf16*)(ws + WS_WQKV), T, QKVW, D}; pg8::StaticOrder S; S.init(T, QKVW, G, (int)blockIdx.x);
        pg8::EpiBf16Q E{(bf16*)(ws + WS_QKV), QKVW, (const float*)(ws + WS_H + HS_OFF), (const float*)(ws + WS_WSC + WSC_QKV)};
        pg8::gemm_phase<pg8::EpiBf16Q, pg8::StaticOrder, true, true>(lds + RING_OFF, g, S, E, lds + EPIX_OFF);
        if ((int)blockIdx.x >= 128) bg_run(args, lds, bg_done10(nt_l0) + ((int)blockIdx.x - 128) * BGQ12, BGQ12, 1, wave, lane); ); SEAM(12);
    PHASE(13,  attn_phase(args, lds, tid, wave, lane); ); SEAM(13);
    PHASE(14,  pg8::Gemm g{(const bf16*)(ws + WS_AO), (const bf16*)(ws + WS_WAO), T, D, D}; pg8::StaticOrder S; S.init(T, D, G, (int)blockIdx.x);
        pg8::EpiResid E{X2, X3, GATE + (1 * 2 + 0) * 2048};
        pg8::gemm_phase<pg8::EpiResid, pg8::StaticOrder, true, true>(lds + RING_OFF, g, S, E); ); SEAM(14);
    MOE_PHASES(1, 15, X3)
    PHASE(19,  norm_phase<2, true, false>(args, lds, 1, 0, X3, GATE + (1 * 2 + 1) * 2048, YK, args.out, nullptr, 0, nullptr, tid, wave, lane); );
#undef MOE_PHASES
#undef IN
#undef SEAM
}

extern "C" void kernel_launch(void* const* d_in, const int* in_sizes, int n_in, void* d_out, int out_size, void* d_ws, size_t ws_size, hipStream_t stream) {
    static int grid = 0;
    if (grid == 0) {
        if (n_in != 26 || in_sizes[0] != T * D || out_size != T * D || ws_size < WS_END) { fprintf(stderr, "kernel_launch: unexpected shapes (n_in %d, in0 %d, out %d, ws %zu)\n", n_in, n_in > 0 ? in_sizes[0] : -1, out_size, ws_size); grid = -1; return; }
        if (hipFuncSetAttribute((const void*)fwd_kernel, hipFuncAttributeMaxDynamicSharedMemorySize, LDS_BYTES) != hipSuccess) { fprintf(stderr, "kernel_launch: hipFuncSetAttribute failed\n"); grid = -1; return; }
        int per_cu = 0;
        if (hipOccupancyMaxActiveBlocksPerMultiprocessor(&per_cu, (const void*)fwd_kernel, NTHR, LDS_BYTES) != hipSuccess || per_cu < 1) fprintf(stderr, "kernel_launch: occupancy query reports %d\n", per_cu);
        (void)hipGetLastError();
        grid = 256;
    }
    if (grid < 0) return;
    if (hipMemsetAsync((char*)d_ws + WS_CTL, 0, CTL_ZERO_BYTES, stream) != hipSuccess) { fprintf(stderr, "kernel_launch: memset failed\n"); return; }
    Args a{};
    for (int i = 0; i < 26; ++i) a.in[i] = (const float*)d_in[i];
    a.out = (float*)d_out; a.ws = (unsigned char*)d_ws;
#ifndef MK_SPLIT
    a.ph_lo = 0; a.ph_hi = NPHASE;
    hipLaunchKernelGGL(fwd_kernel, dim3(grid), dim3(NTHR), LDS_BYTES, stream, a);
#else
    for (int p = 0; p < NPHASE; ++p) { a.ph_lo = p; a.ph_hi = p + 1; hipLaunchKernelGGL(fwd_kernel, dim3(grid), dim3(NTHR), LDS_BYTES, stream, a); }
#endif
}
```

```cpp
#include <hip/hip_runtime.h>
#include <cstdio>
#include <cstdint>

#define GAS __attribute__((address_space(1)))
#define LAS __attribute__((address_space(3)))
typedef unsigned short bf16;
typedef unsigned v4u __attribute__((ext_vector_type(4)));
typedef unsigned v2u __attribute__((ext_vector_type(2)));
typedef float f32x4 __attribute__((ext_vector_type(4)));
typedef short bf16x8 __attribute__((ext_vector_type(8)));
typedef short v4i16_t __attribute__((ext_vector_type(4)));
typedef GAS unsigned gu32;

namespace pg8 {
#define PG8_LAS __attribute__((address_space(3)))
typedef unsigned short bf16_t;
typedef unsigned u32x4 __attribute__((ext_vector_type(4)));
typedef int i32x4 __attribute__((ext_vector_type(4)));
constexpr int BM = 256, BK = 64, HALF = 128, HTB = HALF * BK * 2, STAGE_BYTES = 8 * HTB, NXCD = 8, WGM = 8;
__host__ __device__ __forceinline__ int lds_byte(int r, int c) { const int st = (r >> 4) * 2 + (c >> 5), rr = r & 15, cc = c & 31, ob = rr * 64 + cc * 2; return st * 1024 + (ob ^ (((ob >> 9) & 1) << 5)); }
__host__ __device__ __forceinline__ void stage_rc(int b, int& R, int& C) { const int st = b / 1024, sb = b % 1024, swz = sb ^ (((sb >> 9) & 1) << 5); R = (st >> 1) * 16 + swz / 64; C = (st & 1) * 32 + (swz % 64) / 2; }
__host__ __device__ __forceinline__ int perm32(int rho) { const int n = rho >> 4, i = rho & 15; return 8 * (i >> 2) + 4 * n + (i & 3); }
struct Unit { int pm, pn; };
struct Gemm { const bf16_t* A; const bf16_t* Bt; int M, N, K; };
struct StaticOrder {
    int nM, nN, nwg, G, c;
    __host__ __device__ void init(int M, int N, int G_, int c_) { nM = M / BM; nN = N / BM; nwg = nM * nN; G = G_; c = c_; }
    __host__ __device__ bool next(int i, Unit& u) const {
        const long L = (long)i * G + c; if (L >= nwg) return false;
        int wgid = (int)L; { const int q = nwg / NXCD, r = nwg % NXCD, xcd = wgid % NXCD, off = wgid / NXCD; wgid = (xcd < r ? xcd * (q + 1) : r * (q + 1) + (xcd - r) * q) + off; }
        const int nig = WGM * nN, gid = wgid / nig, fm = gid * WGM, gsz = (nM - fm) < WGM ? (nM - fm) : WGM;
        u.pm = fm + ((wgid % nig) % gsz); u.pn = (wgid % nig) / gsz; return true;
    }
    static constexpr bool GATHER = false; const int* rowoff = nullptr; PG8_LAS int* rowt = nullptr;
    __device__ __forceinline__ void a_ready(const Unit&) const {}
    __device__ __forceinline__ void done(const Unit&) const {}
};
template <bool GATHER_> struct MoeOrderT {
    static constexpr bool GATHER = GATHER_;
    int ntiles, NT, G, c; const volatile PG8_LAS int* te; const int* rowoff; PG8_LAS int* rowt;
    __device__ bool next(int i, Unit& u) const {
        const int L = i * G + c; if (L >= ntiles * NT) return false;
        const int tile = L / NT, n = L % NT; const int e = __builtin_amdgcn_readfirstlane(te[tile]);
        u.pm = tile; u.pn = e * NT + n; return true;
    }
    __device__ __forceinline__ void a_ready(const Unit&) const {}
    __device__ __forceinline__ void done(const Unit&) const {}
};
typedef MoeOrderT<false> MoeOrder; typedef MoeOrderT<true> MoeGatherOrder;
__device__ __forceinline__ unsigned cvt_pk_bf16(float lo, float hi) { unsigned r; asm volatile("v_cvt_pk_bf16_f32 %0, %1, %2" : "=v"(r) : "v"(lo), "v"(hi)); return r; }

struct EpiBf16 {
    static constexpr int NSTAGE = 0; __device__ __forceinline__ const void* stage_src(int, const Unit&) const { return nullptr; }
    static constexpr bool PERM = true, AFTER_DRAIN = false; static constexpr int MODE = 0; typedef f32x4 acc_t;
    bf16_t* O; int ldc;
    __device__ __forceinline__ void operator()(const f32x4 (&acc)[2][2][4][2], const Unit& u, int wr, int wc, int fr, int fq, const PG8_LAS unsigned char* xl) const {
        const int row0 = u.pm * BM + wr * 64 + fr, col0 = u.pn * BM + wc * 32 + 8 * fq;
#pragma unroll
        for (int ai = 0; ai < 2; ++ai)
#pragma unroll
            for (int m = 0; m < 4; ++m) { bf16_t* rowp = O + (size_t)(row0 + ai * HALF + m * 16) * ldc + col0;
#pragma unroll
                for (int bj = 0; bj < 2; ++bj) { const f32x4 v0 = acc[ai][bj][m][0], v1 = acc[ai][bj][m][1];
                    u32x4 w; w.x = cvt_pk_bf16(v0[0], v0[1]); w.y = cvt_pk_bf16(v0[2], v0[3]); w.z = cvt_pk_bf16(v1[0], v1[1]); w.w = cvt_pk_bf16(v1[2], v1[3]);
                    *(u32x4*)(rowp + bj * HALF) = w; } }
    }
};
struct EpiResid {
    static constexpr int NSTAGE = 0; __device__ __forceinline__ const void* stage_src(int, const Unit&) const { return nullptr; }
    static constexpr bool PERM = true, AFTER_DRAIN = false; static constexpr int MODE = 0; typedef f32x4 acc_t;
    const float* res; float* out; const float* gate;
    __device__ __forceinline__ void operator()(const f32x4 (&acc)[2][2][4][2], const Unit& u, int wr, int wc, int fr, int fq, const PG8_LAS unsigned char* xl) const {
        const int row0 = u.pm * BM + wr * 64 + fr, col0 = u.pn * BM + wc * 32 + 8 * fq; const int b = (u.pm * BM) >> 13;
        f32x4 gv[2][2];
#pragma unroll
        for (int bj = 0; bj < 2; ++bj)
#pragma unroll
            for (int n = 0; n < 2; ++n) gv[bj][n] = *(const f32x4*)(gate + b * 1024 + col0 + bj * HALF + 4 * n);
#pragma unroll
        for (int ai = 0; ai < 2; ++ai)
#pragma unroll
            for (int m = 0; m < 4; ++m) { const size_t off = (size_t)(row0 + ai * HALF + m * 16) * 1024 + col0;
#pragma unroll
                for (int bj = 0; bj < 2; ++bj)
#pragma unroll
                    for (int n = 0; n < 2; ++n) { const f32x4 r4 = *(const f32x4*)(res + off + bj * HALF + 4 * n);
                        *(f32x4*)(out + off + bj * HALF + 4 * n) = r4 + gv[bj][n] * acc[ai][bj][m][n]; } }
    }
};
struct EpiSwiglu {
    static constexpr int NSTAGE = 0; __device__ __forceinline__ const void* stage_src(int, const Unit&) const { return nullptr; }
    static constexpr bool PERM = true, AFTER_DRAIN = false; static constexpr int MODE = 0; typedef f32x4 acc_t;
    bf16_t* act; const float* b1;
    __device__ __forceinline__ void operator()(const f32x4 (&acc)[2][2][4][2], const Unit& u, int wr, int wc, int fr, int fq, const PG8_LAS unsigned char* xl) const {
        const int row0 = u.pm * BM + wr * 64 + fr; const int e = u.pn >> 3, ntile = u.pn & 7;
        const int c0 = ntile * BM + wc * 32 + 8 * fq;
        f32x4 bv[2][2];
#pragma unroll
        for (int bj = 0; bj < 2; ++bj)
#pragma unroll
            for (int n = 0; n < 2; ++n) bv[bj][n] = *(const f32x4*)(b1 + e * 2048 + c0 + bj * HALF + 4 * n);
#pragma unroll
        for (int ai = 0; ai < 2; ++ai)
#pragma unroll
            for (int m = 0; m < 4; ++m) { bf16_t* rowp = act + (size_t)(row0 + ai * HALF + m * 16) * 1024 + (c0 >> 1);
#pragma unroll
                for (int bj = 0; bj < 2; ++bj) { const f32x4 v0 = acc[ai][bj][m][0] + bv[bj][0], v1 = acc[ai][bj][m][1] + bv[bj][1];
                    float o[4];
                    const float g[4] = {v0[0], v0[2], v1[0], v1[2]}, l[4] = {v0[1], v0[3], v1[1], v1[3]};
#pragma unroll
                    for (int t = 0; t < 4; ++t) { const float xg = fminf(g[t], 7.0f), xl = fminf(fmaxf(l[t], -7.0f), 7.0f);
                        o[t] = xg * __builtin_amdgcn_rcpf(1.0f + __expf(-1.702f * xg)) * (xl + 1.0f); }
                    v2u w; w.x = cvt_pk_bf16(o[0], o[1]); w.y = cvt_pk_bf16(o[2], o[3]);
                    *(v2u*)(rowp + bj * (HALF / 2)) = w; } }
    }
};
struct EpiMoeOut {
    static constexpr int NSTAGE = 0; __device__ __forceinline__ const void* stage_src(int, const Unit&) const { return nullptr; }
    static constexpr bool PERM = true, AFTER_DRAIN = false; static constexpr int MODE = 0; typedef f32x4 acc_t;
    bf16_t* yk; const float* b2; const int* srt_tok; const float* srt_gate;
    __device__ __forceinline__ void operator()(const f32x4 (&acc)[2][2][4][2], const Unit& u, int wr, int wc, int fr, int fq, const PG8_LAS unsigned char* xl) const {
        const int row0 = u.pm * BM + wr * 64 + fr; const int e = u.pn >> 2, ntile = u.pn & 3;
        const int c0 = ntile * BM + wc * 32 + 8 * fq;
        f32x4 bv[2][2];
#pragma unroll
        for (int bj = 0; bj < 2; ++bj)
#pragma unroll
            for (int n = 0; n < 2; ++n) bv[bj][n] = *(const f32x4*)(b2 + e * 1024 + c0 + bj * HALF + 4 * n);
#pragma unroll
        for (int ai = 0; ai < 2; ++ai)
#pragma unroll
            for (int m = 0; m < 4; ++m) { const int pos = row0 + ai * HALF + m * 16; const int id = srt_tok[pos]; const float gt = srt_gate[pos];
                if (id >= 0) { bf16_t* rowp = yk + (size_t)id * 1024 + c0;
#pragma unroll
                    for (int bj = 0; bj < 2; ++bj) { const f32x4 v0 = (acc[ai][bj][m][0] + bv[bj][0]) * gt, v1 = (acc[ai][bj][m][1] + bv[bj][1]) * gt;
                        u32x4 w; w.x = cvt_pk_bf16(v0[0], v0[1]); w.y = cvt_pk_bf16(v0[2], v0[3]); w.z = cvt_pk_bf16(v1[0], v1[1]); w.w = cvt_pk_bf16(v1[2], v1[3]);
                        *(u32x4*)(rowp + bj * HALF) = w; } } }
    }
};

struct EpiBf16Q {
    static constexpr bool PERM = true, AFTER_DRAIN = false; static constexpr int MODE = 1; typedef i32x4 acc_t;
    bf16_t* O; int ldc; const float* sa; const float* sb;
    static constexpr int NSTAGE = 2; __device__ __forceinline__ const void* stage_src(int k, const Unit& u) const { return k == 0 ? (const void*)(sa + u.pm * BM) : (const void*)(sb + u.pn * BM); }
    __device__ __forceinline__ void operator()(const i32x4 (&acc)[2][2][4][2], const Unit& u, int wr, int wc, int fr, int fq, const PG8_LAS unsigned char* xl) const {
        const int row0 = u.pm * BM + wr * 64 + fr, col0 = u.pn * BM + wc * 32 + 8 * fq;
        f32x4 sv[2][2];
#pragma unroll
        for (int bj = 0; bj < 2; ++bj)
#pragma unroll
            for (int n = 0; n < 2; ++n) sv[bj][n] = *(const PG8_LAS f32x4*)(xl + 1024 + (wc * 32 + 8 * fq + bj * HALF + 4 * n) * 4);
#pragma unroll
        for (int ai = 0; ai < 2; ++ai)
#pragma unroll
            for (int m = 0; m < 4; ++m) { const int row = row0 + ai * HALF + m * 16; const float s = *(const PG8_LAS float*)(xl + (wr * 64 + fr + ai * HALF + m * 16) * 4); bf16_t* rowp = O + (size_t)row * ldc + col0;
#pragma unroll
                for (int bj = 0; bj < 2; ++bj) { const f32x4 v0 = __builtin_convertvector(acc[ai][bj][m][0], f32x4) * (sv[bj][0] * s), v1 = __builtin_convertvector(acc[ai][bj][m][1], f32x4) * (sv[bj][1] * s);
                    u32x4 w; w.x = cvt_pk_bf16(v0[0], v0[1]); w.y = cvt_pk_bf16(v0[2], v0[3]); w.z = cvt_pk_bf16(v1[0], v1[1]); w.w = cvt_pk_bf16(v1[2], v1[3]);
                    *(u32x4*)(rowp + bj * HALF) = w; } }
    }
};
__device__ __forceinline__ void xpose4(unsigned& r0, unsigned& r1, unsigned& r2, unsigned& r3) {
    { const auto t = __builtin_amdgcn_permlane32_swap(r0, r2, false, false); r0 = t[0]; r2 = t[1]; }
    { const auto t = __builtin_amdgcn_permlane32_swap(r1, r3, false, false); r1 = t[0]; r3 = t[1]; }
    { const auto t = __builtin_amdgcn_permlane16_swap(r0, r1, false, false); r0 = t[0]; r1 = t[1]; }
    { const auto t = __builtin_amdgcn_permlane16_swap(r2, r3, false, false); r2 = t[0]; r3 = t[1]; }
}
struct EpiSwigluQ {
    static constexpr bool PERM = true, AFTER_DRAIN = false; static constexpr int MODE = 1; typedef i32x4 acc_t;
    unsigned char* act; const float* b1; const float* sa; const float* sb;
    static constexpr int NSTAGE = 3;
    __device__ __forceinline__ const void* stage_src(int k, const Unit& u) const { const int e = u.pn >> 3, ntile = u.pn & 7;
        return k == 0 ? (const void*)(sa + u.pm * BM) : (k == 1 ? (const void*)(b1 + e * 2048 + ntile * BM) : (const void*)(sb + e * 2048 + ntile * BM)); }
    __device__ __forceinline__ void operator()(const i32x4 (&acc)[2][2][4][2], const Unit& u, int wr, int wc, int fr, int fq, const PG8_LAS unsigned char* xl) const {
        const int row0 = u.pm * BM + wr * 64 + fr; const int e = u.pn >> 3, ntile = u.pn & 7;
        const int c0 = ntile * BM + wc * 32 + 8 * fq;
        f32x4 bv[2][2], sv[2][2];
#pragma unroll
        for (int bj = 0; bj < 2; ++bj)
#pragma unroll
            for (int n = 0; n < 2; ++n) { const int cl = (wc * 32 + 8 * fq + bj * HALF + 4 * n) * 4; bv[bj][n] = *(const PG8_LAS f32x4*)(xl + 1024 + cl); sv[bj][n] = *(const PG8_LAS f32x4*)(xl + 2048 + cl); }
#pragma unroll
        for (int ai = 0; ai < 2; ++ai) { unsigned w4[2][4];
#pragma unroll
            for (int m = 0; m < 4; ++m) { const float s = *(const PG8_LAS float*)(xl + (wr * 64 + fr + ai * HALF + m * 16) * 4);
#pragma unroll
                for (int bj = 0; bj < 2; ++bj) { const f32x4 v0 = __builtin_convertvector(acc[ai][bj][m][0], f32x4) * (sv[bj][0] * s) + bv[bj][0], v1 = __builtin_convertvector(acc[ai][bj][m][1], f32x4) * (sv[bj][1] * s) + bv[bj][1];
                    float o[4];
                    const float g[4] = {v0[0], v0[2], v1[0], v1[2]}, l[4] = {v0[1], v0[3], v1[1], v1[3]};
#pragma unroll
                    for (int t = 0; t < 4; ++t) { const float xg = fminf(g[t], 7.0f), xl = fminf(fmaxf(l[t], -7.0f), 7.0f);
                        const float tg = xg * __builtin_amdgcn_rcpf(1.0f + __builtin_amdgcn_exp2f(xg * -2.4554669595930156f)); o[t] = __builtin_fmaf(tg, xl, tg); }
                    int w = __builtin_amdgcn_cvt_pk_fp8_f32(o[0], o[1], 0, false); w = __builtin_amdgcn_cvt_pk_fp8_f32(o[2], o[3], w, true);
                    w4[bj][m] = (unsigned)w; } }
            unsigned char* rowp = act + (size_t)(row0 + ai * HALF + 16 * fq) * 1024 + ((ntile * BM + wc * 32) >> 1);
#pragma unroll
            for (int bj = 0; bj < 2; ++bj) { xpose4(w4[bj][0], w4[bj][1], w4[bj][2], w4[bj][3]);
                u32x4 o4; o4.x = w4[bj][0]; o4.y = w4[bj][1]; o4.z = w4[bj][2]; o4.w = w4[bj][3];
                *(u32x4*)(rowp + bj * (HALF / 2)) = o4; } }
    }
};
struct EpiMoeOutF8 {
    static constexpr bool PERM = true, AFTER_DRAIN = false; static constexpr int MODE = 2; typedef f32x4 acc_t;
    unsigned char* yk; const float* b2; const float* sb; const int* srt_tok; const float* srt_gate;
    static constexpr int NSTAGE = 4;
    __device__ __forceinline__ const void* stage_src(int k, const Unit& u) const { const int e = u.pn >> 2, ntile = u.pn & 3;
        return k == 0 ? (const void*)(b2 + e * 1024 + ntile * BM) : (k == 1 ? (const void*)(sb + e * 1024 + ntile * BM) : (k == 2 ? (const void*)(srt_tok + u.pm * BM) : (const void*)(srt_gate + u.pm * BM))); }
    __device__ __forceinline__ void operator()(const f32x4 (&acc)[2][2][4][2], const Unit& u, int wr, int wc, int fr, int fq, const PG8_LAS unsigned char* xl) const {
        const int row0 = u.pm * BM + wr * 64 + fr; const int e = u.pn >> 2, ntile = u.pn & 3;
        const int c0 = ntile * BM + wc * 32 + 8 * fq;
#pragma unroll
        for (int bj = 0; bj < 2; ++bj) { f32x4 bv[2], sv[2];
#pragma unroll
            for (int n = 0; n < 2; ++n) { const int cl = (wc * 32 + 8 * fq + bj * HALF + 4 * n) * 4; bv[n] = *(const PG8_LAS f32x4*)(xl + cl); sv[n] = *(const PG8_LAS f32x4*)(xl + 1024 + cl); }
#pragma unroll
            for (int ai = 0; ai < 2; ++ai)
#pragma unroll
                for (int m = 0; m < 4; ++m) { const int rl = (wr * 64 + fr + ai * HALF + m * 16) * 4; const int id = *(const PG8_LAS int*)(xl + 2048 + rl); const float gt = *(const PG8_LAS float*)(xl + 3072 + rl);
                    if (id >= 0) { const f32x4 v0 = (acc[ai][bj][m][0] * sv[0] + bv[0]) * gt, v1 = (acc[ai][bj][m][1] * sv[1] + bv[1]) * gt;
                        int w0 = __builtin_amdgcn_cvt_pk_fp8_f32(v0[0], v0[1], 0, false); w0 = __builtin_amdgcn_cvt_pk_fp8_f32(v0[2], v0[3], w0, true);
                        int w1 = __builtin_amdgcn_cvt_pk_fp8_f32(v1[0], v1[1], 0, false); w1 = __builtin_amdgcn_cvt_pk_fp8_f32(v1[2], v1[3], w1, true);
                        v2u w; w.x = (unsigned)w0; w.y = (unsigned)w1;
                        *(v2u*)(yk + (size_t)id * 1024 + c0 + bj * HALF) = w; } }
            asm volatile("" ::: "memory"); }
    }
};


typedef int i32x8 __attribute__((ext_vector_type(8)));
struct Frag2 { bf16x8 h[2]; };
template <int MODE> struct FragOps { typedef Frag2 frag_t;
    static __device__ __forceinline__ Frag2 load(const PG8_LAS unsigned char* p) { Frag2 f; f.h[0] = *(const PG8_LAS bf16x8*)p; f.h[1] = *(const PG8_LAS bf16x8*)(p + 1024); return f; } };
template <> struct FragOps<2> { typedef i32x8 frag_t;
    static __device__ __forceinline__ i32x8 load(const PG8_LAS unsigned char* p) { const i32x4 lo = *(const PG8_LAS i32x4*)p, hi = *(const PG8_LAS i32x4*)(p + 1024); return __builtin_shufflevector(lo, hi, 0, 1, 2, 3, 4, 5, 6, 7); } };
template <int MODE> struct Mma;
template <> struct Mma<0> { static __device__ __forceinline__ f32x4 run(const Frag2& a, const Frag2& b, f32x4 c) { c = __builtin_amdgcn_mfma_f32_16x16x32_bf16(a.h[0], b.h[0], c, 0, 0, 0); return __builtin_amdgcn_mfma_f32_16x16x32_bf16(a.h[1], b.h[1], c, 0, 0, 0); } };
template <> struct Mma<1> { static __device__ __forceinline__ i32x4 run(const Frag2& a, const Frag2& b, i32x4 c) { c = __builtin_amdgcn_mfma_i32_16x16x64_i8(__builtin_bit_cast(i32x4, a.h[0]), __builtin_bit_cast(i32x4, b.h[0]), c, 0, 0, 0);
        return __builtin_amdgcn_mfma_i32_16x16x64_i8(__builtin_bit_cast(i32x4, a.h[1]), __builtin_bit_cast(i32x4, b.h[1]), c, 0, 0, 0); } };
template <> struct Mma<2> { static __device__ __forceinline__ f32x4 run(const i32x8& a, const i32x8& b, f32x4 c) {
        asm volatile("v_mfma_scale_f32_16x16x128_f8f6f4 %0, %1, %2, %0, %3, %3 op_sel_hi:[0,0,0]" : "+v"(c) : "v"(a), "v"(b), "v"(0x7F7F7F7F)); return c; } };

template <class Epi, class Sched, bool ALIGN_EPI = false, bool SP2 = false>
__device__ __forceinline__ void gemm_phase(PG8_LAS unsigned char* lds, const Gemm g, const Sched& S, const Epi& E, PG8_LAS unsigned char* xlds = nullptr) {
    const int tid = threadIdx.x, wid = __builtin_amdgcn_readfirstlane(tid >> 6), lane = tid & 63, wr = wid >> 2, wc = wid & 3, fr = lane & 15, fq = lane >> 4;
    constexpr int MODE = Epi::MODE; typedef typename Epi::acc_t acc_t;
    const int rowb = MODE ? g.K : g.K * 2, nt = rowb / (BK * 2);
    unsigned voffA[2], voffB[2];
#pragma unroll
    for (int i = 0; i < 2; ++i) { int R, C; stage_rc(tid * 16 + i * 8192, R, C); const int Rb = Epi::PERM ? ((R & ~31) + perm32(R & 31)) : R;
        voffA[i] = (unsigned)(R * rowb + C * 2); voffB[i] = (unsigned)(Rb * rowb + C * 2); }
    const size_t kstep = (size_t)(BK * 2);
    const size_t hstep = (size_t)HALF * rowb;
    const size_t tstep = 2 * hstep;
    const unsigned ldsw = (unsigned)wid * 1024u;
    const int aoff = lds_byte(wr * 64 + fr, fq * 8), boff = lds_byte(wc * 32 + fr, fq * 8);
    constexpr bool GATHER = Sched::GATHER;
    int gR[2]; unsigned gC[2]; unsigned gA[2][2], gN[2][2];
#pragma unroll
    for (int i = 0; i < 2; ++i) { int R, C; stage_rc(tid * 16 + i * 8192, R, C); gR[i] = R; gC[i] = (unsigned)(C * 2);
#pragma unroll
        for (int h = 0; h < 2; ++h) { gA[h][i] = 0u; gN[h][i] = 0u; } }
#define PG8_SA(b, h) (((b) * 2 + (h)) * HTB)
#define PG8_SB(b, h) ((4 + (b) * 2 + (h)) * HTB)
#define PG8_STAGE(bufoff, gbase, voff) do { _Pragma("unroll") for (int _i = 0; _i < 2; ++_i) \
        __builtin_amdgcn_global_load_lds((const unsigned*)((const char*)(gbase) + (voff)[_i]), (PG8_LAS unsigned*)(lds + (bufoff) + ldsw + _i * 8192), 16, 0, 0); } while (0)
#define PG8_STA(bufoff, h, nxsel, kb) do { if constexpr (GATHER) { unsigned o_[2] = {(nxsel) ? gN[h][0] : gA[h][0], (nxsel) ? gN[h][1] : gA[h][1]}; PG8_STAGE(bufoff, (const char*)g.A + (kb), o_); } \
        else { PG8_STAGE(bufoff, ((nxsel) ? nA : cA) + (size_t)(h) * hstep + (kb), voffA); } } while (0)
#define PG8_ROWT_ISSUE(slot, pm) do { if constexpr (GATHER) { if (wid < 4) __builtin_amdgcn_global_load_lds((const unsigned*)(S.rowoff + (size_t)(pm) * BM + wid * 64 + lane), (PG8_LAS unsigned*)(S.rowt + (slot) * 256 + wid * 64), 4, 0, 0); } } while (0)
#define PG8_ROWT_READ(dst, slot) do { if constexpr (GATHER) { _Pragma("unroll") for (int h_ = 0; h_ < 2; ++h_) _Pragma("unroll") for (int i_ = 0; i_ < 2; ++i_) dst[h_][i_] = (unsigned)S.rowt[(slot) * 256 + h_ * HALF + gR[i_]] + gC[i_]; } } while (0)
#define PG8_EPI_ISSUE(slot, U) do { if constexpr (Epi::NSTAGE > 0) { if (wid < Epi::NSTAGE) __builtin_amdgcn_global_load_lds((const unsigned*)((const char*)E.stage_src(wid, U) + lane * 16), (PG8_LAS unsigned*)(xlds + (slot) * 4096 + wid * 1024), 16, 0, 0); } } while (0)
#define PG8_LDA(dst, b, h) do { _Pragma("unroll") for (int m = 0; m < 4; ++m) dst[m] = FragOps<MODE>::load(lds + PG8_SA(b, h) + aoff + m * 2048); } while (0)
#define PG8_LDB(dst, b, h) do { _Pragma("unroll") for (int n = 0; n < 2; ++n) dst[n] = FragOps<MODE>::load(lds + PG8_SB(b, h) + boff + n * 2048); } while (0)
#define PG8_MMA(ai, bj, At, Bt) do { __builtin_amdgcn_s_setprio(1); _Pragma("unroll") for (int m = 0; m < 4; ++m) _Pragma("unroll") for (int n = 0; n < 2; ++n) \
        acc[ai][bj][m][n] = Mma<MODE>::run(Bt[n], At[m], acc[ai][bj][m][n]); __builtin_amdgcn_s_setprio(0); } while (0)
#define PG8_WAIT_V(n) asm volatile("s_waitcnt vmcnt(" #n ")" ::: "memory")
#define PG8_WAIT_L(n) asm volatile("s_waitcnt lgkmcnt(" #n ")" ::: "memory")
#define PG8_BAR __builtin_amdgcn_s_barrier()
#define PG8_SCHED __builtin_amdgcn_sched_barrier(0)
    Unit cur, nxt; int ui = 0;
    if (!S.next(0, cur)) return;
    acc_t acc[2][2][4][2];
#pragma unroll
    for (int a = 0; a < 2; ++a)
#pragma unroll
        for (int b = 0; b < 2; ++b)
#pragma unroll
            for (int m = 0; m < 4; ++m)
#pragma unroll
                for (int n = 0; n < 2; ++n) acc[a][b][m][n] = (acc_t)0;
    typename FragOps<MODE>::frag_t At[4], B0[2], B1[2];
    const char* cA = (const char*)g.A + (size_t)cur.pm * tstep; const char* cB = (const char*)g.Bt + (size_t)cur.pn * tstep; const char* nA = cA;
    S.a_ready(cur);
    PG8_EPI_ISSUE(0, cur);
    if constexpr (GATHER) { PG8_ROWT_ISSUE(0, cur.pm); PG8_WAIT_V(0); __syncthreads(); PG8_ROWT_READ(gA, 0); PG8_WAIT_L(0); }
    if constexpr (SP2) {
        PG8_STAGE(PG8_SB(0, 0), cB, voffB); PG8_STAGE(PG8_SB(0, 1), cB + hstep, voffB); PG8_STA(PG8_SA(0, 0), 0, false, 0); PG8_STA(PG8_SA(0, 1), 1, false, 0);
        if (wr == 1) PG8_BAR;
        PG8_WAIT_V(2); PG8_BAR;
        PG8_STAGE(PG8_SB(1, 0), cB + kstep, voffB); PG8_STA(PG8_SA(1, 0), 0, false, kstep); PG8_STAGE(PG8_SB(1, 1), cB + hstep + kstep, voffB);
        PG8_WAIT_V(6); PG8_BAR;
    } else {
        PG8_STAGE(PG8_SB(0, 0), cB, voffB); PG8_STAGE(PG8_SA(0, 0), cA, voffA); PG8_STAGE(PG8_SB(0, 1), cB + hstep, voffB); PG8_STAGE(PG8_SA(0, 1), cA + hstep, voffA);
        if (wr == 1) PG8_BAR;
        PG8_WAIT_V(4); PG8_BAR;
        PG8_STAGE(PG8_SB(1, 0), cB + kstep, voffB); PG8_STAGE(PG8_SA(1, 0), cA + kstep, voffA); PG8_STAGE(PG8_SB(1, 1), cB + hstep + kstep, voffB);
        PG8_WAIT_V(6); PG8_BAR;
    }
    for (;;) {
        const bool has_next = S.next(ui + 1, nxt);
        nA = has_next ? (const char*)g.A + (size_t)nxt.pm * tstep : cA; const char* nB = has_next ? (const char*)g.Bt + (size_t)nxt.pn * tstep : cB;
        if (has_next) { PG8_EPI_ISSUE((ui + 1) % 3, nxt); }
        if (has_next) PG8_ROWT_ISSUE((ui + 1) & 1, nxt.pm);
#pragma unroll 1
        for (int t = 0; t < nt; t += 2) {
            const bool last = (t == nt - 2);
            const char* a1 = cA + (size_t)(t + 1) * kstep;
            const char* a2 = last ? nA : cA + (size_t)(t + 2) * kstep; const char* b2 = last ? nB : cB + (size_t)(t + 2) * kstep;
            const char* a3 = a2 + kstep; const char* b3 = b2 + kstep;
            const size_t kb1 = (size_t)(t + 1) * kstep, kb2 = last ? 0 : (size_t)(t + 2) * kstep, kb3 = kb2 + kstep;
            if (last && has_next) S.a_ready(nxt);
            if constexpr (GATHER) { if (last) { if (has_next) { PG8_ROWT_READ(gN, (ui + 1) & 1); } else {
#pragma unroll
                        for (int h_ = 0; h_ < 2; ++h_) { gN[h_][0] = gA[h_][0]; gN[h_][1] = gA[h_][1]; } } } }
            if constexpr (SP2) {
            PG8_LDB(B0, 0, 0); PG8_LDB(B1, 0, 1); PG8_SCHED; PG8_LDA(At, 0, 0); PG8_STA(PG8_SA(1, 1), 1, false, kb1);
            PG8_WAIT_V(8); PG8_WAIT_L(0); PG8_BAR; PG8_MMA(0, 0, At, B0); PG8_MMA(0, 1, At, B1); PG8_BAR; PG8_SCHED;
            PG8_LDA(At, 0, 1); PG8_STAGE(PG8_SB(0, 0), b2, voffB); PG8_STAGE(PG8_SB(0, 1), b2 + hstep, voffB); PG8_STA(PG8_SA(0, 0), 0, last, kb2);
            PG8_WAIT_V(8); PG8_WAIT_L(0); PG8_BAR; PG8_MMA(1, 0, At, B0); PG8_MMA(1, 1, At, B1); PG8_BAR; PG8_SCHED;
            PG8_LDB(B0, 1, 0); PG8_LDB(B1, 1, 1); PG8_SCHED; PG8_LDA(At, 1, 0); PG8_STA(PG8_SA(0, 1), 1, last, kb2);
            PG8_WAIT_V(8); PG8_WAIT_L(0); PG8_BAR; PG8_MMA(0, 0, At, B0); PG8_MMA(0, 1, At, B1); PG8_BAR; PG8_SCHED;
            PG8_LDA(At, 1, 1); PG8_STAGE(PG8_SB(1, 0), b3, voffB); PG8_STAGE(PG8_SB(1, 1), b3 + hstep, voffB); PG8_STA(PG8_SA(1, 0), 0, last, kb3);
            PG8_WAIT_V(8); PG8_WAIT_L(0); PG8_BAR; PG8_MMA(1, 0, At, B0); PG8_MMA(1, 1, At, B1); PG8_BAR; PG8_SCHED;
            } else {
            PG8_LDB(B0, 0, 0); PG8_SCHED; PG8_LDA(At, 0, 0); PG8_STAGE(PG8_SA(1, 1), a1 + hstep, voffA);
            PG8_WAIT_L(8); PG8_BAR; PG8_WAIT_L(0); PG8_MMA(0, 0, At, B0); PG8_BAR; PG8_SCHED;
            PG8_LDB(B1, 0, 1); PG8_STAGE(PG8_SB(0, 0), b2, voffB);
            PG8_BAR; PG8_WAIT_L(0); PG8_MMA(0, 1, At, B1); PG8_BAR;
            PG8_LDA(At, 0, 1); PG8_STAGE(PG8_SA(0, 0), a2, voffA);
            PG8_BAR; PG8_WAIT_L(0); PG8_MMA(1, 0, At, B0); PG8_BAR; PG8_SCHED;
            PG8_STAGE(PG8_SB(0, 1), b2 + hstep, voffB);
            PG8_WAIT_V(6); PG8_BAR; PG8_MMA(1, 1, At, B1); PG8_BAR;
            PG8_LDB(B0, 1, 0); PG8_SCHED; PG8_LDA(At, 1, 0); PG8_STAGE(PG8_SA(0, 1), a2 + hstep, voffA);
            PG8_WAIT_L(8); PG8_BAR; PG8_WAIT_L(0); PG8_MMA(0, 0, At, B0); PG8_BAR; PG8_SCHED;
            PG8_LDB(B1, 1, 1); PG8_STAGE(PG8_SB(1, 0), b3, voffB);
            PG8_BAR; PG8_WAIT_L(0); PG8_MMA(0, 1, At, B1); PG8_BAR;
            PG8_LDA(At, 1, 1); PG8_STAGE(PG8_SA(1, 0), a3, voffA);
            PG8_BAR; PG8_WAIT_L(0); PG8_MMA(1, 0, At, B0); PG8_BAR; PG8_SCHED;
            PG8_STAGE(PG8_SB(1, 1), b3 + hstep, voffB);
            PG8_WAIT_V(6); PG8_BAR; PG8_MMA(1, 1, At, B1); PG8_BAR;
            }
        }
        if constexpr (ALIGN_EPI) { if (wr == 0) PG8_BAR; }
        if constexpr (!Epi::AFTER_DRAIN) { E(acc, cur, wr, wc, fr, fq, xlds + (ui % 3) * 4096); S.done(cur); }
        if (!has_next) break;
#pragma unroll
        for (int a = 0; a < 2; ++a)
#pragma unroll
            for (int b = 0; b < 2; ++b)
#pragma unroll
                for (int m = 0; m < 4; ++m)
#pragma unroll
                    for (int n = 0; n < 2; ++n) acc[a][b][m][n] = (acc_t)0;
        cur = nxt; cA = nA; cB = nB; ++ui;
        if constexpr (GATHER) {
#pragma unroll
            for (int h_ = 0; h_ < 2; ++h_) { gA[h_][0] = gN[h_][0]; gA[h_][1] = gN[h_][1]; } }
        if constexpr (ALIGN_EPI) { if (wr == 1) PG8_BAR; }
    }
    PG8_WAIT_V(0);
    if constexpr (!ALIGN_EPI) { if (wr == 0) PG8_BAR; }
    PG8_BAR;
#undef PG8_SA
#undef PG8_SB
#undef PG8_STAGE
#undef PG8_STA
#undef PG8_EPI_ISSUE
#undef PG8_ROWT_ISSUE
#undef PG8_ROWT_READ
#undef PG8_LDA
#undef PG8_LDB
#undef PG8_MMA
#undef PG8_WAIT_V
#undef PG8_WAIT_L
#undef PG8_BAR
#undef PG8_SCHED
}
}

constexpr int NWAVES = 8, NTHR = 512;
constexpr int BATCH = 2, SEQ = 8192, T = BATCH * SEQ, D = 1024;
constexpr int DI = 2048, SH = 32, HP = 64, NGRP = 4, NS = 128, CHK = 128, NCH = SEQ / CHK;
constexpr int IN_DIM = 5152, XW = 5120, XOFF = 2048, BOFF = 4096, COFF = 4608, CONVD = 3072;
constexpr int QH = 16, KVH = 4, HD = 64, QKVW = 1536;
constexpr int NE = 32, TOPK = 4, FF = 1024, NA = T * TOPK, MTILE = 256, CAP = NA + NE * MTILE, MAXTILES = CAP / MTILE;
constexpr float EPS = 1e-6f;

constexpr size_t MiB = 1u << 20;
constexpr size_t WS_CTL = 0, CTL_ZERO_BYTES = 32768;
constexpr size_t WS_MODP = 1 * MiB;
constexpr size_t WS_MISC = 2 * MiB;
constexpr size_t MISC_CNT = 0, MISC_TE = 65536, MISC_NT = 65536 + 2048, MISC_CDEC = 131072, MISC_GATE = 262144;
constexpr size_t WS_WSC = 3 * MiB;
constexpr size_t WSC_W1 = 0, WSC_IN = 524288, WSC_QKV = 524288 + 32768, WSC_W2 = 524288 + 65536;
constexpr size_t HS_OFF = 16 * MiB, XGS_OFF = 80 * MiB;
constexpr size_t WS_WIN = 4 * MiB, WS_WOUT = 14 * MiB, WS_WQKV = 18 * MiB, WS_WAO = 21 * MiB;
constexpr size_t WS_W1 = 32 * MiB, WS_W2 = 288 * MiB;
constexpr size_t WS_H = 416 * MiB, WS_ZX = 448 * MiB, WS_DT = 608 * MiB, WS_ST = 610 * MiB, WS_Y = 674 * MiB;
constexpr size_t WS_X1 = 738 * MiB, WS_X2 = 802 * MiB, WS_X3 = 866 * MiB;
constexpr size_t WS_ASG = 930 * MiB;
constexpr size_t WS_SRT = 931 * MiB;
constexpr size_t WS_XG = 932 * MiB, WS_ACT = 1076 * MiB, WS_YK = 1220 * MiB, WS_QKV = 1348 * MiB, WS_AO = 1396 * MiB;
constexpr size_t WS_XT = 1428 * MiB, WS_BT = 1492 * MiB, WS_BN = 1508 * MiB, WS_CN = 1524 * MiB, WS_END = 1540 * MiB;
constexpr int CW_TMO = 0, CW_CODE = 1, CW_BAR = 4096;

constexpr int RING_OFF = 0, RING_BYTES = 131072;
constexpr int LDSCTL_OFF = RING_BYTES, MISC_OFF = LDSCTL_OFF + 320, TE_OFF = MISC_OFF + 128;
constexpr int ROWT_OFF = TE_OFF + 1280;
constexpr int EPIX_OFF = ROWT_OFF + 2048;
constexpr int LDS_BYTES = 147456;
static_assert(EPIX_OFF + 3 * 4096 <= LDS_BYTES && (EPIX_OFF & 15) == 0, "LDS map");
static_assert(TE_OFF + 4 * (MAXTILES + 4) <= LDS_BYTES, "LDS map");

#define LDS_WAIT() asm volatile("s_waitcnt lgkmcnt(0)" ::: "memory")
#define VM_WAIT() asm volatile("s_waitcnt vmcnt(0)" ::: "memory")
__device__ __forceinline__ unsigned f2bf(float f) { unsigned u = __builtin_bit_cast(unsigned, f); return (u + 0x7fffu + ((u >> 16) & 1u)) >> 16; }
typedef float f32x2_t __attribute__((ext_vector_type(2)));
typedef __bf16 bf16x2_t __attribute__((ext_vector_type(2)));
__device__ __forceinline__ unsigned pk2(float lo, float hi) { const f32x2_t v = {lo, hi}; const bf16x2_t b = __builtin_convertvector(v, bf16x2_t); return __builtin_bit_cast(unsigned, b); }
__device__ __forceinline__ float bf2f(unsigned h) { return __builtin_bit_cast(float, h << 16); }
__device__ __forceinline__ float bflo(unsigned w) { return __builtin_bit_cast(float, w << 16); }
__device__ __forceinline__ float bfhi(unsigned w) { return __builtin_bit_cast(float, w & 0xffff0000u); }
__device__ __forceinline__ bf16x8 pack8(const float (&o)[8]) { v4u w; w.x = pk2(o[0], o[1]); w.y = pk2(o[2], o[3]); w.z = pk2(o[4], o[5]); w.w = pk2(o[6], o[7]); return __builtin_bit_cast(bf16x8, w); }
__device__ __forceinline__ float rcp_f(float x) { return __builtin_amdgcn_rcpf(x); }
__device__ __forceinline__ float rsq_f(float x) { return __builtin_amdgcn_rsqf(x); }
__device__ __forceinline__ float silu_f(float x) { return x * rcp_f(1.0f + __expf(-x)); }
__device__ __forceinline__ float wave_sum(float v) {
#pragma unroll
    for (int o = 1; o < 64; o <<= 1) v += __shfl_xor(v, o);
    return v;
}
#define MFMA16(a, b, c) __builtin_amdgcn_mfma_f32_16x16x32_bf16((a), (b), (c), 0, 0, 0)

#define XB_TMO      128
#define XB_XCNT(j)  (256  + 64 * (j))
#define XB_XSUB(j)  (1280 + 64 * (j))
#define XB_XGEN(j)  (2304 + 64 * (j))
#define XB_TOP      3328
#define XB_TOPGEN   3392
#define XCD_BAR_WORDS 3456
#define XB_SPIN_CAP (1u << 18)
__device__ __forceinline__ unsigned xb_ld(unsigned* p)              { return __hip_atomic_load(p, __ATOMIC_RELAXED, __HIP_MEMORY_SCOPE_AGENT); }
__device__ __forceinline__ unsigned xb_add(unsigned* p, unsigned v) { return __hip_atomic_fetch_add(p, v, __ATOMIC_RELAXED, __HIP_MEMORY_SCOPE_AGENT); }
__device__ __forceinline__ unsigned xb_xcc_id() { return (unsigned)__builtin_amdgcn_s_getreg((3 << 11) | 20) & 0xFu; }
#define XB_SPIN(cond, bar) do { unsigned _sp = 0; while (cond) { __builtin_amdgcn_s_sleep(1); \
    if ((++_sp & 255u) == 0u) { if (xb_ld(&(bar)[XB_TMO])) break; if (_sp > XB_SPIN_CAP) { atomicAdd(&(bar)[XB_TMO], 1u); break; } } } } while (0)
struct XcdBarrier { unsigned* bar; unsigned x; volatile LAS unsigned* st; };
__device__ __forceinline__ XcdBarrier xcd_barrier_post(unsigned* bar, volatile LAS unsigned* st) {
    XcdBarrier b; b.bar = bar; b.x = xb_xcc_id(); b.st = st;
    if (threadIdx.x == 0) (void)xb_add(&bar[XB_XCNT(b.x)], 1u);
    return b;
}
__device__ __forceinline__ void xcd_barrier_complete(unsigned* bar, unsigned x, unsigned& nloc, unsigned& nx) {
    const unsigned G = gridDim.x * gridDim.y * gridDim.z;
    unsigned sum, cnt, mine, sp = 0u;
    for (;;) {
        sum = 0u; cnt = 0u; mine = 0u;
#pragma unroll
        for (unsigned j = 0; j < 16; ++j) { const unsigned c = xb_ld(&bar[XB_XCNT(j)]); sum += c; cnt += (c > 0u) ? 1u : 0u; mine = (j == x) ? c : mine; }
        if (sum == G) break;
        __builtin_amdgcn_s_sleep(1);
        if ((++sp & 255u) == 0u) { if (xb_ld(&bar[XB_TMO])) break; if (sp > XB_SPIN_CAP) { atomicAdd(&bar[XB_TMO], 1u); break; } }
    }
    nloc = mine > 0u ? mine : 1u; nx = cnt > 0u ? cnt : 1u;
}
__device__ __forceinline__ void xcd_barrier(const XcdBarrier& b) {
    asm volatile("s_waitcnt vmcnt(0)" ::: "memory");
    __syncthreads();
    if (threadIdx.x == 0) {
        unsigned* bar = b.bar;
        __builtin_amdgcn_s_waitcnt(0);
        unsigned nloc = b.st[0], nx = b.st[1];
        if (nloc == 0u) { xcd_barrier_complete(bar, b.x, nloc, nx); b.st[0] = nloc; b.st[1] = nx; }
        const unsigned old = xb_add(&bar[XB_XSUB(b.x)], 1u);
        const unsigned gen = old / nloc;
        if (old + 1u == (gen + 1u) * nloc) {
            __builtin_amdgcn_fence(__ATOMIC_RELEASE, "agent");
            asm volatile("s_waitcnt vmcnt(0)" ::: "memory");
            const unsigned og = xb_add(&bar[XB_TOP], 1u);
            const unsigned tg = og / nx;
            if (og + 1u == (tg + 1u) * nx) xb_add(&bar[XB_TOPGEN], 1u);
            else XB_SPIN(xb_ld(&bar[XB_TOPGEN]) == tg, bar);
            __builtin_amdgcn_fence(__ATOMIC_ACQUIRE, "agent");
            xb_add(&bar[XB_XGEN(b.x)], 1u);
            asm volatile("s_waitcnt vmcnt(0)" ::: "memory");
        } else {
            XB_SPIN(xb_ld(&bar[XB_XGEN(b.x)]) == gen, bar);
            __builtin_amdgcn_fence(__ATOMIC_ACQUIRE, "agent");
            asm volatile("s_waitcnt vmcnt(0)" ::: "memory");
        }
    }
    __syncthreads();
}

struct Args { const float* in[26]; float* out; unsigned char* ws; int ph_lo, ph_hi; };
enum { I_X = 0, I_C, I_ADAW, I_ADAB, I_N1G, I_N2G, I_MINW, I_MCONVW, I_MCONVB, I_MDTB, I_MALOG, I_MD, I_MNG, I_MOUTW, I_AQKVW, I_AQNG, I_AKNG, I_ASINK, I_AOUTW, I_RELB, I_RW, I_RB, I_EW1, I_EB1, I_EW2, I_EB2 };

__device__ __forceinline__ void p0_transpose_item(const float* __restrict__ W, int ldw, int K, int nblk, bf16* WT, LAS float* scr, int item, int lane) {
    const int kb = item / nblk, nb = item % nblk, k0 = 64 * kb, n0 = 32 * nb;
    float tv[32];
#pragma unroll
    for (int i = 0; i < 32; ++i) { const int kk = 2 * i + (lane >> 5); tv[i] = W[(size_t)(k0 + kk) * ldw + n0 + (lane & 31)]; }
#pragma unroll
    for (int i = 0; i < 32; ++i) { const int kk = 2 * i + (lane >> 5); scr[kk * 33 + (lane & 31)] = tv[i]; }
    LDS_WAIT(); asm volatile("" ::: "memory");
    const int c = lane & 7;
#pragma unroll
    for (int j = 0; j < 4; ++j) { const int n = (lane >> 3) + 8 * j; const LAS float* s = scr + (8 * c) * 33 + n;
        v4u o; o.x = pk2(s[0 * 33], s[1 * 33]); o.y = pk2(s[2 * 33], s[3 * 33]); o.z = pk2(s[4 * 33], s[5 * 33]); o.w = pk2(s[6 * 33], s[7 * 33]);
        *(GAS v4u*)(WT + (size_t)(n0 + n) * K + k0 + 8 * c) = o; }
    LDS_WAIT(); asm volatile("" ::: "memory");
}
__device__ __forceinline__ void p0_prologue(const Args& a, LAS unsigned char* lds, int wave, int lane) {
    unsigned char* ws = a.ws; const int blk = blockIdx.x, G = gridDim.x;
    float* modp = (float*)(ws + WS_MODP);
    const float* __restrict__ cin = a.in[I_C]; const float* __restrict__ adaw = a.in[I_ADAW];
    if (wave < 2) {
        for (int it = wave * G + blk; it < 384; it += 2 * G) {
            const int kc = it & 7, rest = it >> 3, l = rest / 24, nb = rest % 24;
            f32x4 a0 = {0.f, 0.f, 0.f, 0.f}, a1 = {0.f, 0.f, 0.f, 0.f};
            const float* wp = adaw + ((size_t)l * 1024 + kc * 128) * 6144 + nb * 256 + lane * 4;
#pragma unroll 32
            for (int k = 0; k < 128; ++k) { const f32x4 w = *(const f32x4*)(wp + (size_t)k * 6144);
                const float c0 = silu_f(cin[kc * 128 + k]), c1 = silu_f(cin[1024 + kc * 128 + k]); a0 += w * c0; a1 += w * c1; }
            *(f32x4*)(modp + ((size_t)(kc * 2 + l) * 2 + 0) * 6144 + nb * 256 + lane * 4) = a0;
            *(f32x4*)(modp + ((size_t)(kc * 2 + l) * 2 + 1) * 6144 + nb * 256 + lane * 4) = a1;
        }
    } else {
        LAS float* scr = (LAS float*)(lds + RING_OFF + wave * 16384);
        constexpr int I1 = 32 * 32, I3 = 16 * 32;
        constexpr int NITEMS = I1 + I3;
        for (int it = (wave - 2) * G + blk; it < NITEMS; it += 6 * G) {
            int r = it;
            if (r < I1) { p0_transpose_item(a.in[I_MOUTW], 1024, 2048, 32, (bf16*)(ws + WS_WOUT), scr, r, lane); continue; } r -= I1;
            { p0_transpose_item(a.in[I_AOUTW], 1024, 1024, 32, (bf16*)(ws + WS_WAO), scr, r, lane); }
        }
    }
}
struct QItem { const float* W; int ldw, n0; signed char* outq; float* sc; int f8; };
__device__ __forceinline__ QItem quant_decode(const Args& a, int it) {
    unsigned char* ws = a.ws; float* wsc = (float*)(ws + WS_WSC); QItem q; q.f8 = 0;
    constexpr int Q2 = 160;
    if (it < Q2) { q.W = a.in[I_MINW]; q.ldw = IN_DIM; q.n0 = 32 * it; q.outq = (signed char*)(ws + WS_WIN); q.sc = wsc + WSC_IN / 4; }
    else { q.W = a.in[I_AQKVW]; q.ldw = 1536; q.n0 = 32 * (it - Q2); q.outq = (signed char*)(ws + WS_WQKV); q.sc = wsc + WSC_QKV / 4; }
    return q;
}
__device__ __forceinline__ void quant_load(const QItem& q, int wave, int lane, float (&vals)[64]) {
    const int n = lane & 31, kh = lane >> 5; const float* __restrict__ wp = q.W + (size_t)(128 * wave + kh) * q.ldw + q.n0 + n;
#pragma unroll
    for (int i = 0; i < 64; ++i) vals[i] = wp[(size_t)(2 * i) * q.ldw];
}
__device__ __forceinline__ void quant_finish(const QItem& q, const float (&vals)[64], LAS unsigned char* lds, int wave, int lane) {
    LAS float* AMX = (LAS float*)(lds + 36864);
    LAS unsigned char* Tt = lds + wave * 4224;
    const int n = lane & 31, kh = lane >> 5; float am = 0.f;
#pragma unroll
    for (int i = 0; i < 64; ++i) am = fmaxf(am, fabsf(vals[i]));
    am = fmaxf(am, __shfl_xor(am, 32));
    if (lane < 32) AMX[wave * 32 + n] = am;
    __syncthreads();
    float amt = 0.f;
#pragma unroll
    for (int w = 0; w < 8; ++w) amt = fmaxf(amt, AMX[w * 32 + n]);
    const float qmax = q.f8 ? 448.0f : 127.0f;
    const float inv = amt > 0.f ? qmax / amt : 0.f;
    if (wave == 0 && lane < 32) q.sc[q.n0 + n] = amt > 0.f ? amt / qmax : 1.0f;
    if (q.f8) {
#pragma unroll
        for (int i = 0; i < 64; ++i) { const float x = vals[i] * inv; Tt[n * 132 + 2 * i + kh] = (unsigned char)(__builtin_amdgcn_cvt_pk_fp8_f32(x, x, 0, false) & 255); }
    } else {
#pragma unroll
        for (int i = 0; i < 64; ++i) Tt[n * 132 + 2 * i + kh] = (unsigned char)((int)__builtin_rintf(vals[i] * inv) & 255);
    }
    LDS_WAIT(); asm volatile("" ::: "memory");
    { const int rn = lane >> 1, half = lane & 1; const LAS unsigned* src = (const LAS unsigned*)(Tt + rn * 132 + 64 * half);
        v4u o[4];
#pragma unroll
        for (int qd = 0; qd < 4; ++qd) { o[qd].x = src[4 * qd]; o[qd].y = src[4 * qd + 1]; o[qd].z = src[4 * qd + 2]; o[qd].w = src[4 * qd + 3]; }
#pragma unroll
        for (int qd = 0; qd < 4; ++qd) *(v4u*)(q.outq + (size_t)(q.n0 + rn) * 1024 + 128 * wave + 64 * half + 16 * qd) = o[qd]; }
    __syncthreads();
}
__device__ __forceinline__ void p0_quant(const Args& a, LAS unsigned char* lds, int wave, int lane) {
    constexpr int NQ = 160 + 48;
    __syncthreads();
    float va[64], vb[64];
    int it = blockIdx.x;
    if (it < NQ) { const QItem q0 = quant_decode(a, it); quant_load(q0, wave, lane, va); }
#pragma unroll 1
    for (; it < NQ; it += gridDim.x) {
        const int nx = it + gridDim.x;
        if (nx < NQ) { const QItem qn = quant_decode(a, nx); quant_load(qn, wave, lane, vb); }
        const QItem q = quant_decode(a, it);
        quant_finish(q, va, lds, wave, lane);
#pragma unroll
        for (int i = 0; i < 64; ++i) va[i] = vb[i];
    }
}
constexpr int BG_N = 2048 + 1024;
__device__ __forceinline__ QItem bg_decode(const Args& a, int j, int matbase) {
    unsigned char* ws = a.ws; float* wsc = (float*)(ws + WS_WSC); QItem q;
    if (j < 2048) { const int mat = matbase + (j >> 6), nb = j & 63;
        q.W = a.in[I_EW1] + (size_t)mat * 1024 * 2048; q.ldw = 2048; q.n0 = 32 * nb; q.outq = (signed char*)(ws + WS_W1) + (size_t)mat * 2048 * 1024; q.sc = wsc + WSC_W1 / 4 + mat * 2048; q.f8 = 0; }
    else { const int g = j - 2048, mat = matbase + (g >> 5), nb = g & 31;
        q.W = a.in[I_EW2] + (size_t)mat * 1024 * 1024; q.ldw = 1024; q.n0 = 32 * nb; q.outq = (signed char*)(ws + WS_W2) + (size_t)mat * 1024 * 1024; q.sc = wsc + WSC_W2 / 4 + mat * 1024; q.f8 = 1; }
    return q;
}
__device__ __forceinline__ void bg_run(const Args& a, LAS unsigned char* lds, int first, int count, int step, int wave, int lane, int matbase = 32) {
    if (first > BG_N) first = BG_N;
    __syncthreads();
    float va[64], vb[64];
    int j = first, left = count;
    if (j >= BG_N) left = 0;
    if (left > 0) { const QItem q0 = bg_decode(a, j, matbase); quant_load(q0, wave, lane, va); }
#pragma unroll 1
    for (; left > 0; --left, j += step) {
        const int nx = j + step; const bool more = (left > 1) && (nx < BG_N);
        if (more) { const QItem qn = bg_decode(a, nx, matbase); quant_load(qn, wave, lane, vb); }
        const QItem q = bg_decode(a, j, matbase);
        quant_finish(q, va, lds, wave, lane);
        if (!more) break;
#pragma unroll
        for (int i = 0; i < 64; ++i) va[i] = vb[i];
    }
    __syncthreads();
}
__device__ __forceinline__ float modval(const Args& a, int l, int b, int idx) {
    const float* modp = (const float*)(a.ws + WS_MODP);
    float s = a.in[I_ADAB][l * 6144 + idx];
#pragma unroll
    for (int kc = 0; kc < 8; ++kc) s += modp[((size_t)(kc * 2 + l) * 2 + b) * 6144 + idx];
    return s;
}

constexpr int NP_MOD = 0, NP_HI = 16384, NP_LO = NP_HI + 16 * 1032 * 2, NP_PART = NP_LO + 16 * 1032 * 2, NP_LOG = NP_PART + 16384, NP_AE = NP_LOG + 2048, NP_AG = NP_AE + 1024, NP_TOPV = NP_AG + 1024, NP_END = NP_TOPV + 256;
static_assert(NP_END <= RING_BYTES, "norm phase LDS");
template <int MODE, bool COMBINE, bool NORM>
__device__ __forceinline__ void norm_phase(const Args& a, LAS unsigned char* lds, int layer, int which, const float* xin, const float* cgate, const unsigned char* yk, float* xout,
                                           const float* __restrict__ Wsk, int ldw, const float* __restrict__ bsk, int tid, int wave, int lane) {
    unsigned char* ws = a.ws;
    LAS float* MOD = (LAS float*)(lds + NP_MOD);
    LAS bf16* HI = (LAS bf16*)(lds + NP_HI); LAS bf16* LO = (LAS bf16*)(lds + NP_LO);
    LAS float* PART = (LAS float*)(lds + NP_PART); LAS float* LOG = (LAS float*)(lds + NP_LOG);
    LAS int* AE = (LAS int*)(lds + NP_AE); LAS float* AG = (LAS float*)(lds + NP_AG); LAS float* TOPV = (LAS float*)(lds + NP_TOPV);
    signed char* H8 = (signed char*)(ws + WS_H); float* hscale = (float*)(ws + WS_H + HS_OFF);
    const int rb = blockIdx.x;
    if (NORM) {
        const float* ng = a.in[which ? I_N2G : I_N1G] + layer * 1024;
        for (int idx = tid; idx < 2048; idx += NTHR) { const int b = idx >> 10, col = idx & 1023;
            const float sh = modval(a, layer, b, which * 3072 + col), sc = modval(a, layer, b, which * 3072 + 1024 + col);
            MOD[(b * 2 + 0) * 1024 + col] = ng[col] * (1.0f + sc); MOD[(b * 2 + 1) * 1024 + col] = sh; }
    }
    const int fi = lane & 15, fq = lane >> 4;
    bf16x8 Bh[2][4], Bl[2][4];
    if (MODE != 2) {
#pragma unroll
        for (int s = 0; s < 4; ++s)
#pragma unroll
            for (int nt = 0; nt < 2; ++nt) { float hi[8], lo[8];
#pragma unroll
                for (int e = 0; e < 8; ++e) { const float w = Wsk[(size_t)(128 * wave + 32 * s + 8 * fq + e) * ldw + 16 * nt + fi]; const float h = bf2f(f2bf(w)); hi[e] = h; lo[e] = w - h; }
                Bh[nt][s] = pack8(hi); Bl[nt][s] = pack8(lo); }
    }
    __syncthreads();
    f32x4 vn[2][4]; unsigned yn[2][4][4];
#define NP_LOAD_TILE(tlx) do { _Pragma("unroll") for (int rr_ = 0; rr_ < 2; ++rr_) { const int m_ = 64 * rb + 16 * (tlx) + 8 * rr_ + wave; \
        _Pragma("unroll") for (int j = 0; j < 4; ++j) { vn[rr_][j] = *(const f32x4*)(xin + (size_t)m_ * 1024 + 4 * lane + 256 * j); \
            if (COMBINE) { _Pragma("unroll") for (int k = 0; k < 4; ++k) yn[rr_][j][k] = *(const unsigned*)(yk + ((size_t)m_ * 4 + k) * 1024 + 4 * lane + 256 * j); } } } } while (0)
    NP_LOAD_TILE(0);
#pragma unroll 1
    for (int tl = 0; tl < 4; ++tl) {
        f32x4 vc[2][4]; unsigned yc[2][4][4];
#pragma unroll
        for (int rr = 0; rr < 2; ++rr)
#pragma unroll
            for (int j = 0; j < 4; ++j) { vc[rr][j] = vn[rr][j];
                if (COMBINE) {
#pragma unroll
                    for (int k = 0; k < 4; ++k) yc[rr][j][k] = yn[rr][j][k]; } }
        if (tl < 3) NP_LOAD_TILE(tl + 1);
#pragma unroll
        for (int rr = 0; rr < 2; ++rr) {
            const int lr = 8 * rr + wave, m = 64 * rb + 16 * tl + lr, b = m >> 13;
            f32x4 v[4];
#pragma unroll
            for (int j = 0; j < 4; ++j) v[j] = vc[rr][j];
            if (COMBINE) {
#pragma unroll
                for (int j = 0; j < 4; ++j) { const int col = 4 * lane + 256 * j; const f32x4 g = *(const f32x4*)(cgate + b * 1024 + col);
                    f32x4 s = {0.f, 0.f, 0.f, 0.f};
#pragma unroll
                    for (int k = 0; k < 4; ++k) { const unsigned y = yc[rr][j][k]; const f32x2_t lo = __builtin_amdgcn_cvt_pk_f32_fp8((int)y, false), hi = __builtin_amdgcn_cvt_pk_f32_fp8((int)y, true); s += (f32x4){lo[0], lo[1], hi[0], hi[1]}; }
                    v[j] += g * s; *(f32x4*)(xout + (size_t)m * 1024 + col) = v[j]; }
            }
            if (NORM) {
                float ss = 0.f;
#pragma unroll
                for (int j = 0; j < 4; ++j) ss += (v[j].x * v[j].x + v[j].y * v[j].y) + (v[j].z * v[j].z + v[j].w * v[j].w);
                const float r = rsq_f(wave_sum(ss) * (1.0f / 1024.0f) + EPS);
                float am = 0.f;
#pragma unroll
                for (int j = 0; j < 4; ++j) { const int col = 4 * lane + 256 * j;
                    const f32x4 A = *(const LAS f32x4*)(MOD + (b * 2 + 0) * 1024 + col), S = *(const LAS f32x4*)(MOD + (b * 2 + 1) * 1024 + col);
                    const f32x4 h = v[j] * r * A + S; v[j] = h;
                    am = fmaxf(fmaxf(am, fmaxf(fabsf(h.x), fabsf(h.y))), fmaxf(fabsf(h.z), fabsf(h.w)));
                    if (MODE != 2) { v2u hw; hw.x = pk2(h.x, h.y); hw.y = pk2(h.z, h.w);
                        const f32x4 hr = {bflo(hw.x), bfhi(hw.x), bflo(hw.y), bfhi(hw.y)}; const f32x4 l4 = h - hr;
                        v2u lw; lw.x = pk2(l4.x, l4.y); lw.y = pk2(l4.z, l4.w);
                        *(LAS v2u*)(HI + lr * 1032 + col) = hw; *(LAS v2u*)(LO + lr * 1032 + col) = lw; } }
#pragma unroll
                for (int o = 1; o < 64; o <<= 1) am = fmaxf(am, __shfl_xor(am, o));
                const float inv = am > 0.f ? 127.0f / am : 0.f;
#pragma unroll
                for (int j = 0; j < 4; ++j) { const int col = 4 * lane + 256 * j;
                    const int q0 = (int)__builtin_rintf(v[j].x * inv), q1 = (int)__builtin_rintf(v[j].y * inv), q2 = (int)__builtin_rintf(v[j].z * inv), q3 = (int)__builtin_rintf(v[j].w * inv);
                    *(unsigned*)(H8 + (size_t)m * 1024 + col) = (unsigned)(q0 & 255) | ((unsigned)(q1 & 255) << 8) | ((unsigned)(q2 & 255) << 16) | ((unsigned)q3 << 24); }
                if (lane == 0) hscale[m] = am * (1.0f / 127.0f);
            }
        }
        if (MODE != 2) {
            __syncthreads();
            f32x4 acc[2] = {{0.f, 0.f, 0.f, 0.f}, {0.f, 0.f, 0.f, 0.f}};
#pragma unroll
            for (int s = 0; s < 4; ++s) { const int k0 = 128 * wave + 32 * s + 8 * fq;
                const bf16x8 ah = *(const LAS bf16x8*)(HI + fi * 1032 + k0), al = *(const LAS bf16x8*)(LO + fi * 1032 + k0);
#pragma unroll
                for (int nt = 0; nt < 2; ++nt) { acc[nt] = MFMA16(ah, Bh[nt][s], acc[nt]); acc[nt] = MFMA16(al, Bh[nt][s], acc[nt]); acc[nt] = MFMA16(ah, Bl[nt][s], acc[nt]); } }
#pragma unroll
            for (int nt = 0; nt < 2; ++nt)
#pragma unroll
                for (int r = 0; r < 4; ++r) PART[(wave * 16 + 4 * fq + r) * 32 + 16 * nt + fi] = acc[nt][r];
            __syncthreads();
            { const int lr = tid >> 5, n = tid & 31; float s = bsk[n];
#pragma unroll
                for (int w = 0; w < 8; ++w) s += PART[(w * 16 + lr) * 32 + n];
                if (MODE == 0) { const float sp = fmaxf(s, 0.f) + log1pf(__expf(-fabsf(s))); ((float*)(ws + WS_DT))[(size_t)(64 * rb + 16 * tl + lr) * 32 + n] = sp; }
                else LOG[lr * 32 + n] = s; }
            if (MODE == 1) {
                __syncthreads();
                { const int lr = tid >> 5, n = tid & 31; const float sv = LOG[lr * 32 + n]; int rank = 0;
#pragma unroll
                    for (int n2 = 0; n2 < 32; ++n2) { const float o = LOG[lr * 32 + n2]; rank += (o > sv || (o == sv && n2 < n)) ? 1 : 0; }
                    if (rank < 4) { TOPV[lr * 4 + rank] = sv; AE[(16 * tl + lr) * 4 + rank] = n; } }
                __syncthreads();
                if (tid < 64) { const int row = tid >> 2, k = tid & 3; const float v0 = TOPV[row * 4], v1 = TOPV[row * 4 + 1], v2 = TOPV[row * 4 + 2], v3 = TOPV[row * 4 + 3];
                    const float e0 = 1.0f, e1 = __expf(v1 - v0), e2 = __expf(v2 - v0), e3 = __expf(v3 - v0); const float sum = (e0 + e1) + (e2 + e3);
                    const float ek = k == 0 ? e0 : (k == 1 ? e1 : (k == 2 ? e2 : e3));
                    AG[(16 * tl + row) * 4 + k] = ek / sum; }
            }
        }
    }
    if (MODE == 1) {
        __syncthreads();
        int* asg_e = (int*)(ws + WS_ASG); float* asg_g = (float*)(ws + WS_ASG + 262144); int* asg_r = (int*)(ws + WS_ASG + 524288);
        int* cntblk = (int*)(ws + WS_MISC + MISC_CNT);
        LAS int* WC = (LAS int*)(lds + NP_PART);
        int e_mine = 0, rank_w = 0;
        if (wave < 4) { e_mine = AE[tid];
#pragma unroll 4
            for (int e = 0; e < 32; ++e) { const unsigned long long mb = __ballot(e_mine == e); if (e_mine == e) rank_w = __popcll(mb & ((1ull << lane) - 1ull)); if (lane == 0) WC[wave * 32 + e] = __popcll(mb); } }
        __syncthreads();
        if (wave < 4) { int base = 0;
#pragma unroll
            for (int w = 0; w < 3; ++w) base += (w < wave) ? WC[w * 32 + e_mine] : 0;
            asg_e[rb * 256 + tid] = e_mine; asg_g[rb * 256 + tid] = AG[tid]; asg_r[rb * 256 + tid] = base + rank_w; }
        else if (tid < 288) { const int e = tid - 256; cntblk[rb * 32 + e] = (WC[e] + WC[32 + e]) + (WC[64 + e] + WC[96 + e]); }
    }
    __syncthreads();
}

__device__ __forceinline__ void moe_scatter(const Args& a, LAS unsigned char* lds, int tid, int wave, int lane) {
    unsigned char* ws = a.ws; const int rb = blockIdx.x, G = gridDim.x;
    LAS int* PARTS = (LAS int*)(lds + 0); LAS int* TOT = (LAS int*)(lds + 4096); LAS int* BASE = (LAS int*)(lds + 4224); LAS int* PS = (LAS int*)(lds + 4352); LAS int* POS = (LAS int*)(lds + 4608);
    const int* cntblk = (const int*)(ws + WS_MISC + MISC_CNT);
    const int* asg_e = (const int*)(ws + WS_ASG); const float* asg_g = (const float*)(ws + WS_ASG + 262144); const int* asg_r = (const int*)(ws + WS_ASG + 524288);
    int* srt_tok = (int*)(ws + WS_SRT); float* srt_gate = (float*)(ws + WS_SRT + 524288);
    int* rowoff = (int*)(ws + WS_XG); float* xgs = (float*)(ws + WS_XG + XGS_OFF); const float* hscale = (const float*)(ws + WS_H + HS_OFF);
    { const int e = tid & 31, part = tid >> 5; int tot = 0, base = 0;
        for (int bb = part * 16; bb < part * 16 + 16; ++bb) { if (bb < G) { const int c = cntblk[bb * 32 + e]; tot += c; if (bb < rb) base += c; } }
        PARTS[(part * 32 + e) * 2] = tot; PARTS[(part * 32 + e) * 2 + 1] = base; }
    __syncthreads();
    if (tid < 32) { int tot = 0, base = 0; for (int p = 0; p < 16; ++p) { tot += PARTS[(p * 32 + tid) * 2]; base += PARTS[(p * 32 + tid) * 2 + 1]; } TOT[tid] = tot; BASE[tid] = base; }
    __syncthreads();
    if (tid == 0) { int ps = 0; for (int e = 0; e < 32; ++e) { PS[e] = ps; ps += ((TOT[e] + MTILE - 1) / MTILE) * MTILE; } PS[32] = ps; }
    __syncthreads();
    if (tid < 256) { const int aidx = rb * 256 + tid; const int e = asg_e[aidx]; const int pos = PS[e] + BASE[e] + asg_r[aidx];
        srt_tok[pos] = aidx; srt_gate[pos] = asg_g[aidx]; rowoff[pos] = (aidx >> 2) * 1024; xgs[pos] = hscale[aidx >> 2]; }
    if (rb < 32) { const int e = rb; const int p0 = PS[e] + TOT[e], p1 = PS[e + 1];
        for (int pos = p0 + tid; pos < p1; pos += NTHR) { srt_tok[pos] = -1; srt_gate[pos] = 0.f; xgs[pos] = 0.f; rowoff[pos] = 0; } }
    { LAS int* TE = (LAS int*)(lds + TE_OFF);
        if (tid < MAXTILES) { const int r0 = tid * MTILE; int e = 0; for (int j = 0; j < 32; ++j) e += (PS[j + 1] <= r0) ? 1 : 0; TE[tid] = (r0 < PS[32]) ? e : 31; }
        if (tid == 0) TE[MAXTILES] = PS[32] / MTILE; }
    __syncthreads();
    __syncthreads();
}
__device__ __forceinline__ void load_tile_table(const Args& a, LAS unsigned char* lds, int tid) {
    (void)a; (void)lds; (void)tid;
}

#define OPAQUE(x) asm volatile("" : "+v"(x))
__device__ __forceinline__ void conv_load(const bf16* __restrict__ ZX, int tok0, int l0, int zc0, int lane, v4u (&raw)[11]) {
    const int chunk = lane & 7, run = lane >> 3; const int zc = zc0 + 8 * chunk;
    const bf16* __restrict__ base = ZX - 3 * XW; unsigned off = (unsigned)((tok0 + l0 + 8 * run) * XW + zc);
#pragma unroll
    for (int e = 0; e < 11; ++e) { raw[e] = *(const v4u*)(base + off); off += XW; OPAQUE(off); }
}
__device__ __forceinline__ void conv_finish(const Args& a, bool first, int l0, int zc0, bf16* outT, bf16* outN, int lane, v4u (&raw)[11], LAS bf16* ldsT = nullptr, int ldsS = 0, int ldsL = 0) {
    const int chunk = lane & 7, run = lane >> 3; const int zc = zc0 + 8 * chunk, ch = zc - XOFF;
    const float* __restrict__ cw = a.in[I_MCONVW]; const float* __restrict__ cbp = a.in[I_MCONVB];
    if (first && l0 == 0 && run == 0) { raw[0] = (v4u){0u, 0u, 0u, 0u}; raw[1] = (v4u){0u, 0u, 0u, 0u}; raw[2] = (v4u){0u, 0u, 0u, 0u}; }
    float w[4][8], cb[8];
#pragma unroll
    for (int j = 0; j < 4; ++j) { const f32x4 t0 = *(const f32x4*)(cw + j * CONVD + ch), t1 = *(const f32x4*)(cw + j * CONVD + ch + 4);
        w[j][0] = t0.x; w[j][1] = t0.y; w[j][2] = t0.z; w[j][3] = t0.w; w[j][4] = t1.x; w[j][5] = t1.y; w[j][6] = t1.z; w[j][7] = t1.w; }
    { const f32x4 t0 = *(const f32x4*)(cbp + ch), t1 = *(const f32x4*)(cbp + ch + 4); cb[0] = t0.x; cb[1] = t0.y; cb[2] = t0.z; cb[3] = t0.w; cb[4] = t1.x; cb[5] = t1.y; cb[6] = t1.z; cb[7] = t1.w; }
    unsigned P[4][8];
#pragma unroll
    for (int rp = 0; rp < 4; ++rp) { float o[2][8];
#pragma unroll
        for (int rr = 0; rr < 2; ++rr) { const int r = 2 * rp + rr;
#pragma unroll
            for (int cx = 0; cx < 8; ++cx) o[rr][cx] = cb[cx];
#pragma unroll
            for (int j = 0; j < 4; ++j) { const v4u x = raw[r + j];
                const float xv[8] = {bflo(x.x), bfhi(x.x), bflo(x.y), bfhi(x.y), bflo(x.z), bfhi(x.z), bflo(x.w), bfhi(x.w)};
#pragma unroll
                for (int cx = 0; cx < 8; ++cx) o[rr][cx] += w[j][cx] * xv[cx]; }
#pragma unroll
            for (int cx = 0; cx < 8; ++cx) o[rr][cx] = silu_f(o[rr][cx]); }
#pragma unroll
        for (int cx = 0; cx < 8; ++cx) P[rp][cx] = pk2(o[0][cx], o[1][cx]); }
    if (outT) {
#pragma unroll
        for (int cx = 0; cx < 8; ++cx) { v4u t = {P[0][cx], P[1][cx], P[2][cx], P[3][cx]}; *(v4u*)(outT + (8 * chunk + cx) * 128 + l0 + 8 * run) = t; } }
    if (ldsS != 0) {
#pragma unroll
        for (int cx = 0; cx < 8; ++cx) { v4u t = {P[0][cx], P[1][cx], P[2][cx], P[3][cx]}; *(LAS v4u*)(ldsT + (8 * chunk + cx) * ldsS + ldsL + 8 * run) = t; } }
    if (outN) {
#pragma unroll
        for (int rp = 0; rp < 4; ++rp) { v4u e0, e1;
            e0.x = (P[rp][0] & 0xffffu) | (P[rp][1] << 16); e0.y = (P[rp][2] & 0xffffu) | (P[rp][3] << 16); e0.z = (P[rp][4] & 0xffffu) | (P[rp][5] << 16); e0.w = (P[rp][6] & 0xffffu) | (P[rp][7] << 16);
            e1.x = (P[rp][0] >> 16) | (P[rp][1] & 0xffff0000u); e1.y = (P[rp][2] >> 16) | (P[rp][3] & 0xffff0000u); e1.z = (P[rp][4] >> 16) | (P[rp][5] & 0xffff0000u); e1.w = (P[rp][6] >> 16) | (P[rp][7] & 0xffff0000u);
            *(v4u*)(outN + (l0 + 8 * run + 2 * rp) * 128 + 8 * chunk) = e0; *(v4u*)(outN + (l0 + 8 * run + 2 * rp + 1) * 128 + 8 * chunk) = e1; } }
}
__device__ __forceinline__ void head_scan(const float* __restrict__ DT, int tok0, int hh, float Ah, int lane, float& d0, float& d1, float& acs0, float& acs1, float& total) {
    d0 = DT[(size_t)(tok0 + 2 * lane) * 32 + hh]; d1 = DT[(size_t)(tok0 + 2 * lane + 1) * 32 + hh];
    const float a0 = d0 * Ah, a1 = a0 + d1 * Ah;
    float v = a1;
#pragma unroll
    for (int o = 1; o < 64; o <<= 1) { const float t = __shfl_up(v, o); if (lane >= o) v += t; }
    acs0 = v - a1 + a0; acs1 = v; total = __shfl(v, 63);
}
__device__ __forceinline__ void ssd_states(const Args& a, LAS unsigned char* lds, int tid, int wave, int lane) {
    unsigned char* ws = a.ws;
    const bf16* __restrict__ ZX = (const bf16*)(ws + WS_ZX); const float* __restrict__ DT = (const float*)(ws + WS_DT);
    bf16* ST = (bf16*)(ws + WS_ST); float* CDEC = (float*)(ws + WS_MISC + MISC_CDEC);
    bf16* XT = (bf16*)(ws + WS_XT); bf16* BT = (bf16*)(ws + WS_BT); bf16* BN = (bf16*)(ws + WS_BN); bf16* CN = (bf16*)(ws + WS_CN);
    LAS bf16* BTs = (LAS bf16*)(lds + 0);
    LAS bf16* XTs = (LAS bf16*)(lds + 34816 + wave * 9216);
    LAS float* WL = (LAS float*)(lds + 34816 + 8 * 9216 + wave * 512);
    const int fi = lane & 15, fq = lane >> 4;
    for (int u = (int)((blockIdx.x & 7) * (gridDim.x >> 3) + (blockIdx.x >> 3)); u < BATCH * NCH * NGRP; u += gridDim.x) {
        const int b = u >> 8, c = (u >> 2) & 63, g = u & 3; const int tok0 = b * SEQ + c * CHK; const bool first = (c == 0);
        const size_t cg = (size_t)((b * NCH + c) * NGRP + g);
        const int hh = 8 * g + wave; const float Ah = -__expf(a.in[I_MALOG][hh]);
        { float d0, d1, acs0, acs1, total; head_scan(DT, tok0, hh, Ah, lane, d0, d1, acs0, acs1, total);
            WL[2 * lane] = d0 * __expf(total - acs0); WL[2 * lane + 1] = d1 * __expf(total - acs1);
            if (lane == 0) CDEC[(b * NCH + c) * SH + hh] = __expf(total); }
        { const int rh = wave & 1, cb2 = (wave & 3) >> 1; const bool isC = wave >= 4;
            const int zc0 = (isC ? COFF : BOFF) + g * 128 + 64 * cb2;
            v4u raw[11]; conv_load(ZX, tok0, 64 * rh, zc0, lane, raw);
            conv_finish(a, first, 64 * rh, zc0, nullptr, (isC ? CN : BN) + cg * 16384 + 64 * cb2, lane, raw, BTs + (64 * cb2) * 136, isC ? 0 : 136, 64 * rh); }
        bf16x8 Xf[4][4];
        bf16* xtg = XT + ((size_t)((b * NCH + c) * SH + hh)) * 8192;
#pragma unroll
        for (int rh = 0; rh < 2; ++rh) {
            { v4u raw[11]; conv_load(ZX, tok0, 64 * rh, XOFF + hh * 64, lane, raw);
                conv_finish(a, first, 64 * rh, XOFF + hh * 64, xtg, nullptr, lane, raw, XTs, 72, 0); }
            LDS_WAIT(); asm volatile("" ::: "memory");
#pragma unroll
            for (int pt = 0; pt < 4; ++pt)
#pragma unroll
                for (int k2 = 0; k2 < 2; ++k2) { const int ll = 32 * k2 + 8 * fq, l0 = 64 * rh + ll; const v4u x = *(const LAS v4u*)(XTs + (16 * pt + fi) * 72 + ll);
                    const f32x4 s0 = *(const LAS f32x4*)(WL + l0), s1 = *(const LAS f32x4*)(WL + l0 + 4);
                    const float o[8] = {bflo(x.x) * s0.x, bfhi(x.x) * s0.y, bflo(x.y) * s0.z, bfhi(x.y) * s0.w, bflo(x.z) * s1.x, bfhi(x.z) * s1.y, bflo(x.w) * s1.z, bfhi(x.w) * s1.w};
                    Xf[pt][2 * rh + k2] = pack8(o); }
            LDS_WAIT(); asm volatile("" ::: "memory");
        }
        __syncthreads();
        bf16* stp = ST + ((size_t)((b * NCH + c) * SH + hh)) * 8192;
#pragma unroll 1
        for (int nh = 0; nh < 2; ++nh) {
            f32x4 acc[4][4];
#pragma unroll
            for (int n4 = 0; n4 < 4; ++n4)
#pragma unroll
                for (int pt = 0; pt < 4; ++pt) acc[n4][pt] = (f32x4){0.f, 0.f, 0.f, 0.f};
#pragma unroll
            for (int ks = 0; ks < 4; ++ks)
#pragma unroll
                for (int n4 = 0; n4 < 4; ++n4) { const bf16x8 af = *(const LAS bf16x8*)(BTs + (16 * (4 * nh + n4) + fi) * 136 + 32 * ks + 8 * fq);
#pragma unroll
                    for (int pt = 0; pt < 4; ++pt) acc[n4][pt] = MFMA16(af, Xf[pt][ks], acc[n4][pt]); }
#pragma unroll
            for (int n4 = 0; n4 < 4; ++n4)
#pragma unroll
                for (int pt = 0; pt < 4; ++pt) { v2u w; w.x = pk2(acc[n4][pt][0], acc[n4][pt][1]); w.y = pk2(acc[n4][pt][2], acc[n4][pt][3]);
                    *(v2u*)(stp + (16 * pt + fi) * 128 + 16 * (4 * nh + n4) + 4 * fq) = w; }
            asm volatile("" ::: "memory");
        }
        __syncthreads();
    }
}

__device__ __forceinline__ void ssd_scan(const Args& a, int tid) {
    unsigned char* ws = a.ws; bf16* ST = (bf16*)(ws + WS_ST); const float* CDEC = (const float*)(ws + WS_MISC + MISC_CDEC);
    for (int e4 = blockIdx.x * NTHR + tid; e4 < BATCH * SH * 2048; e4 += gridDim.x * NTHR) {
        const int b = e4 >> 16, rem = e4 & 65535, hh = rem >> 11, off = (rem & 2047) * 4;
        f32x4 h = {0.f, 0.f, 0.f, 0.f};
        bf16* p = ST + ((size_t)(b * NCH) * SH + hh) * 8192 + off;
        for (int c0 = 0; c0 < NCH; c0 += 8) { v2u s[8]; float dc[8];
#pragma unroll
            for (int j = 0; j < 8; ++j) { s[j] = *(const v2u*)(p + (size_t)(c0 + j) * SH * 8192); dc[j] = CDEC[(b * NCH + c0 + j) * SH + hh]; }
#pragma unroll
            for (int j = 0; j < 8; ++j) { v2u o; o.x = pk2(h.x, h.y); o.y = pk2(h.z, h.w); *(v2u*)(p + (size_t)(c0 + j) * SH * 8192) = o;
                const f32x4 sv = {bflo(s[j].x), bfhi(s[j].x), bflo(s[j].y), bfhi(s[j].y)}; h = h * dc[j] + sv; } }
    }
}

constexpr int S3_CC = 0, S3_BC = 34816, S3_CB = 69632, S3_TAB = 104448, S3_WV = 109568, S3_RMS = 117760, S3_END = 121856;
static_assert(S3_END <= RING_BYTES, "S3 LDS");
__device__ __forceinline__ void ssd_out(const Args& a, LAS unsigned char* lds, int tid, int wave, int lane) {
    unsigned char* ws = a.ws;
    const bf16* __restrict__ ZX = (const bf16*)(ws + WS_ZX); const float* __restrict__ DT = (const float*)(ws + WS_DT);
    const bf16* ST = (const bf16*)(ws + WS_ST); bf16* Y = (bf16*)(ws + WS_Y);
    LAS bf16* Cc = (LAS bf16*)(lds + S3_CC); LAS bf16* Bc = (LAS bf16*)(lds + S3_BC); LAS bf16* CB = (LAS bf16*)(lds + S3_CB);
    LAS float* ACS = (LAS float*)(lds + S3_WV + wave * 1024); LAS float* DTW = ACS + 128;
    LAS float* RMS = (LAS float*)(lds + S3_RMS);
    const int fi = lane & 15, fq = lane >> 4;
    const int u0 = (int)((blockIdx.x & 7) * (gridDim.x >> 3) + (blockIdx.x >> 3));
    v4u bcn[4], ccn[4];
#define S3_LOAD_BC(uu) do { const int b_ = (uu) >> 8, c_ = ((uu) >> 2) & 63, g_ = (uu) & 3; const size_t cg_ = (size_t)((b_ * NCH + c_) * NGRP + g_); \
        const bf16* bn_ = (const bf16*)(ws + WS_BN) + cg_ * 16384; const bf16* cn_ = (const bf16*)(ws + WS_CN) + cg_ * 16384; \
        _Pragma("unroll") for (int i = 0; i < 4; ++i) { const int idx = tid + NTHR * i, row = idx >> 4, c8 = (idx & 15) * 8; bcn[i] = *(const v4u*)(bn_ + row * 128 + c8); ccn[i] = *(const v4u*)(cn_ + row * 128 + c8); } } while (0)
    if (u0 < BATCH * NCH * NGRP) S3_LOAD_BC(u0);
    for (int u = u0; u < BATCH * NCH * NGRP; u += gridDim.x) {
        const int b = u >> 8, c = (u >> 2) & 63, g = u & 3; const int tok0 = b * SEQ + c * CHK;
        {
#pragma unroll
            for (int i = 0; i < 4; ++i) { const int idx = tid + NTHR * i, row = idx >> 4, c8 = (idx & 15) * 8;
                *(LAS v4u*)(Bc + row * 136 + c8) = bcn[i]; *(LAS v4u*)(Cc + row * 136 + c8) = ccn[i]; } }
        const int hh = 8 * g + wave; const float Ah = -__expf(a.in[I_MALOG][hh]); const float Dh = a.in[I_MD][hh];
        { float d0, d1, acs0, acs1, total; head_scan(DT, tok0, hh, Ah, lane, d0, d1, acs0, acs1, total);
            ACS[2 * lane] = acs0; ACS[2 * lane + 1] = acs1; DTW[2 * lane] = d0; DTW[2 * lane + 1] = d1; }
        bf16x8 Xf[4][4];
        { const bf16* xth = (const bf16*)(ws + WS_XT) + ((size_t)((b * NCH + c) * SH + hh)) * 8192;
#pragma unroll
            for (int pt = 0; pt < 4; ++pt)
#pragma unroll
                for (int ks = 0; ks < 4; ++ks) Xf[pt][ks] = *(const bf16x8*)(xth + (16 * pt + fi) * 128 + 32 * ks + 8 * fq); }
        __syncthreads();
        if (u + (int)gridDim.x < BATCH * NCH * NGRP) S3_LOAD_BC(u + (int)gridDim.x);
        { const int lt = wave;
#pragma unroll 1
            for (int st = 0; st < 8; ++st) { if (st <= lt) { f32x4 cacc = {0.f, 0.f, 0.f, 0.f};
#pragma unroll
                for (int kn = 0; kn < 4; ++kn) { const bf16x8 af = *(const LAS bf16x8*)(Bc + (16 * st + fi) * 136 + 32 * kn + 8 * fq), bfr = *(const LAS bf16x8*)(Cc + (16 * lt + fi) * 136 + 32 * kn + 8 * fq);
                    cacc = MFMA16(af, bfr, cacc); }
                v2u w; w.x = pk2(cacc[0], cacc[1]); w.y = pk2(cacc[2], cacc[3]);
                *(LAS v2u*)(CB + (16 * lt + fi) * 136 + 16 * st + 4 * fq) = w; } } }
        __syncthreads();
        const bf16* sth = ST + ((size_t)((b * NCH + c) * SH + hh)) * 8192;
        const float* __restrict__ ng = a.in[I_MNG];
#pragma unroll 1
        for (int lhi = 0; lhi < 4; ++lhi) {
            int lh = lhi; asm volatile("" : "+s"(lh));
            int fio = fi, fqo = fq; asm volatile("" : "+v"(fio), "+v"(fqo));
            f32x4 acc[4][2];
#pragma unroll
            for (int pt = 0; pt < 4; ++pt)
#pragma unroll
                for (int l4 = 0; l4 < 2; ++l4) acc[pt][l4] = (f32x4){0.f, 0.f, 0.f, 0.f};
            bf16x8 ah0[4], ah1[4];
#pragma unroll
            for (int pt = 0; pt < 4; ++pt) { ah0[pt] = *(const bf16x8*)(sth + (16 * pt + fio) * 128 + 8 * fqo); ah1[pt] = *(const bf16x8*)(sth + (16 * pt + fio) * 128 + 32 + 8 * fqo); }
#pragma unroll
            for (int kn = 0; kn < 4; ++kn) { bf16x8 bfr[2];
#pragma unroll
                for (int l4 = 0; l4 < 2; ++l4) bfr[l4] = *(const LAS bf16x8*)(Cc + (16 * (2 * lh + l4) + fio) * 136 + 32 * kn + 8 * fqo);
#pragma unroll
                for (int pt = 0; pt < 4; ++pt) { const bf16x8 ah = (kn & 1) ? ah1[pt] : ah0[pt];
#pragma unroll
                    for (int l4 = 0; l4 < 2; ++l4) acc[pt][l4] = MFMA16(ah, bfr[l4], acc[pt][l4]); }
                if (kn < 2) {
#pragma unroll
                    for (int pt = 0; pt < 4; ++pt) { const bf16x8 t = *(const bf16x8*)(sth + (16 * pt + fio) * 128 + 32 * (kn + 2) + 8 * fqo); if (kn & 1) ah1[pt] = t; else ah0[pt] = t; } }
                asm volatile("" ::: "memory"); }
#pragma unroll
            for (int l4 = 0; l4 < 2; ++l4) { const float ea = __expf(ACS[16 * (2 * lh + l4) + fio]);
#pragma unroll
                for (int pt = 0; pt < 4; ++pt) acc[pt][l4] *= ea; }
            v2u zq[2][4];
#pragma unroll
            for (int l4 = 0; l4 < 2; ++l4)
#pragma unroll
                for (int pt = 0; pt < 4; ++pt) zq[l4][pt] = *(const v2u*)(ZX + (size_t)(tok0 + 16 * (2 * lh + l4) + fio) * XW + hh * 64 + 16 * pt + 4 * fqo);
#pragma unroll
            for (int l4 = 0; l4 < 2; ++l4) { const int lt = 2 * lh + l4, l = 16 * lt + fio; const float al = ACS[l];
#pragma unroll
                for (int ks = 0; ks < 4; ++ks) { if (32 * ks <= 16 * lt + 15) { const int s0 = 32 * ks + 8 * fqo;
                    const v4u cb8 = *(const LAS v4u*)(CB + l * 136 + s0);
                    const f32x4 as0 = *(const LAS f32x4*)(ACS + s0), as1 = *(const LAS f32x4*)(ACS + s0 + 4), dt0 = *(const LAS f32x4*)(DTW + s0), dt1 = *(const LAS f32x4*)(DTW + s0 + 4);
                    const float cbv[8] = {bflo(cb8.x), bfhi(cb8.x), bflo(cb8.y), bfhi(cb8.y), bflo(cb8.z), bfhi(cb8.z), bflo(cb8.w), bfhi(cb8.w)};
                    const float asv[8] = {as0.x, as0.y, as0.z, as0.w, as1.x, as1.y, as1.z, as1.w}, dtv[8] = {dt0.x, dt0.y, dt0.z, dt0.w, dt1.x, dt1.y, dt1.z, dt1.w};
                    float mv[8];
#pragma unroll
                    for (int e = 0; e < 8; ++e) { const int s = s0 + e; float v = (s <= l) ? cbv[e] * __expf(al - asv[e]) * dtv[e] : 0.f; if (s == l) v += Dh; mv[e] = v; }
                    const bf16x8 mf = pack8(mv);
#pragma unroll
                    for (int pt = 0; pt < 4; ++pt) acc[pt][l4] = MFMA16(Xf[pt][ks], mf, acc[pt][l4]); asm volatile("" ::: "memory"); } } }
#pragma unroll
            for (int l4 = 0; l4 < 2; ++l4) { const int l = 16 * (2 * lh + l4) + fio; float ssq = 0.f;
#pragma unroll
                for (int pt = 0; pt < 4; ++pt) { const v2u z = zq[l4][pt];
                    const float zv[4] = {bflo(z.x), bfhi(z.x), bflo(z.y), bfhi(z.y)};
#pragma unroll
                    for (int r = 0; r < 4; ++r) { const float yv = acc[pt][l4][r] * silu_f(zv[r]); acc[pt][l4][r] = yv; ssq += yv * yv; } }
                ssq += __shfl_xor(ssq, 16); ssq += __shfl_xor(ssq, 32);
                if (fqo == 0) RMS[wave * 128 + l] = ssq; asm volatile("" ::: "memory"); }
            __syncthreads();
#pragma unroll
            for (int l4 = 0; l4 < 2; ++l4) { const int l = 16 * (2 * lh + l4) + fio; float tot = 0.f;
#pragma unroll
                for (int w = 0; w < 8; ++w) tot += RMS[w * 128 + l];
                const float rstd = rsq_f(tot * (1.0f / 512.0f) + EPS);
#pragma unroll
                for (int pt = 0; pt < 4; ++pt) { const int col = hh * 64 + 16 * pt + 4 * fqo; const f32x4 gv = *(const f32x4*)(ng + col);
                    v2u w; w.x = pk2(acc[pt][l4][0] * rstd * gv.x, acc[pt][l4][1] * rstd * gv.y); w.y = pk2(acc[pt][l4][2] * rstd * gv.z, acc[pt][l4][3] * rstd * gv.w);
                    *(v2u*)(Y + (size_t)(tok0 + l) * DI + col) = w; } }
        }
        __syncthreads();
    }
}

constexpr int AT_K = 0, AT_V = 36864, AT_TAB = 73728, AT_END = 75776;
__device__ __forceinline__ void attn_phase(const Args& a, LAS unsigned char* lds, int tid, int wave, int lane) {
    unsigned char* ws = a.ws;
    const bf16* __restrict__ QKV = (const bf16*)(ws + WS_QKV); bf16* AO = (bf16*)(ws + WS_AO);
    LAS bf16* Ks = (LAS bf16*)(lds + AT_K); LAS bf16* Vs = (LAS bf16*)(lds + AT_V); LAS float* TAB = (LAS float*)(lds + AT_TAB);
    const float* __restrict__ qg = a.in[I_AQNG]; const float* __restrict__ kg = a.in[I_AKNG];
    const int fi = lane & 15, fq = lane >> 4;
    const int u0 = (int)((blockIdx.x & 7) * (gridDim.x >> 3) + (blockIdx.x >> 3));
    v4u kxn[4], vxn[4];
#define AT_LOAD_KV(uu) do { const int b_ = (uu) >> 8, nb_ = ((uu) >> 2) & 63, g_ = (uu) & 3; const int key_ = tid >> 1, half_ = tid & 1; \
        const bf16* kp_ = QKV + (ptrdiff_t)(b_ * SEQ + nb_ * 128 - 128 + key_) * QKVW + 1024 + g_ * 64 + 32 * half_; \
        _Pragma("unroll") for (int j = 0; j < 4; ++j) { kxn[j] = *(const v4u*)(kp_ + 8 * j); vxn[j] = *(const v4u*)(kp_ + 256 + 8 * j); } } while (0)
    if (u0 < BATCH * 64 * KVH) AT_LOAD_KV(u0);
    for (int u = u0; u < BATCH * 64 * KVH; u += gridDim.x) {
        const int b = u >> 8, nb = (u >> 2) & 63, g = u & 3; const int tokq0 = b * SEQ + nb * 128;
        { const int key = tid >> 1, half = tid & 1; const bool valid = (nb > 0) || (key >= 128);
            v4u kx[4], vx[4];
            {
#pragma unroll
                for (int j = 0; j < 4; ++j) { kx[j] = kxn[j]; vx[j] = vxn[j]; }
                if (!valid) {
#pragma unroll
                    for (int j = 0; j < 4; ++j) { kx[j] = (v4u){0u, 0u, 0u, 0u}; vx[j] = (v4u){0u, 0u, 0u, 0u}; } } }
            float kf[32]; float ss = 0.f;
#pragma unroll
            for (int j = 0; j < 4; ++j) { kf[8 * j + 0] = bflo(kx[j].x); kf[8 * j + 1] = bfhi(kx[j].x); kf[8 * j + 2] = bflo(kx[j].y); kf[8 * j + 3] = bfhi(kx[j].y);
                kf[8 * j + 4] = bflo(kx[j].z); kf[8 * j + 5] = bfhi(kx[j].z); kf[8 * j + 6] = bflo(kx[j].w); kf[8 * j + 7] = bfhi(kx[j].w); }
#pragma unroll
            for (int e = 0; e < 32; ++e) ss += kf[e] * kf[e];
            ss += __shfl_xor(ss, 1);
            const float r = rsq_f(ss * (1.0f / 64.0f) + EPS);
#pragma unroll
            for (int j = 0; j < 4; ++j) { float o[8];
#pragma unroll
                for (int e = 0; e < 8; ++e) o[e] = kf[8 * j + e] * r * kg[32 * half + 8 * j + e];
                *(LAS bf16x8*)(Ks + key * 72 + 32 * half + 8 * j) = pack8(o);
                *(LAS v4u*)(Vs + key * 72 + 32 * half + 8 * j) = vx[j]; } }
        { const int r = tid >> 7, dist = tid & 127; int bucket;
            if (dist < 16) bucket = dist; else { bucket = 16 + (int)(logf((float)dist / 16.0f) / logf(8.0f) * 16.0f); bucket = bucket < 31 ? bucket : 31; }
            TAB[r * 128 + dist] = a.in[I_RELB][bucket * 16 + 4 * g + r]; }
        __syncthreads();
        if (u + (int)gridDim.x < BATCH * 64 * KVH) AT_LOAD_KV(u + (int)gridDim.x);
        const int r = wave >> 1, hf = wave & 1, h = 4 * g + r; const float sink = a.in[I_ASINK][h];
        for (int qt = 0; qt < 4; ++qt) {
            const int qi0 = 64 * hf + 16 * qt;
            bf16x8 Qf[2];
            { const bf16* qp = QKV + (size_t)(tokq0 + qi0 + fi) * QKVW + h * 64 + 8 * fq;
                const v4u q0 = *(const v4u*)qp, q1 = *(const v4u*)(qp + 32);
                float f0[8] = {bflo(q0.x), bfhi(q0.x), bflo(q0.y), bfhi(q0.y), bflo(q0.z), bfhi(q0.z), bflo(q0.w), bfhi(q0.w)};
                float f1[8] = {bflo(q1.x), bfhi(q1.x), bflo(q1.y), bfhi(q1.y), bflo(q1.z), bfhi(q1.z), bflo(q1.w), bfhi(q1.w)};
                float ss = 0.f;
#pragma unroll
                for (int e = 0; e < 8; ++e) ss += f0[e] * f0[e] + f1[e] * f1[e];
                ss += __shfl_xor(ss, 16); ss += __shfl_xor(ss, 32);
                const float rs = 0.125f * rsq_f(ss * (1.0f / 64.0f) + EPS);
#pragma unroll
                for (int e = 0; e < 8; ++e) { f0[e] *= rs * qg[8 * fq + e]; f1[e] *= rs * qg[32 + 8 * fq + e]; }
                Qf[0] = pack8(f0); Qf[1] = pack8(f1); }
            const int kt0 = (qi0 >> 4) < 6 ? (qi0 >> 4) : 6;
            f32x4 s[10];
#pragma unroll
            for (int kt = 0; kt < 10; ++kt) { const LAS bf16* kp = Ks + (16 * (kt0 + kt) + fi) * 72 + 8 * fq;
                f32x4 z = {0.f, 0.f, 0.f, 0.f};
                z = MFMA16(*(const LAS bf16x8*)kp, Qf[0], z); z = MFMA16(*(const LAS bf16x8*)(kp + 32), Qf[1], z); s[kt] = z; }
            const int qi = qi0 + fi; float mx = -__builtin_inff();
#pragma unroll
            for (int kt = 0; kt < 10; ++kt)
#pragma unroll
                for (int rr = 0; rr < 4; ++rr) { const int kj = 16 * (kt0 + kt) + 4 * fq + rr; const int dist = qi + 128 - kj;
                    const bool valid = (dist >= 0) && (dist < 128) && ((nb > 0) || (kj >= 128));
                    const float sc = valid ? s[kt][rr] + TAB[r * 128 + (dist & 127)] : -__builtin_inff();
                    s[kt][rr] = sc; mx = fmaxf(mx, sc); }
            mx = fmaxf(mx, __shfl_xor(mx, 16)); mx = fmaxf(mx, __shfl_xor(mx, 32)); mx = fmaxf(mx, sink);
            float sum = 0.f;
#pragma unroll
            for (int kt = 0; kt < 10; ++kt)
#pragma unroll
                for (int rr = 0; rr < 4; ++rr) { const float p = __expf(s[kt][rr] - mx); s[kt][rr] = p; sum += p; }
            sum += __shfl_xor(sum, 16); sum += __shfl_xor(sum, 32);
            const float inv = rcp_f(sum + __expf(sink - mx));
            f32x4 o[4];
#pragma unroll
            for (int dt = 0; dt < 4; ++dt) o[dt] = (f32x4){0.f, 0.f, 0.f, 0.f};
#pragma unroll
            for (int kk = 0; kk < 5; ++kk) {
                const float pv[8] = {s[2 * kk][0], s[2 * kk][1], s[2 * kk][2], s[2 * kk][3], s[2 * kk + 1][0], s[2 * kk + 1][1], s[2 * kk + 1][2], s[2 * kk + 1][3]};
                const bf16x8 pf = pack8(pv);
#pragma unroll
                for (int dt = 0; dt < 4; ++dt) {
                    const LAS bf16* vp0 = Vs + (16 * (kt0 + 2 * kk) + 4 * fq + (fi >> 2)) * 72 + 16 * dt + 4 * (fi & 3);
                    const v4i16_t t0 = __builtin_amdgcn_ds_read_tr16_b64_v4i16((LAS v4i16_t*)vp0);
                    const v4i16_t t1 = __builtin_amdgcn_ds_read_tr16_b64_v4i16((LAS v4i16_t*)(vp0 + 16 * 72));
                    const bf16x8 vf = {t0[0], t0[1], t0[2], t0[3], t1[0], t1[1], t1[2], t1[3]};
                    o[dt] = MFMA16(vf, pf, o[dt]); } }
            bf16* op = AO + (size_t)(tokq0 + qi) * 1024 + h * 64 + 4 * fq;
#pragma unroll
            for (int dt = 0; dt < 4; ++dt) { v2u w; w.x = pk2(o[dt][0] * inv, o[dt][1] * inv); w.y = pk2(o[dt][2] * inv, o[dt][3] * inv); *(v2u*)(op + 16 * dt) = w; }
        }
        __syncthreads();
    }
}

constexpr int NPHASE = 20;
constexpr int BG6_PER = 8, BG6 = 256 * BG6_PER;
constexpr int BGQ9 = 4, BGQ10 = 3, BGQ12 = 3;
__device__ __forceinline__ int bg_done9(int nt) { const int r = (nt * 8) & 255; return BG6 + (r ? (256 - r) * BGQ9 : 0); }
__device__ __forceinline__ int bg_done10(int nt) { const int r = (nt * 4) & 255; return bg_done9(nt) + (r ? (256 - r) * BGQ10 : 0); }
__global__ void __launch_bounds__(NTHR, 2) fwd_kernel(Args args) {
    extern __shared__ __attribute__((aligned(16))) unsigned char lds_raw[];
    LAS unsigned char* lds = (LAS unsigned char*)lds_raw;
    volatile LAS unsigned* MISC = (volatile LAS unsigned*)(lds + MISC_OFF);
    const int tid = threadIdx.x, lane = tid & 63, wave = __builtin_amdgcn_readfirstlane(tid >> 6);
    const int G = gridDim.x;
    unsigned char* ws = args.ws;
    gu32* ctl = (gu32*)(ws + WS_CTL);
    for (int u = tid; u < (LDS_BYTES - LDSCTL_OFF) / 4; u += NTHR) ((LAS unsigned*)(lds + LDSCTL_OFF))[u] = 0u;
    __syncthreads();
    XcdBarrier bar = xcd_barrier_post((unsigned*)(ctl + CW_BAR), MISC + 8);
    const int lo = args.ph_lo, hi = args.ph_hi;
    int nt_l0 = 256;
#ifndef PROBE_MASK
#define PROBE_MASK 0
#endif
#define PROBE_REP(k) ((int)(((unsigned)PROBE_MASK >> (k)) & 1u))
#define PHASE(k, ...) do { if (IN(k)) { __VA_ARGS__ } if (IN(k) && PROBE_REP(k)) { __VA_ARGS__ } } while (0)
#ifdef ONLYMASK
#define IN(k) (((ONLYMASK >> (k)) & 1) && lo <= (k) && (k) < hi)
#else
#define IN(k) (lo <= (k) && (k) < hi)
#endif
#define SEAM(k) do { if (IN(k) && IN((k) + 1)) xcd_barrier(bar); } while (0)
    bf16* H = (bf16*)(ws + WS_H);
    float* X1 = (float*)(ws + WS_X1); float* X2 = (float*)(ws + WS_X2); float* X3 = (float*)(ws + WS_X3);
    float* GATE = (float*)(ws + WS_MISC + MISC_GATE);
    const unsigned char* YK = (const unsigned char*)(ws + WS_YK);

    PHASE(0,  p0_prologue(args, lds, wave, lane); p0_quant(args, lds, wave, lane); ); SEAM(0);
    PHASE(1,
        { const int gid = blockIdx.x * NTHR + tid; if (gid < 8192) { const int l = gid >> 12, w = (gid >> 11) & 1, b = (gid >> 10) & 1, col = gid & 1023; GATE[gid] = modval(args, l, b, (w ? 5120 : 2048) + col); } }
        norm_phase<0, false, true>(args, lds, 0, 0, args.in[I_X], nullptr, nullptr, nullptr, args.in[I_MINW] + XW, IN_DIM, args.in[I_MDTB], tid, wave, lane);
    ); SEAM(1);
    PHASE(2,  const bool grpA_ = (((int)blockIdx.x >> 3) & 1) == 0;
        if (grpA_) bg_run(args, lds, (int)blockIdx.x, 12, 256, wave, lane, 0);
        pg8::Gemm g{H, (const bf16*)(ws + WS_WIN), T, XW, D}; pg8::StaticOrder S; S.init(T, XW, G, (int)blockIdx.x);
        pg8::EpiBf16Q E{(bf16*)(ws + WS_ZX), XW, (const float*)(ws + WS_H + HS_OFF), (const float*)(ws + WS_WSC + WSC_IN)};
        pg8::gemm_phase<pg8::EpiBf16Q, pg8::StaticOrder, true, true>(lds + RING_OFF, g, S, E, lds + EPIX_OFF);
        if (!grpA_) bg_run(args, lds, (int)blockIdx.x, 12, 256, wave, lane, 0); ); SEAM(2);
    PHASE(3,  ssd_states(args, lds, tid, wave, lane); ); SEAM(3);
    PHASE(4,  ssd_scan(args, tid); ); SEAM(4);
    PHASE(5,  ssd_out(args, lds, tid, wave, lane); ); SEAM(5);
    PHASE(6,  const bool grpA6_ = (((int)blockIdx.x >> 3) & 1) == 0;
        if (!grpA6_) bg_run(args, lds, (int)blockIdx.x, BG6_PER, 256, wave, lane, 32);
        pg8::Gemm g{(const bf16*)(ws + WS_Y), (const bf16*)(ws + WS_WOUT), T, D, DI}; pg8::StaticOrder S; S.init(T, D, G, (int)blockIdx.x);
        pg8::EpiResid E{args.in[I_X], X1, GATE + (0 * 2 + 0) * 2048};
        pg8::gemm_phase<pg8::EpiResid, pg8::StaticOrder, true, true>(lds + RING_OFF, g, S, E);
        if (grpA6_) bg_run(args, lds, (int)blockIdx.x, BG6_PER, 256, wave, lane, 32); ); SEAM(6);
#define MOE_PHASES(layer, pb, xres) \
    PHASE(pb,  norm_phase<1, false, true>(args, lds, layer, 1, xres, nullptr, nullptr, nullptr, args.in[I_RW] + (size_t)(layer) * 1024 * 32, 32, args.in[I_RB] + (layer) * 32, tid, wave, lane); ); SEAM(pb); \
    PHASE((pb) + 1,  moe_scatter(args, lds, tid, wave, lane); \
        if ((layer) == 1) { const int d_ = bg_done10(nt_l0) + 128 * BGQ12; bg_run(args, lds, d_ + (int)blockIdx.x, 16, 256, wave, lane); } ); SEAM((pb) + 1); \
    PHASE((pb) + 2,  load_tile_table(args, lds, tid); \
        const volatile LAS int* TE = (const volatile LAS int*)(lds + TE_OFF); \
        pg8::Gemm g{(const bf16*)(ws + WS_H), (const bf16*)(ws + WS_W1 + (size_t)(layer) * 32 * 2048 * 1024), CAP, 32 * 2048, D}; \
        pg8::MoeGatherOrder S{(int)TE[MAXTILES], 8, G, (int)((blockIdx.x & 7) * 32 + (blockIdx.x >> 3)), TE, (const int*)(ws + WS_XG), (LAS int*)(lds + ROWT_OFF)}; \
        pg8::EpiSwigluQ E{(unsigned char*)(ws + WS_ACT), args.in[I_EB1] + (size_t)(layer) * 32 * 2048, (const float*)(ws + WS_XG + XGS_OFF), (const float*)(ws + WS_WSC + WSC_W1) + (size_t)(layer) * 32 * 2048}; \
        pg8::gemm_phase<pg8::EpiSwigluQ, pg8::MoeGatherOrder, true, true>(lds + RING_OFF, g, S, E, lds + EPIX_OFF); \
        if ((layer) == 0) { const int nt_ = (int)TE[MAXTILES]; nt_l0 = nt_; const int r_ = (nt_ * 8) & 255, vc_ = (int)((blockIdx.x & 7) * 32 + (blockIdx.x >> 3)); if (r_ && vc_ >= r_) bg_run(args, lds, BG6 + (vc_ - r_) * BGQ9, BGQ9, 1, wave, lane); } ); SEAM((pb) + 2); \
    PHASE((pb) + 3,  load_tile_table(args, lds, tid); \
        const volatile LAS int* TE = (const volatile LAS int*)(lds + TE_OFF); \
        pg8::Gemm g{(const bf16*)(ws + WS_ACT), (const bf16*)(ws + WS_W2 + (size_t)(layer) * 32 * 1024 * 1024), CAP, 32 * 1024, FF}; \
        pg8::MoeOrder S{(int)TE[MAXTILES], 4, G, (int)((blockIdx.x & 7) * 32 + (blockIdx.x >> 3)), TE, nullptr, nullptr}; \
        pg8::EpiMoeOutF8 E{(unsigned char*)(ws + WS_YK), args.in[I_EB2] + (size_t)(layer) * 32 * 1024, (const float*)(ws + WS_WSC + WSC_W2) + (size_t)(layer) * 32 * 1024, (const int*)(ws + WS_SRT), (const float*)(ws + WS_SRT + 524288)}; \
        pg8::gemm_phase<pg8::EpiMoeOutF8, pg8::MoeOrder, true, true>(lds + RING_OFF, g, S, E, lds + EPIX_OFF); \
        if ((layer) == 0) { const int nt_ = (int)TE[MAXTILES]; const int r_ = (nt_ * 4) & 255, vc_ = (int)((blockIdx.x & 7) * 32 + (blockIdx.x >> 3)); if (r_ && vc_ >= r_) bg_run(args, lds, bg_done9(nt_) + (vc_ - r_) * BGQ10, BGQ10, 1, wave, lane); } ); SEAM((pb) + 3);

    MOE_PHASES(0, 7, X1)
    PHASE(11,  norm_phase<2, true, true>(args, lds, 1, 0, X1, GATE + (0 * 2 + 1) * 2048, YK, X2, nullptr, 0, nullptr, tid, wave, lane); ); SEAM(11);
    PHASE(12,  pg8::Gemm g{H, (const bf16*)(ws + WS_WQKV), T, QKVW, D}; pg8::StaticOrder S; S.init(T, QKVW, G, (int)blockIdx.x);
        pg8::EpiBf16Q E{(bf16*)(ws + WS_QKV), QKVW, (const float*)(ws + WS_H + HS_OFF), (const float*)(ws + WS_WSC + WSC_QKV)};
        pg8::gemm_phase<pg8::EpiBf16Q, pg8::StaticOrder, true, true>(lds + RING_OFF, g, S, E, lds + EPIX_OFF);
        if ((int)blockIdx.x >= 128) bg_run(args, lds, bg_done10(nt_l0) + ((int)blockIdx.x - 128) * BGQ12, BGQ12, 1, wave, lane); ); SEAM(12);
    PHASE(13,  attn_phase(args, lds, tid, wave, lane); ); SEAM(13);
    PHASE(14,  pg8::Gemm g{(const bf16*)(ws + WS_AO), (const bf16*)(ws + WS_WAO), T, D, D}; pg8::StaticOrder S; S.init(T, D, G, (int)blockIdx.x);
        pg8::EpiResid E{X2, X3, GATE + (1 * 2 + 0) * 2048};
        pg8::gemm_phase<pg8::EpiResid, pg8::StaticOrder, true, true>(lds + RING_OFF, g, S, E); ); SEAM(14);
    MOE_PHASES(1, 15, X3)
    PHASE(19,  norm_phase<2, true, false>(args, lds, 1, 0, X3, GATE + (1 * 2 + 1) * 2048, YK, args.out, nullptr, 0, nullptr, tid, wave, lane); );
#undef MOE_PHASES
#undef IN
#undef SEAM
}

extern "C" void kernel_launch(void* const* d_in, const int* in_sizes, int n_in, void* d_out, int out_size, void* d_ws, size_t ws_size, hipStream_t stream) {
    static int grid = 0;
    if (grid == 0) {
        if (n_in != 26 || in_sizes[0] != T * D || out_size != T * D || ws_size < WS_END) { fprintf(stderr, "kernel_launch: unexpected shapes (n_in %d, in0 %d, out %d, ws %zu)\n", n_in, n_in > 0 ? in_sizes[0] : -1, out_size, ws_size); grid = -1; return; }
        if (hipFuncSetAttribute((const void*)fwd_kernel, hipFuncAttributeMaxDynamicSharedMemorySize, LDS_BYTES) != hipSuccess) { fprintf(stderr, "kernel_launch: hipFuncSetAttribute failed\n"); grid = -1; return; }
        int per_cu = 0;
        if (hipOccupancyMaxActiveBlocksPerMultiprocessor(&per_cu, (const void*)fwd_kernel, NTHR, LDS_BYTES) != hipSuccess || per_cu < 1) fprintf(stderr, "kernel_launch: occupancy query reports %d\n", per_cu);
        (void)hipGetLastError();
        grid = 256;
    }
    if (grid < 0) return;
    if (hipMemsetAsync((char*)d_ws + WS_CTL, 0, CTL_ZERO_BYTES, stream) != hipSuccess) { fprintf(stderr, "kernel_launch: memset failed\n"); return; }
    Args a{};
    for (int i = 0; i < 26; ++i) a.in[i] = (const float*)d_in[i];
    a.out = (float*)d_out; a.ws = (unsigned char*)d_ws;
#ifndef MK_SPLIT
    a.ph_lo = 0; a.ph_hi = NPHASE;
    hipLaunchKernelGGL(fwd_kernel, dim3(grid), dim3(NTHR), LDS_BYTES, stream, a);
#else
    for (int p = 0; p < NPHASE; ++p) { a.ph_lo = p; a.ph_hi = p + 1; hipLaunchKernelGGL(fwd_kernel, dim3(grid), dim3(NTHR), LDS_BYTES, stream, a); }
#endif
}
```
